# Optimizing an MI355X kernel written in HIP

```python
import jax, jax.numpy as jnp
from jax import lax
import numpy as np

D_MODEL = 2048
BATCH = 2
SEQ = 16384
DEPTH = 2

CTX_LEN = 256
GRID_W = 64
N_MOD = 9
D_FF = 5632
FNET_GROUPS = 8
FNET_GROUP_DIM = D_MODEL // FNET_GROUPS
RWKV_HEAD = 64
RWKV_HEADS = D_MODEL // RWKV_HEAD
DECAY_LORA = 96
AAA_LORA = 96
GATE_LORA = 256
N_DIR = 2
NORM_EPS = 1e-6
GN_EPS = 64e-5

kernel_name = 'hybrid_fnet_rwkv7_dit_trunk'


def rms_norm(x, g):
    x32 = x.astype(jnp.float32)
    y = x32 * lax.rsqrt(jnp.mean(x32 * x32, axis=-1, keepdims=True) + NORM_EPS)
    return (y * g.astype(jnp.float32)).astype(x.dtype)


def modulate(x, g, shift, scale):
    return rms_norm(x, g) * (1 + scale) + shift


def swiglu(h, w13, w2):
    gate, up = jnp.split(h @ w13, 2, axis=-1)
    return (jax.nn.silu(gate) * up) @ w2


def fourier_mix(h, w_o, b_o):
    B_, L, D = h.shape
    hg = h.astype(jnp.float32).reshape(B_, L, FNET_GROUPS, FNET_GROUP_DIM)
    f = jnp.fft.fftn(hg, axes=(1, 3), norm='ortho').real
    return f.reshape(B_, L, D).astype(h.dtype) @ w_o + b_o


def grid_shift(h):
    B_, L, D = h.shape
    rows = L // GRID_W
    q = D // 4
    g = h.reshape(B_, rows, GRID_W, D)
    left = jnp.pad(g[:, :, :-1, :q], ((0, 0), (0, 0), (1, 0), (0, 0)))
    right = jnp.pad(g[:, :, 1:, q:2 * q], ((0, 0), (0, 0), (0, 1), (0, 0)))
    up = jnp.pad(g[:, :-1, :, 2 * q:3 * q], ((0, 0), (1, 0), (0, 0), (0, 0)))
    down = jnp.pad(g[:, 1:, :, 3 * q:], ((0, 0), (0, 1), (0, 0), (0, 0)))
    return jnp.concatenate([left, right, up, down], axis=-1).reshape(B_, L, D)


def seq_shift(h):
    q = h.shape[-1] // 4
    prev = jnp.pad(h[:, :-1], ((0, 0), (1, 0), (0, 0)))
    nxt = jnp.pad(h[:, 1:], ((0, 0), (0, 1), (0, 0)))
    return jnp.concatenate([prev[..., :q], nxt[..., q:2 * q], prev[..., 2 * q:3 * q], nxt[..., 3 * q:]], axis=-1)


def rwkv_project(h, hs, mu, w_rkv, w0, w1, w2, a0, a1, a2, g1, g2, k_k, k_a):
    B_, L, D = h.shape
    hm = h[None] + (hs - h)[None] * mu[:, None, None, :]
    r, k, v = jnp.einsum('pbld,pde->pble', hm[:3], w_rkv)
    lora_w = jnp.einsum('zblr,zrd->zbld', jnp.tanh(jnp.einsum('bld,zdr->zblr', hm[3], w1)), w2)
    log_w = -jax.nn.softplus(-(w0[:, None, None, :] + lora_w)) - 0.5
    decay = jnp.exp(-jnp.exp(log_w))
    a = jax.nn.sigmoid(a0[:, None, None, :] + jnp.einsum('zblr,zrd->zbld', jnp.einsum('bld,zdr->zblr', hm[4], a1), a2))
    g = jax.nn.sigmoid(hm[5] @ g1) @ g2
    kk32 = (k * k_k).astype(jnp.float32).reshape(B_, L, RWKV_HEADS, RWKV_HEAD)
    kk32 = kk32 * lax.rsqrt(jnp.maximum(jnp.sum(kk32 * kk32, axis=-1, keepdims=True), 1e-24))
    kk = kk32.reshape(B_, L, D).astype(h.dtype)
    k_dir = k[None] * (1 + (a - 1) * k_a)
    b_dir = kk[None] * a
    return r, v, g, kk, decay, k_dir, b_dir


def wkv_step(S, inp):
    r, w, k, v, a, b = inp
    sa = jnp.einsum('bhij,bhj->bhi', S, a)
    S = S * w[:, :, None, :] + sa[..., None] * b[:, :, None, :] + v[..., None] * k[:, :, None, :]
    return S, jnp.einsum('bhij,bhj->bhi', S, r)


def wkv_scan(S0, reverse, r, w, k, v, a, b):
    B_, L, _ = r.shape
    seq = tuple(jnp.moveaxis(t.astype(jnp.float32).reshape(B_, L, RWKV_HEADS, RWKV_HEAD), 1, 0)
                for t in (r, w, k, v, a, b))
    S, ys = lax.scan(wkv_step, S0, seq, reverse=reverse)
    return S, jnp.moveaxis(ys, 0, 1)


def rwkv_output(y, r, k_bonus, v, g, r_k, ln_w, ln_b, w_o):
    B_, L = y.shape[:2]
    mean = jnp.mean(y, axis=-1, keepdims=True)
    var = jnp.mean(jnp.square(y - mean), axis=-1, keepdims=True)
    yn = (y - mean) * lax.rsqrt(var + GN_EPS)
    yn = yn * ln_w.reshape(RWKV_HEADS, RWKV_HEAD).astype(jnp.float32) + ln_b.reshape(RWKV_HEADS, RWKV_HEAD).astype(jnp.float32)
    rh = r.reshape(B_, L, RWKV_HEADS, RWKV_HEAD)
    kh = k_bonus.reshape(B_, L, RWKV_HEADS, RWKV_HEAD)
    vh = v.reshape(B_, L, RWKV_HEADS, RWKV_HEAD)
    bonus = jnp.sum(rh * kh * r_k, axis=-1, keepdims=True) * vh
    o = (yn.astype(r.dtype) + bonus).reshape(B_, L, D_MODEL) * g
    return o @ w_o


def rwkv_mix(h_ctx, h_lat, need_ctx_out, mu, w_rkv, w0, w1, w2, a0, a1, a2, g1, g2, k_k, k_a, r_k, ln_w, ln_b, w_o):
    p = (mu, w_rkv, w0, w1, w2, a0, a1, a2, g1, g2, k_k, k_a)
    r_c, v_c, g_c, kk_c, w_c, k_c, b_c = rwkv_project(h_ctx, seq_shift(h_ctx), *p)
    r_l, v_l, g_l, kk_l, w_l, k_l, b_l = rwkv_project(h_lat, grid_shift(h_lat), *p)
    B_ = h_lat.shape[0]
    S0 = jnp.zeros((B_, RWKV_HEADS, RWKV_HEAD, RWKV_HEAD), jnp.float32)
    S_f, yf_c = wkv_scan(S0, False, r_c, w_c[0], k_c[0], v_c, -kk_c, b_c[0])
    S_b, yb_c = wkv_scan(S0, True, r_c, w_c[1], k_c[1], v_c, -kk_c, b_c[1])
    _, yf_l = wkv_scan(S_f, False, r_l, w_l[0], k_l[0], v_l, -kk_l, b_l[0])
    _, yb_l = wkv_scan(S_b, True, r_l, w_l[1], k_l[1], v_l, -kk_l, b_l[1])
    o_lat = rwkv_output(yf_l + yb_l, r_l, 0.5 * (k_l[0] + k_l[1]), v_l, g_l, r_k, ln_w, ln_b, w_o)
    o_ctx = None
    if need_ctx_out:
        o_ctx = rwkv_output(yf_c + yb_c, r_c, 0.5 * (k_c[0] + k_c[1]), v_c, g_c, r_k, ln_w, ln_b, w_o)
    return o_ctx, o_lat


def setup_inputs(seed: int = 0) -> dict:
    key = jax.random.key(seed)
    ks = jax.random.split(key, 32)
    n_a = (DEPTH + 1) // 2
    n_b = DEPTH // 2
    D = D_MODEL

    def nrm(k, shape, s):
        return jax.random.normal(k, shape, jnp.float32) * s

    return {
        'x': nrm(ks[0], (BATCH, SEQ, D), 1.0),
        'c': nrm(ks[1], (BATCH, D), 1.0),
        'ctx': nrm(ks[2], (BATCH, CTX_LEN, D), 1.0),
        'c_ctx': nrm(ks[3], (D,), 1.0),
        'mod_w': nrm(ks[4], (DEPTH, D, N_MOD * D), 0.5 * D ** -0.5),
        'mod_b': nrm(ks[5], (DEPTH, N_MOD * D), 0.01),
        'norm_w': 1.0 + nrm(ks[6], (DEPTH, 3, D), 0.02),
        'ffn_w13': nrm(ks[7], (DEPTH, 2, D, 2 * D_FF), D ** -0.5),
        'ffn_w2': nrm(ks[8], (DEPTH, 2, D_FF, D), D_FF ** -0.5),
        'fnet_w_o': nrm(ks[9], (n_a, D, D), D ** -0.5),
        'fnet_b_o': nrm(ks[10], (n_a, D), 0.01),
        'rwkv_mu': jax.random.uniform(ks[11], (n_b, 6, D), jnp.float32),
        'rwkv_w_rkv': nrm(ks[12], (n_b, 3, D, D), D ** -0.5),
        'rwkv_w0': jax.random.uniform(ks[13], (n_b, N_DIR, D), jnp.float32, minval=-6.5, maxval=-1.5),
        'rwkv_w1': nrm(ks[14], (n_b, N_DIR, D, DECAY_LORA), D ** -0.5),
        'rwkv_w2': nrm(ks[15], (n_b, N_DIR, DECAY_LORA, D), 0.1 * DECAY_LORA ** -0.5),
        'rwkv_a0': nrm(ks[16], (n_b, N_DIR, D), 0.1),
        'rwkv_a1': nrm(ks[17], (n_b, N_DIR, D, AAA_LORA), D ** -0.5),
        'rwkv_a2': nrm(ks[18], (n_b, N_DIR, AAA_LORA, D), 0.1 * AAA_LORA ** -0.5),
        'rwkv_g1': nrm(ks[19], (n_b, D, GATE_LORA), D ** -0.5),
        'rwkv_g2': nrm(ks[20], (n_b, GATE_LORA, D), GATE_LORA ** -0.5),
        'rwkv_k_k': 0.85 + nrm(ks[21], (n_b, D), 0.05),
        'rwkv_k_a': 1.0 + nrm(ks[22], (n_b, D), 0.05),
        'rwkv_r_k': nrm(ks[23], (n_b, RWKV_HEADS, RWKV_HEAD), 0.1),
        'rwkv_ln_w': 1.0 + nrm(ks[24], (n_b, D), 0.02),
        'rwkv_ln_b': nrm(ks[25], (n_b, D), 0.01),
        'rwkv_w_o': nrm(ks[26], (n_b, D, D), D ** -0.5),
        'final_norm_w': 1.0 + nrm(ks[27], (D,), 0.02),
    }


def reference(x, c, ctx, c_ctx, mod_w, mod_b, norm_w, ffn_w13, ffn_w2, fnet_w_o, fnet_b_o,
              rwkv_mu, rwkv_w_rkv, rwkv_w0, rwkv_w1, rwkv_w2, rwkv_a0, rwkv_a1, rwkv_a2,
              rwkv_g1, rwkv_g2, rwkv_k_k, rwkv_k_a, rwkv_r_k, rwkv_ln_w, rwkv_ln_b, rwkv_w_o,
              final_norm_w):
    B_ = x.shape[0]
    sc = jax.nn.silu(c)
    sc_ctx = jax.nn.silu(c_ctx)
    xl, xc = x, ctx
    for i in range(DEPTH):
        last = i == DEPTH - 1
        kind = i % 2
        j = i // 2
        ml = (sc @ mod_w[i] + mod_b[i]).reshape(B_, N_MOD, D_MODEL)[:, :, None, :]
        mc = (sc_ctx @ mod_w[i] + mod_b[i]).reshape(N_MOD, D_MODEL)
        ctx_live = (not last) or kind == 1

        xl = xl + 0.5 * ml[:, 2] * swiglu(modulate(xl, norm_w[i, 0], ml[:, 0], ml[:, 1]), ffn_w13[i, 0], ffn_w2[i, 0])
        if ctx_live:
            xc = xc + 0.5 * mc[2] * swiglu(modulate(xc, norm_w[i, 0], mc[0], mc[1]), ffn_w13[i, 0], ffn_w2[i, 0])

        hl = modulate(xl, norm_w[i, 1], ml[:, 3], ml[:, 4])
        if kind == 0:
            o_l = fourier_mix(hl, fnet_w_o[j], fnet_b_o[j])
            if not last:
                hc = modulate(xc, norm_w[i, 1], mc[3], mc[4])
                xc = xc + mc[5] * fourier_mix(hc, fnet_w_o[j], fnet_b_o[j])
        else:
            hc = modulate(xc, norm_w[i, 1], mc[3], mc[4])
            o_c, o_l = rwkv_mix(hc, hl, not last, rwkv_mu[j], rwkv_w_rkv[j], rwkv_w0[j], rwkv_w1[j], rwkv_w2[j],
                                rwkv_a0[j], rwkv_a1[j], rwkv_a2[j], rwkv_g1[j], rwkv_g2[j], rwkv_k_k[j],
                                rwkv_k_a[j], rwkv_r_k[j], rwkv_ln_w[j], rwkv_ln_b[j], rwkv_w_o[j])
            if not last:
                xc = xc + mc[5] * o_c
        xl = xl + ml[:, 5] * o_l

        xl = xl + 0.5 * ml[:, 8] * swiglu(modulate(xl, norm_w[i, 2], ml[:, 6], ml[:, 7]), ffn_w13[i, 1], ffn_w2[i, 1])
        if not last:
            xc = xc + 0.5 * mc[8] * swiglu(modulate(xc, norm_w[i, 2], mc[6], mc[7]), ffn_w13[i, 1], ffn_w2[i, 1])
    return rms_norm(xl, final_norm_w)
```

```cpp
#include <hip/hip_runtime.h>
#include <cstdio>
#include <cstdint>

#ifndef MK_PER_PHASE
#define MK_PER_PHASE 0
#endif
#ifndef MK_PROBE
#define MK_PROBE 0
#endif
#define REP(mask) _Pragma("unroll 1") for (int rep_ = 0; rep_ < ((MK_PROBE & (mask)) ? 2 : 1); ++rep_)
#ifndef MK_DEBUG
#define MK_DEBUG 0
#endif

#define GAS __attribute__((address_space(1)))
#define LAS __attribute__((address_space(3)))
typedef unsigned short bf16;
typedef unsigned v4u __attribute__((ext_vector_type(4)));
typedef unsigned v2u __attribute__((ext_vector_type(2)));
typedef float f32x4 __attribute__((ext_vector_type(4)));
typedef float f32x2 __attribute__((ext_vector_type(2)));
typedef float f32x16 __attribute__((ext_vector_type(16)));
typedef short bf16x8 __attribute__((ext_vector_type(8)));
typedef __bf16 bf2_t __attribute__((ext_vector_type(2)));

constexpr int D = 2048, NBATCH = 2, SEQ = 16384, CTXL = 256, DFF = 5632, NMODV = 9 * 2048, NH = 32, HD = 64;
constexpr int ML = NBATCH * SEQ, MC = NBATCH * CTXL, MT = ML + MC;
constexpr int LORA = 96;
constexpr int HKT = DFF / 64;
constexpr int NWAVES = 8;
constexpr float NORM_EPS = 1e-6f, GN_EPS = 64e-5f;

constexpr size_t MiB = 1u << 20;
constexpr size_t WS_CTL = 0, CTL_ZERO_BYTES = 64 * 1024;
constexpr size_t WS_MODP = 1 * MiB;
constexpr size_t WS_TAB = 3 * MiB;
constexpr size_t TAB_DMAT = 0, TAB_M1 = 262144, TAB_M2 = 393216, TAB_M3 = 524288, TAB_TW = 786432;
constexpr size_t WS_RSTD = 4 * MiB;
constexpr size_t WS_SA = 5 * MiB;
constexpr size_t WS_XC = 14 * MiB;
constexpr size_t WS_WSMALL = 18 * MiB;
constexpr size_t WSM_W1CAT = 0, WSM_A1CAT = 1 * MiB, WSM_G1T = 2 * MiB, WSM_W2UP = 3 * MiB, WSM_A2UP = 4 * MiB, WSM_G2T = 5 * MiB;
constexpr size_t WS_WFO = 24 * MiB, WS_WRO = 32 * MiB, WS_WRKV = 40 * MiB;
constexpr size_t WS_WL0 = 64 * MiB, WS_WL1 = 196 * MiB;
constexpr size_t WS_ACT = 328 * MiB;
constexpr size_t ACT_HN = 0, ACT_H = 130 * MiB;
constexpr size_t ACT_YT = 130 * MiB, ACT_T2 = 386 * MiB, ACT_YC = 642 * MiB;
constexpr size_t ACT_XM = 0, XM_STRIDE = 130 * MiB, ACT_LR = 780 * MiB, LR_STRIDE = 17039360;
constexpr size_t ACT_WBUF = 0, WBUF_STRIDE = 123 * MiB, ACT_YB0 = 248 * MiB, ACT_YB1 = 829 * MiB, ACT_PO = 0;
constexpr size_t WS_SST = WS_ACT + 957 * MiB;
constexpr size_t WS_RKVC = WS_SST + 2 * MiB;
constexpr size_t WS_PS = WS_RKVC + 6 * MiB;
constexpr size_t WS_MODV = WS_PS + 6 * MiB;
constexpr size_t WS_END = WS_MODV + 1 * MiB;
static_assert(WS_END <= 1476395008ull, "workspace map exceeds the guaranteed minimum");
static_assert((size_t)MT * D * 2 == 130 * MiB, "XM size");

constexpr int CW_DBG = 8;
constexpr int CW_BAR = 4096;
constexpr int CW_PCNT = 8192;

#define LDS_WAIT() asm volatile("s_waitcnt lgkmcnt(0)" ::: "memory")
#define VM_WAIT() asm volatile("s_waitcnt vmcnt(0)" ::: "memory")
__device__ __forceinline__ unsigned pk2(float lo, float hi) { f32x2 v = {lo, hi}; bf2_t b = __builtin_convertvector(v, bf2_t); return __builtin_bit_cast(unsigned, b); }
__device__ __forceinline__ float bf2f(bf16 b) { return __uint_as_float(((unsigned)b) << 16); }
__device__ __forceinline__ float bflo(unsigned w) { return __uint_as_float(w << 16); }
__device__ __forceinline__ float bfhi(unsigned w) { return __uint_as_float(w & 0xffff0000u); }
__device__ __forceinline__ float wave_sum(float v) {
#pragma unroll
    for (int o = 1; o < 64; o <<= 1) v += __shfl_xor(v, o);
    return v;
}
__device__ __forceinline__ float sigmoidf_(float x) { return __builtin_amdgcn_rcpf(1.f + __expf(-x)); }

#define XB_TMO      128
#define XB_XCNT(j)  (256  + 64 * (j))
#define XB_XSUB(j)  (1280 + 64 * (j))
#define XB_XGEN(j)  (2304 + 64 * (j))
#define XB_TOP      3328
#define XB_TOPGEN   3392
#define XCD_BAR_WORDS 3456
#define XB_SPIN_CAP (1u << 22)

__device__ __forceinline__ unsigned xb_ld(unsigned* p)              { return __hip_atomic_load(p, __ATOMIC_RELAXED, __HIP_MEMORY_SCOPE_AGENT); }
__device__ __forceinline__ unsigned xb_add(unsigned* p, unsigned v) { return __hip_atomic_fetch_add(p, v, __ATOMIC_RELAXED, __HIP_MEMORY_SCOPE_AGENT); }
__device__ __forceinline__ unsigned xb_xcc_id() { return (unsigned)__builtin_amdgcn_s_getreg((3 << 11) | 20) & 0xFu; }
#define XB_SPIN(cond, bar) do { unsigned _sp = 0; while (cond) { __builtin_amdgcn_s_sleep(1); \
    if ((++_sp & 255u) == 0u) { if (xb_ld(&(bar)[XB_TMO])) break; if (_sp > XB_SPIN_CAP) { atomicAdd(&(bar)[XB_TMO], 1u); break; } } } } while (0)

struct XcdBarrier { unsigned* bar; unsigned x; volatile LAS unsigned* st; };

__device__ __forceinline__ XcdBarrier xcd_barrier_post(unsigned* bar, volatile LAS unsigned* st) {
    XcdBarrier b; b.bar = bar; b.x = xb_xcc_id(); b.st = st;
    if (threadIdx.x == 0) (void)xb_add(&bar[XB_XCNT(b.x)], 1u);
    return b;
}
__device__ __forceinline__ void xcd_barrier_complete(unsigned* bar, unsigned x, unsigned& nloc, unsigned& nx) {
    const unsigned G = gridDim.x * gridDim.y * gridDim.z;
    unsigned sum, cnt, mine, sp = 0u;
    for (;;) {
        sum = 0u; cnt = 0u; mine = 0u;
#pragma unroll
        for (unsigned j = 0; j < 16; ++j) { const unsigned c = xb_ld(&bar[XB_XCNT(j)]); sum += c; cnt += (c > 0u) ? 1u : 0u; mine = (j == x) ? c : mine; }
        if (sum == G) break;
        __builtin_amdgcn_s_sleep(1);
        if ((++sp & 255u) == 0u) { if (xb_ld(&bar[XB_TMO])) break; if (sp > XB_SPIN_CAP) { atomicAdd(&bar[XB_TMO], 1u); break; } }
    }
    nloc = mine > 0u ? mine : 1u; nx = cnt > 0u ? cnt : 1u;
}
__device__ __forceinline__ void xcd_barrier(const XcdBarrier& b) {
    asm volatile("s_waitcnt vmcnt(0)" ::: "memory");
    __syncthreads();
    if (threadIdx.x == 0) {
        unsigned* bar = b.bar;
        __builtin_amdgcn_s_waitcnt(0);
        unsigned nloc = b.st[0], nx = b.st[1];
        if (nloc == 0u) { xcd_barrier_complete(bar, b.x, nloc, nx); b.st[0] = nloc; b.st[1] = nx; }
        const unsigned old = xb_add(&bar[XB_XSUB(b.x)], 1u);
        const unsigned gen = old / nloc;
        if (old + 1u == (gen + 1u) * nloc) {
            __builtin_amdgcn_fence(__ATOMIC_RELEASE, "agent");
            asm volatile("s_waitcnt vmcnt(0)" ::: "memory");
            const unsigned og = xb_add(&bar[XB_TOP], 1u);
            const unsigned tg = og / nx;
            if (og + 1u == (tg + 1u) * nx) xb_add(&bar[XB_TOPGEN], 1u);
            else XB_SPIN(xb_ld(&bar[XB_TOPGEN]) == tg, bar);
            __builtin_amdgcn_fence(__ATOMIC_ACQUIRE, "agent");
            xb_add(&bar[XB_XGEN(b.x)], 1u);
            asm volatile("s_waitcnt vmcnt(0)" ::: "memory");
        } else {
            XB_SPIN(xb_ld(&bar[XB_XGEN(b.x)]) == gen, bar);
            __builtin_amdgcn_fence(__ATOMIC_ACQUIRE, "agent");
            asm volatile("s_waitcnt vmcnt(0)" ::: "memory");
        }
    }
    __syncthreads();
}

namespace pg8 {
constexpr int BM = 256, BK = 64, HALF = 128, HTB = HALF * BK * 2, STAGE_BYTES = 8 * HTB, NXCD = 8, WGM = 8;
__host__ __device__ __forceinline__ int lds_byte(int r, int c) { const int st = (r >> 4) * 2 + (c >> 5), rr = r & 15, cc = c & 31, ob = rr * 64 + cc * 2; return st * 1024 + (ob ^ (((ob >> 9) & 1) << 5)); }
__host__ __device__ __forceinline__ void stage_rc(int b, int& R, int& C) { const int st = b / 1024, sb = b % 1024, swz = sb ^ (((sb >> 9) & 1) << 5); R = (st >> 1) * 16 + swz / 64; C = (st & 1) * 32 + (swz % 64) / 2; }
__host__ __device__ __forceinline__ int perm32(int rho) { const int n = rho >> 4, i = rho & 15; return 8 * (i >> 2) + 4 * n + (i & 3); }

struct Unit { int pm, pn; };
struct StaticOrder {
    int nM, nN, nwg, G, c, wgm, pm0, rev;
    __host__ __device__ void init(int nM_, int nN_, int G_, int c_, int wgm_ = WGM, int pm0_ = 0, int rev_ = 0) { nM = nM_; nN = nN_; nwg = nM * nN; G = G_; c = c_; wgm = wgm_; pm0 = pm0_; rev = rev_; }
    __host__ __device__ bool next(int i, Unit& u) const {
        const long L = (long)i * G + c; if (L >= nwg) return false;
        int wgid = (int)L; { const int q = nwg / NXCD, r = nwg % NXCD, xcd = wgid % NXCD, off = wgid / NXCD; wgid = (xcd < r ? xcd * (q + 1) : r * (q + 1) + (xcd - r) * q) + off; }
        const int nig = wgm * nN, gid = wgid / nig, fm = gid * wgm, gsz = (nM - fm) < wgm ? (nM - fm) : wgm;
        const int pmi = fm + ((wgid % nig) % gsz); u.pm = pm0 + (rev ? nM - 1 - pmi : pmi); u.pn = (wgid % nig) / gsz; return true;
    }
};
struct OpPlain {
    const bf16* base; int ld; bool isA;
    __device__ __forceinline__ const char* tile(const Unit& u) const { return (const char*)base + (size_t)(isA ? u.pm : u.pn) * 256 * ld * 2; }
    __device__ __forceinline__ unsigned voff(int R, int C) const { return (unsigned)(R * ld + C) * 2u; }
    __device__ __forceinline__ size_t hstep() const { return (size_t)HALF * ld * 2; }
    __device__ __forceinline__ size_t kstep() const { return 128; }
};

template <class AOp, class BOp, class Epi, class Sched>
__device__ __forceinline__ void gemm_phase(LAS unsigned char* lds, const int K, const AOp& Aop, const BOp& Bop, const Sched& S, const Epi& E) {
    int tid = threadIdx.x; asm volatile("" : "+v"(tid));
    const int wid = __builtin_amdgcn_readfirstlane(tid >> 6), lane = tid & 63, wr = wid >> 2, wc = wid & 3, fr = lane & 15, fq = lane >> 4;
    int nt = K / BK; asm volatile("" : "+s"(nt));
    unsigned voffA[2], voffB[2];
#pragma unroll
    for (int i = 0; i < 2; ++i) { int R, C; stage_rc(tid * 16 + i * 8192, R, C); const int Rb = Epi::PERM ? ((R & ~31) + perm32(R & 31)) : R;
        voffA[i] = Aop.voff(R, C); voffB[i] = Bop.voff(Rb, C); }
    const size_t kstepA = Aop.kstep(), kstepB = Bop.kstep();
    const size_t hstepA = Aop.hstep(), hstepB = Bop.hstep();
    const unsigned ldsw = (unsigned)wid * 1024u;
    const int aoff = lds_byte(wr * 64 + fr, fq * 8), boff = lds_byte(wc * 32 + fr, fq * 8);
#define PG8_SA(b, h) (((b) * 2 + (h)) * HTB)
#define PG8_SB(b, h) ((4 + (b) * 2 + (h)) * HTB)
#define PG8_STAGE(bufoff, gbase, voff) do { _Pragma("unroll") for (int _i = 0; _i < 2; ++_i) \
        __builtin_amdgcn_global_load_lds((const unsigned*)((const char*)(gbase) + (voff)[_i]), (LAS unsigned*)(lds + (bufoff) + ldsw + _i * 8192), 16, 0, 0); } while (0)
#define PG8_LDA(dst, b, h) do { _Pragma("unroll") for (int m = 0; m < 4; ++m) _Pragma("unroll") for (int k = 0; k < 2; ++k) dst[m][k] = *(const LAS bf16x8*)(lds + PG8_SA(b, h) + aoff + m * 2048 + k * 1024); } while (0)
#define PG8_LDB(dst, b, h) do { _Pragma("unroll") for (int n = 0; n < 2; ++n) _Pragma("unroll") for (int k = 0; k < 2; ++k) dst[n][k] = *(const LAS bf16x8*)(lds + PG8_SB(b, h) + boff + n * 2048 + k * 1024); } while (0)
#define PG8_MMA(ai, bj, At, Bt) do { __builtin_amdgcn_s_setprio(1); _Pragma("unroll") for (int m = 0; m < 4; ++m) _Pragma("unroll") for (int n = 0; n < 2; ++n) _Pragma("unroll") for (int k = 0; k < 2; ++k) \
        acc[ai][bj][m][n] = __builtin_amdgcn_mfma_f32_16x16x32_bf16(Bt[n][k], At[m][k], acc[ai][bj][m][n], 0, 0, 0); __builtin_amdgcn_s_setprio(0); } while (0)
#define PG8_WAIT_V(n) asm volatile("s_waitcnt vmcnt(" #n ")" ::: "memory")
#define PG8_WAIT_L(n) asm volatile("s_waitcnt lgkmcnt(" #n ")" ::: "memory")
#define PG8_BAR __builtin_amdgcn_s_barrier()
#define PG8_SCHED __builtin_amdgcn_sched_barrier(0)
    Unit cur, nxt; int ui = 0;
    if (!S.next(0, cur)) return;
    f32x4 acc[2][2][4][2];
#pragma unroll
    for (int a = 0; a < 2; ++a)
#pragma unroll
        for (int b = 0; b < 2; ++b)
#pragma unroll
            for (int m = 0; m < 4; ++m)
#pragma unroll
                for (int n = 0; n < 2; ++n) acc[a][b][m][n] = (f32x4){0.f, 0.f, 0.f, 0.f};
    bf16x8 At[4][2], B0[2][2], B1[2][2];
    const char* cA = Aop.tile(cur); const char* cB = Bop.tile(cur);
    PG8_STAGE(PG8_SB(0, 0), cB, voffB); PG8_STAGE(PG8_SB(0, 1), cB + hstepB, voffB); PG8_STAGE(PG8_SA(0, 0), cA, voffA); PG8_STAGE(PG8_SA(0, 1), cA + hstepA, voffA);
    if (wr == 1) PG8_BAR;
    PG8_WAIT_V(2); PG8_BAR;
    PG8_STAGE(PG8_SB(1, 0), cB + kstepB, voffB); PG8_STAGE(PG8_SA(1, 0), cA + kstepA, voffA); PG8_STAGE(PG8_SB(1, 1), cB + hstepB + kstepB, voffB);
    PG8_WAIT_V(6); PG8_BAR;
    for (;;) {
        const bool has_next = S.next(ui + 1, nxt);
        const char* nA = has_next ? Aop.tile(nxt) : cA; const char* nB = has_next ? Bop.tile(nxt) : cB;
#pragma unroll 1
        for (int t = 0; t < nt; t += 2) {
            const bool last = (t == nt - 2);
            const char* a1 = cA + (size_t)(t + 1) * kstepA;
            const char* a2 = last ? nA : cA + (size_t)(t + 2) * kstepA; const char* b2 = last ? nB : cB + (size_t)(t + 2) * kstepB;
            const char* a3 = a2 + kstepA; const char* b3 = b2 + kstepB;
            PG8_LDB(B0, 0, 0); PG8_LDB(B1, 0, 1); PG8_SCHED; PG8_LDA(At, 0, 0); PG8_STAGE(PG8_SA(1, 1), a1 + hstepA, voffA);
            PG8_WAIT_V(8); PG8_WAIT_L(0); PG8_BAR; PG8_MMA(0, 0, At, B0); PG8_MMA(0, 1, At, B1); PG8_BAR; PG8_SCHED;
            PG8_LDA(At, 0, 1); PG8_STAGE(PG8_SB(0, 0), b2, voffB); PG8_STAGE(PG8_SB(0, 1), b2 + hstepB, voffB); PG8_STAGE(PG8_SA(0, 0), a2, voffA);
            PG8_WAIT_V(8); PG8_WAIT_L(0); PG8_BAR; PG8_MMA(1, 0, At, B0); PG8_MMA(1, 1, At, B1); PG8_BAR; PG8_SCHED;
            PG8_LDB(B0, 1, 0); PG8_LDB(B1, 1, 1); PG8_SCHED; PG8_LDA(At, 1, 0); PG8_STAGE(PG8_SA(0, 1), a2 + hstepA, voffA);
            PG8_WAIT_V(8); PG8_WAIT_L(0); PG8_BAR; PG8_MMA(0, 0, At, B0); PG8_MMA(0, 1, At, B1); PG8_BAR; PG8_SCHED;
            PG8_LDA(At, 1, 1); PG8_STAGE(PG8_SB(1, 0), b3, voffB); PG8_STAGE(PG8_SB(1, 1), b3 + hstepB, voffB); PG8_STAGE(PG8_SA(1, 0), a3, voffA);
            PG8_WAIT_V(8); PG8_WAIT_L(0); PG8_BAR; PG8_MMA(1, 0, At, B0); PG8_MMA(1, 1, At, B1); PG8_BAR; PG8_SCHED;
        }
        if (wr == 0) PG8_BAR;
        E(acc, cur, wr, wc, fr, fq);
        if (!has_next) break;
#pragma unroll
        for (int a = 0; a < 2; ++a)
#pragma unroll
            for (int b = 0; b < 2; ++b)
#pragma unroll
                for (int m = 0; m < 4; ++m)
#pragma unroll
                    for (int n = 0; n < 2; ++n) acc[a][b][m][n] = (f32x4){0.f, 0.f, 0.f, 0.f};
        cur = nxt; cA = nA; cB = nB; ++ui;
        if (wr == 1) PG8_BAR;
    }
    PG8_WAIT_V(0);
    PG8_BAR;
#undef PG8_SA
#undef PG8_SB
#undef PG8_STAGE
#undef PG8_LDA
#undef PG8_LDB
#undef PG8_MMA
#undef PG8_WAIT_V
#undef PG8_WAIT_L
#undef PG8_BAR
#undef PG8_SCHED
}
}

constexpr int RING_OFF = 0, RING_BYTES = 131072;
constexpr int LDSCTL_OFF = 160 * 1024 - 64;
constexpr int LDS_BYTES = 160 * 1024;

struct Args { const float* in[28]; float* out; unsigned char* ws; int ph_lo, ph_hi; };
struct Frame {
    LAS unsigned char* lds;
    volatile LAS unsigned* MISC;
    unsigned* ctl;
    int vcu, G;
    float* out; unsigned char* ws; const float* modb;
};
struct ModRef { const float* modp; const float* modb; const float* modv; };
__device__ __forceinline__ f32x4 modv4(const ModRef& M, int layer, int who, int col  ) {
    const float* p = M.modp + ((size_t)(layer * 3 + who)) * NMODV + col;
    f32x4 s = *(const f32x4*)(M.modb + (size_t)layer * NMODV + col);
#pragma unroll
    for (int q = 0; q < 4; ++q) s += *(const f32x4*)(p + (size_t)q * 6 * NMODV);
    return s;
}
__device__ __forceinline__ f32x4 modvF(const ModRef& M, int layer, int who, int col) { return *(const f32x4*)(M.modv + ((size_t)(layer * 3 + who)) * NMODV + col); }
__device__ __forceinline__ int who_of_row(int r) { return r < SEQ ? 0 : (r < ML ? 1 : 2); }

struct EpiSwiGLU {
    static constexpr bool PERM = true;
    bf16* H;
    __device__ __forceinline__ void operator()(const f32x4 (&acc)[2][2][4][2], const pg8::Unit& u, int wr, int wc, int fr, int fq) const {
        const int rl0 = wr * 64 + fr; const size_t tb = ((size_t)u.pm * HKT + 2 * u.pn + (wc >> 1)) * 16384 + 32 * (wc & 1) + 8 * fq;
#pragma unroll
        for (int ai = 0; ai < 2; ++ai)
#pragma unroll
            for (int m = 0; m < 4; ++m) {
                bf16* rowp = H + tb + (size_t)(rl0 + ai * 128 + m * 16) * 64;
                float h[8];
#pragma unroll
                for (int n = 0; n < 2; ++n)
#pragma unroll
                    for (int e = 0; e < 4; ++e) { const float g = acc[ai][0][m][n][e], up = acc[ai][1][m][n][e]; h[4 * n + e] = g * sigmoidf_(g) * up; }
                v4u w; w.x = pk2(h[0], h[1]); w.y = pk2(h[2], h[3]); w.z = pk2(h[4], h[5]); w.w = pk2(h[6], h[7]);
                *(v4u*)rowp = w;
            }
    }
};
template <bool HAS_BIAS, bool HALF, bool DRY = false> struct EpiResid {
    static constexpr bool PERM = false;
    ModRef MR; const float* baseL; const float* baseC; float* outL; float* outC; const float* bias; int layer, gidx;
    __device__ __forceinline__ void operator()(const f32x4 (&acc)[2][2][4][2], const pg8::Unit& u, int wr, int wc, int fr, int fq) const {
        const int who = u.pm < 64 ? 0 : (u.pm < 128 ? 1 : 2);
        const bool isl = u.pm < 128;
        const int rbase = (isl ? u.pm : u.pm - 128) * 256 + wr * 64 + fr;
        const float* bp = isl ? baseL : baseC; float* op = isl ? outL : outC;
        const int col0 = u.pn * 256 + wc * 32 + 4 * fq;
        f32x4 gv[2][2], bv[2][2];
#pragma unroll
        for (int bj = 0; bj < 2; ++bj)
#pragma unroll
            for (int n = 0; n < 2; ++n) { gv[bj][n] = modvF(MR, layer, who, gidx * D + col0 + bj * 128 + n * 16) * (HALF ? 0.5f : 1.0f);
                bv[bj][n] = (f32x4){0.f, 0.f, 0.f, 0.f}; if (HAS_BIAS) bv[bj][n] = *(const f32x4*)(bias + col0 + bj * 128 + n * 16); }
#pragma unroll
        for (int ai = 0; ai < 2; ++ai) {
            f32x4 bs[4][2][2];
#pragma unroll
            for (int m = 0; m < 4; ++m)
#pragma unroll
                for (int bj = 0; bj < 2; ++bj)
#pragma unroll
                    for (int n = 0; n < 2; ++n) bs[m][bj][n] = *(const f32x4*)(bp + (size_t)(rbase + ai * 128 + m * 16) * D + col0 + bj * 128 + n * 16);
#pragma unroll
            for (int m = 0; m < 4; ++m) asm volatile("" : "+v"(bs[m][0][0]), "+v"(bs[m][0][1]), "+v"(bs[m][1][0]), "+v"(bs[m][1][1]));
#pragma unroll
            for (int m = 0; m < 4; ++m)
#pragma unroll
                for (int bj = 0; bj < 2; ++bj)
#pragma unroll
                    for (int n = 0; n < 2; ++n) { const f32x4 o_ = bs[m][bj][n] + gv[bj][n] * (acc[ai][bj][m][n] + bv[bj][n]);
                        if (!DRY || o_.x == 123456.789f) *(f32x4*)(op + (size_t)(rbase + ai * 128 + m * 16) * D + col0 + bj * 128 + n * 16) = o_; }
            asm volatile("" ::: "memory");
        }
    }
};

template <bool HAS_BIAS, bool HALF, int NX> struct EpiResidNorm {
    static constexpr bool PERM = false;
    ModRef MR; const float* baseL; float* outL; const float* bias; int layer, gidx;
    const float* nw; int nlayer, sidx; bf16* HN; float* RSTD; float* PS; unsigned* cnt; LAS unsigned char* sl;
    __device__ __forceinline__ void operator()(const f32x4 (&acc)[2][2][4][2], const pg8::Unit& u, int wr, int wc, int fr_, int fq_) const {
        int fr = fr_, fq = fq_; asm volatile("" : "+v"(fr), "+v"(fq));
        const int who = u.pm < 64 ? 0 : 1;
        const int rbase = u.pm * 256 + wr * 64 + fr;
        const int col0 = u.pn * 256 + wc * 32 + 4 * fq;
        const unsigned eo0 = (unsigned)(rbase * D + col0) * 4u;
        f32x4 xn[2][2][4][2]; float ssq[2][4];
        {
            f32x4 gv[2][2];
#pragma unroll
            for (int bj = 0; bj < 2; ++bj)
#pragma unroll
                for (int n = 0; n < 2; ++n) { gv[bj][n] = modvF(MR, layer, who, gidx * D + col0 + bj * 128 + n * 16) * (HALF ? 0.5f : 1.0f);
                    f32x4 bv = (f32x4){0.f, 0.f, 0.f, 0.f}; if (HAS_BIAS) bv = *(const f32x4*)(bias + col0 + bj * 128 + n * 16);
#pragma unroll
                    for (int ai = 0; ai < 2; ++ai)
#pragma unroll
                        for (int m = 0; m < 4; ++m) { xn[ai][bj][m][n] = acc[ai][bj][m][n]; if (HAS_BIAS) xn[ai][bj][m][n] += bv; } }
#pragma unroll
            for (int ai = 0; ai < 2; ++ai) {
                f32x4 bs[4][2][2];
#pragma unroll
                for (int m = 0; m < 4; ++m)
#pragma unroll
                    for (int bj = 0; bj < 2; ++bj)
#pragma unroll
                        for (int n = 0; n < 2; ++n) bs[m][bj][n] = *(const f32x4*)((const char*)baseL + (size_t)(eo0 + (unsigned)((ai * 128 + m * 16) * D) * 4u) + (bj * 128 + n * 16) * 4);
#pragma unroll
                for (int m = 0; m < 4; ++m) asm volatile("" : "+v"(bs[m][0][0]), "+v"(bs[m][0][1]), "+v"(bs[m][1][0]), "+v"(bs[m][1][1]));
#pragma unroll
                for (int m = 0; m < 4; ++m) { float sq = 0.f;
#pragma unroll
                    for (int bj = 0; bj < 2; ++bj)
#pragma unroll
                        for (int n = 0; n < 2; ++n) { const f32x4 o_ = bs[m][bj][n] + gv[bj][n] * xn[ai][bj][m][n];
                            *(f32x4*)((char*)outL + (size_t)(eo0 + (unsigned)((ai * 128 + m * 16) * D) * 4u) + (bj * 128 + n * 16) * 4) = o_;
                            xn[ai][bj][m][n] = o_; sq += (o_.x * o_.x + o_.y * o_.y) + (o_.z * o_.z + o_.w * o_.w); }
                    ssq[ai][m] = sq; }
                asm volatile("" ::: "memory");
            }
        }
        f32x4 a4[2][2], b4[2][2];
        if (NX != 3) {
#pragma unroll
            for (int bj = 0; bj < 2; ++bj)
#pragma unroll
                for (int n = 0; n < 2; ++n) { const int col = col0 + bj * 128 + n * 16;
                    a4[bj][n] = *(const f32x4*)(nw + col); b4[bj][n] = (f32x4){0.f, 0.f, 0.f, 0.f};
                    if (NX != 4) { a4[bj][n] = a4[bj][n] * (modvF(MR, nlayer, who, (sidx + 1) * D + col) + 1.f); b4[bj][n] = modvF(MR, nlayer, who, sidx * D + col); } }
        }
        LAS float* P = (LAS float*)sl; LAS float* RS = P + 1024;
#pragma unroll
        for (int ai = 0; ai < 2; ++ai)
#pragma unroll
            for (int m = 0; m < 4; ++m) { float v = ssq[ai][m]; v += __shfl_xor(v, 16); v += __shfl_xor(v, 32); if (fq == 0) P[wc * 256 + ai * 128 + wr * 64 + m * 16 + fr] = v; }
        LDS_WAIT(); __builtin_amdgcn_s_barrier(); asm volatile("" ::: "memory");
        const int wid = wr * 4 + wc, t = wid * 64 + fq * 16 + fr;
        if (wid < 4) {
            const float v = (P[t] + P[256 + t]) + (P[512 + t] + P[768 + t]);
            unsigned* slot = (unsigned*)PS + (size_t)u.pm * 2048 + t;
            __hip_atomic_store(slot + u.pn * 256, __float_as_uint(v) | 1u, __ATOMIC_RELAXED, __HIP_MEMORY_SCOPE_AGENT);
            float tot = 0.f;
            for (int it = 0; it < (1 << 20); ++it) { unsigned w[8]; bool ok = true;
#pragma unroll
                for (int j = 0; j < 8; ++j) { w[j] = __hip_atomic_load(slot + j * 256, __ATOMIC_RELAXED, __HIP_MEMORY_SCOPE_AGENT); ok = ok && (w[j] != 0u); }
                if (__all(ok)) { tot = ((__uint_as_float(w[0]) + __uint_as_float(w[1])) + (__uint_as_float(w[2]) + __uint_as_float(w[3]))) + ((__uint_as_float(w[4]) + __uint_as_float(w[5])) + (__uint_as_float(w[6]) + __uint_as_float(w[7]))); break; }
                __builtin_amdgcn_s_sleep(1); }
            const float rstd = 1.0f / sqrtf(tot * (1.f / D) + NORM_EPS); RS[t] = rstd;
            if (NX == 3 && u.pn == 0) RSTD[u.pm * 256 + t] = rstd; }
        LDS_WAIT(); __builtin_amdgcn_s_barrier(); asm volatile("" ::: "memory");
        if (NX == 3) return;
        asm volatile("" : "+v"(fr), "+v"(fq));
        const int rl0 = wr * 64 + fr, cb = u.pn * 256 + wc * 32 + 4 * fq;
        float rs[2][4];
#pragma unroll
        for (int ai = 0; ai < 2; ++ai)
#pragma unroll
            for (int m = 0; m < 4; ++m) rs[ai][m] = RS[ai * 128 + m * 16 + rl0];
#pragma unroll
        for (int bj = 0; bj < 2; ++bj)
#pragma unroll
            for (int n = 0; n < 2; ++n) { const int col = cb + bj * 128 + n * 16;
#pragma unroll
                for (int ai = 0; ai < 2; ++ai)
#pragma unroll
                    for (int m = 0; m < 4; ++m) { const int rl = ai * 128 + m * 16 + rl0; const f32x4 o_ = xn[ai][bj][m][n] * rs[ai][m] * a4[bj][n] + b4[bj][n];
                        if (NX == 4) *(f32x4*)((char*)outL + (unsigned)((u.pm * 256 + rl) * D + col) * 4u) = o_;
                        else { f32x2 w; w.x = __uint_as_float(pk2(o_.x, o_.y)); w.y = __uint_as_float(pk2(o_.z, o_.w));
                            if (NX == 1) *(f32x2*)((char*)HN + (unsigned)((u.pm * (D / 64) + (col >> 6)) * 16384 + rl * 64 + (col & 63)) * 2u) = w;
                            else *(f32x2*)((char*)HN + (unsigned)((u.pm * 256 + rl) * D + col) * 2u) = w; } }
                asm volatile("" ::: "memory"); }
    }
};

struct OpHBlk {
    const bf16* base; int pm0, kt0;
    __device__ __forceinline__ const char* tile(const pg8::Unit& u) const { return (const char*)base + ((size_t)(pm0 < 0 ? u.pm : pm0 + (u.pm & 1)) * HKT + (pm0 < 0 ? 0 : (u.pm >> 1) * kt0)) * 32768; }
    __device__ __forceinline__ unsigned voff(int R, int C) const { return (unsigned)(R * 64 + C) * 2u; }
    __device__ __forceinline__ size_t hstep() const { return 16384; }
    __device__ __forceinline__ size_t kstep() const { return 32768; }
};
struct OpBlk {
    const bf16* base; int nkt; bool isA;
    __device__ __forceinline__ const char* tile(const pg8::Unit& u) const { return (const char*)base + (size_t)(isA ? u.pm : u.pn) * nkt * 32768; }
    __device__ __forceinline__ unsigned voff(int R, int C) const { return (unsigned)(R * 64 + C) * 2u; }
    __device__ __forceinline__ size_t hstep() const { return 16384; }
    __device__ __forceinline__ size_t kstep() const { return 32768; }
};
struct OpBlkK {
    const bf16* base; int nkt;
    __device__ __forceinline__ const char* tile(const pg8::Unit& u) const { return (const char*)base + ((size_t)(u.pn & 7) * nkt + (size_t)(u.pn >> 3) * (nkt / 4)) * 32768; }
    __device__ __forceinline__ unsigned voff(int R, int C) const { return (unsigned)(R * 64 + C) * 2u; }
    __device__ __forceinline__ size_t hstep() const { return 16384; }
    __device__ __forceinline__ size_t kstep() const { return 32768; }
};
struct OrderCtxK { int G, c; __device__ __forceinline__ bool next(int i, pg8::Unit& u) const { const int L = i * G + c; if (L >= 64) return false; const int kq = L >> 4; u.pm = (L & 1) + 2 * kq; u.pn = ((L >> 1) & 7) + 8 * kq; return true; } };
struct OpKSplit {
    const bf16* base; int ld, klen; bool isA;
    __device__ __forceinline__ const char* tile(const pg8::Unit& u) const { const int t = isA ? (u.pm & 1) : (u.pn & 7), kq = isA ? (u.pm >> 1) : (u.pn >> 3); return (const char*)base + ((size_t)t * 256 * ld + (size_t)kq * klen) * 2; }
    __device__ __forceinline__ unsigned voff(int R, int C) const { return (unsigned)(R * ld + C) * 2u; }
    __device__ __forceinline__ size_t hstep() const { return (size_t)128 * ld * 2; }
    __device__ __forceinline__ size_t kstep() const { return 128; }
};
template <bool HAS_BIAS, bool HALF> struct EpiCtxAtomic {
    static constexpr bool PERM = false;
    ModRef MR; float* XC; const float* bias; int layer, gidx;
    __device__ __forceinline__ void operator()(const f32x4 (&acc)[2][2][4][2], const pg8::Unit& u, int wr, int wc, int fr, int fq) const {
        const int panel = u.pm & 1, ct = u.pn & 7, kq = u.pn >> 3;
        const int rbase = panel * 256 + wr * 64 + fr, col0 = ct * 256 + wc * 32 + 4 * fq;
#pragma unroll
        for (int bj = 0; bj < 2; ++bj)
#pragma unroll
            for (int n = 0; n < 2; ++n) {
                const f32x4 gv = modvF(MR, layer, 2, gidx * D + col0 + bj * 128 + n * 16) * (HALF ? 0.5f : 1.0f);
                f32x4 bv = {0.f, 0.f, 0.f, 0.f}; if (HAS_BIAS) { if (kq == 0) bv = *(const f32x4*)(bias + col0 + bj * 128 + n * 16); }
#pragma unroll
                for (int ai = 0; ai < 2; ++ai)
#pragma unroll
                    for (int m = 0; m < 4; ++m) { float* op = XC + (size_t)(rbase + ai * 128 + m * 16) * D + col0 + bj * 128 + n * 16; const f32x4 v = gv * (acc[ai][bj][m][n] + bv);
#pragma unroll
                        for (int e = 0; e < 4; ++e) (void)__hip_atomic_fetch_add(op + e, v[e], __ATOMIC_RELAXED, __HIP_MEMORY_SCOPE_AGENT); }
            }
    }
};

struct OpFixed {
    const bf16* base; int ld; int alt;
    __device__ __forceinline__ const char* tile(const pg8::Unit& u) const { return (const char*)base + (size_t)(alt ? (u.pm & 1) : 0) * 256 * ld * 2; }
    __device__ __forceinline__ unsigned voff(int R, int C) const { return (unsigned)(R * ld + C) * 2u; }
    __device__ __forceinline__ size_t hstep() const { return (size_t)128 * ld * 2; }
    __device__ __forceinline__ size_t kstep() const { return 128; }
};
struct OpChanL {
    const bf16* hn;
    __device__ __forceinline__ const char* tile(const pg8::Unit& u) const { return (const char*)hn + ((size_t)((u.pn >> 6) * SEQ + 2 * (u.pn & 63)) * D + (u.pm >> 1) * 256) * 2; }
    __device__ __forceinline__ unsigned voff(int R, int C) const { return (unsigned)(128 * R * D + C) * 2u; }
    __device__ __forceinline__ size_t hstep() const { return (size_t)D * 2; }
    __device__ __forceinline__ size_t kstep() const { return 128; }
};
struct OpChanC {
    const bf16* hn;
    __device__ __forceinline__ const char* tile(const pg8::Unit& u) const { return (const char*)hn + ((size_t)(ML + u.pn * CTXL) * D + (u.pm >> 1) * 256) * 2; }
    __device__ __forceinline__ unsigned voff(int R, int C) const { return (unsigned)(R * D + C) * 2u; }
    __device__ __forceinline__ size_t hstep() const { return (size_t)128 * D * 2; }
    __device__ __forceinline__ size_t kstep() const { return 128; }
};
struct OpStage2B {
    const bf16* T2;
    __device__ __forceinline__ const char* tile(const pg8::Unit& u) const { return (const char*)T2 + ((size_t)(u.pn >> 7) * 256 * 128 + (u.pn & 127)) * 512; }
    __device__ __forceinline__ unsigned voff(int R, int C) const { return (unsigned)R * 65536u + (unsigned)C * 2u; }
    __device__ __forceinline__ size_t hstep() const { return (size_t)128 * 65536; }
    __device__ __forceinline__ size_t kstep() const { return 128; }
};
__device__ __forceinline__ v4u pack8(const f32x4& a, const f32x4& b) { v4u w; w.x = pk2(a.x, a.y); w.y = pk2(a.z, a.w); w.z = pk2(b.x, b.y); w.w = pk2(b.z, b.w); return w; }
struct EpiChanL {
    static constexpr bool PERM = true; bf16* YT;
    __device__ __forceinline__ void operator()(const f32x4 (&acc)[2][2][4][2], const pg8::Unit& u, int wr, int wc, int fr, int fq) const {
        const int g = u.pm >> 1, cs = u.pm & 1, b = u.pn >> 6, n2p = u.pn & 63;
#pragma unroll
        for (int ai = 0; ai < 2; ++ai)
#pragma unroll
            for (int m = 0; m < 4; ++m) { const int kc = 128 * ai + 64 * wr + 16 * m + fr;
#pragma unroll
                for (int bj = 0; bj < 2; ++bj) { const unsigned idx = ((((unsigned)(b * 8 + g) * 256u + kc) * 128u + (2 * n2p + bj)) * 2u + cs) * 128u + 32 * wc + 8 * fq;
                    *(v4u*)((char*)YT + (size_t)(idx * 2u)) = pack8(acc[ai][bj][m][0], acc[ai][bj][m][1]); }
                asm volatile("" ::: "memory"); }
    }
};
struct EpiChanC {
    static constexpr bool PERM = true; bf16* YC;
    __device__ __forceinline__ void operator()(const f32x4 (&acc)[2][2][4][2], const pg8::Unit& u, int wr, int wc, int fr, int fq) const {
        const int g = u.pm >> 1, cs = u.pm & 1, b = u.pn;
#pragma unroll
        for (int ai = 0; ai < 2; ++ai)
#pragma unroll
            for (int m = 0; m < 4; ++m) { const int kc = 128 * ai + 64 * wr + 16 * m + fr;
#pragma unroll
                for (int bj = 0; bj < 2; ++bj) { const unsigned idx = (((unsigned)(b * 8 + g) * 256u + kc) * 2u + cs) * 256u + 128 * bj + 32 * wc + 8 * fq;
                    *(v4u*)((char*)YC + (size_t)(idx * 2u)) = pack8(acc[ai][bj][m][0], acc[ai][bj][m][1]); }
                asm volatile("" ::: "memory"); }
    }
};
struct EpiStage1 {
    static constexpr bool PERM = true; bf16* T2; const float* tw;
    __device__ __forceinline__ void operator()(const f32x4 (&acc)[2][2][4][2], const pg8::Unit& u, int wr, int wc, int fr, int fq) const {
#pragma unroll
        for (int m = 0; m < 4; ++m) { const int k1 = 64 * wr + 16 * m + fr, n20 = 32 * wc + 8 * fq;
#pragma unroll
            for (int n = 0; n < 2; ++n) {
                const f32x4 t0 = *(const f32x4*)((const char*)tw + (size_t)((unsigned)(k1 * 128 + n20 + 4 * n) * 8u));
                const f32x4 t1 = *(const f32x4*)((const char*)tw + (size_t)((unsigned)(k1 * 128 + n20 + 4 * n) * 8u + 16u));
#pragma unroll
                for (int bj = 0; bj < 2; ++bj) { const int chq = 2 * u.pn + bj;
                    const f32x4 tr = acc[0][bj][m][n], ti = acc[1][bj][m][n];
                    const f32x4 c = {t0.x, t0.z, t1.x, t1.z}, sn = {t0.y, t0.w, t1.y, t1.w};
                    const f32x4 ur = tr * c - ti * sn, ui = tr * sn + ti * c;
                    const unsigned idx = (((unsigned)chq * 128u + k1) * 2u) * 128u + n20 + 4 * n;
                    v2u w0; w0.x = pk2(ur.x, ur.y); w0.y = pk2(ur.z, ur.w); v2u w1; w1.x = pk2(ui.x, ui.y); w1.y = pk2(ui.z, ui.w);
                    *(v2u*)((char*)T2 + (size_t)(idx * 2u)) = w0; *(v2u*)((char*)T2 + (size_t)(idx * 2u + 256u)) = w1; }
                asm volatile("" ::: "memory"); } }
    }
};
struct EpiStage2 {
    static constexpr bool PERM = true; bf16* FO;
    __device__ __forceinline__ void operator()(const f32x4 (&acc)[2][2][4][2], const pg8::Unit& u, int wr, int wc, int fr, int fq) const {
        const int bg = u.pn >> 7, k1 = u.pn & 127, b = bg >> 3, g = bg & 7;
#pragma unroll
        for (int m = 0; m < 4; ++m) { const int k2 = 64 * wr + 16 * m + fr; const unsigned row = (unsigned)b * SEQ + k1 + 128 * k2;
#pragma unroll
            for (int bj = 0; bj < 2; ++bj) *(v4u*)((char*)FO + (size_t)((row * D + g * 256 + 128 * bj + 32 * wc + 8 * fq) * 2u)) = pack8(acc[0][bj][m][0], acc[0][bj][m][1]);
            asm volatile("" ::: "memory"); }
    }
};
struct EpiCtxDft {
    static constexpr bool PERM = true; bf16* FO;
    __device__ __forceinline__ void operator()(const f32x4 (&acc)[2][2][4][2], const pg8::Unit& u, int wr, int wc, int fr, int fq) const {
        const int b = u.pn >> 3, g = u.pn & 7;
#pragma unroll
        for (int ai = 0; ai < 2; ++ai)
#pragma unroll
            for (int m = 0; m < 4; ++m) { const int k = 128 * ai + 64 * wr + 16 * m + fr; const unsigned row = (unsigned)ML + b * CTXL + k;
#pragma unroll
                for (int bj = 0; bj < 2; ++bj) *(v4u*)((char*)FO + (size_t)((row * D + g * 256 + 128 * bj + 32 * wc + 8 * fq) * 2u)) = pack8(acc[ai][bj][m][0], acc[ai][bj][m][1]);
                asm volatile("" ::: "memory"); }
    }
};

struct OpXM {
    const bf16* base; int div, add;
    __device__ __forceinline__ const char* tile(const pg8::Unit& u) const { return (const char*)base + (size_t)(add + u.pn / div) * XM_STRIDE + (size_t)u.pm * 256 * D * 2; }
    __device__ __forceinline__ unsigned voff(int R, int C) const { return (unsigned)(R * D + C) * 2u; }
    __device__ __forceinline__ size_t hstep() const { return (size_t)128 * D * 2; }
    __device__ __forceinline__ size_t kstep() const { return 128; }
};
struct OpWSel {
    const bf16* base; int div; size_t stride;
    __device__ __forceinline__ const char* tile(const pg8::Unit& u) const { return (const char*)base + (size_t)(u.pn / div) * stride + (size_t)(u.pn % div) * 256 * D * 2; }
    __device__ __forceinline__ unsigned voff(int R, int C) const { return (unsigned)(R * D + C) * 2u; }
    __device__ __forceinline__ size_t hstep() const { return (size_t)128 * D * 2; }
    __device__ __forceinline__ size_t kstep() const { return 128; }
};
struct EpiLora {
    static constexpr bool PERM = true; bf16* LR;
    __device__ __forceinline__ void operator()(const f32x4 (&acc)[2][2][4][2], const pg8::Unit& u, int wr, int wc, int fr, int fq) const {
        const int which = u.pn; bf16* O = (bf16*)((char*)LR + (size_t)which * LR_STRIDE);
#pragma unroll
        for (int ai = 0; ai < 2; ++ai)
#pragma unroll
            for (int m = 0; m < 4; ++m) { const unsigned row = u.pm * 256 + 128 * ai + 64 * wr + 16 * m + fr;
#pragma unroll
                for (int bj = 0; bj < 2; ++bj) { f32x4 a = acc[ai][bj][m][0], b = acc[ai][bj][m][1];
                    if (which == 0) {
#pragma unroll
                        for (int e = 0; e < 4; ++e) { a[e] = 1.f - 2.f * __builtin_amdgcn_rcpf(1.f + __expf(2.f * a[e])); b[e] = 1.f - 2.f * __builtin_amdgcn_rcpf(1.f + __expf(2.f * b[e])); } }
                    else if (which == 2) {
#pragma unroll
                        for (int e = 0; e < 4; ++e) { a[e] = sigmoidf_(a[e]); b[e] = sigmoidf_(b[e]); } }
                    *(v4u*)((char*)O + (size_t)((row * 256u + 128 * bj + 32 * wc + 8 * fq) * 2u)) = pack8(a, b); }
                asm volatile("" ::: "memory"); }
    }
};
struct EpiRkv {
    static constexpr bool PERM = true; bf16* XM;
    __device__ __forceinline__ void operator()(const f32x4 (&acc)[2][2][4][2], const pg8::Unit& u, int wr, int wc, int fr, int fq) const {
        char* O = (char*)XM + (size_t)(3 + u.pn / 8) * XM_STRIDE; const int colt = (u.pn % 8) * 256;
#pragma unroll
        for (int ai = 0; ai < 2; ++ai)
#pragma unroll
            for (int m = 0; m < 4; ++m) { const unsigned row = u.pm * 256 + 128 * ai + 64 * wr + 16 * m + fr;
#pragma unroll
                for (int bj = 0; bj < 2; ++bj) *(v4u*)(O + (size_t)((row * D + colt + 128 * bj + 32 * wc + 8 * fq) * 2u)) = pack8(acc[ai][bj][m][0], acc[ai][bj][m][1]);
                asm volatile("" ::: "memory"); }
    }
};
struct EpiRkvC {
    static constexpr bool PERM = true; bf16* O;
    __device__ __forceinline__ void operator()(const f32x4 (&acc)[2][2][4][2], const pg8::Unit& u, int wr, int wc, int fr, int fq) const {
        char* Op = (char*)O + (size_t)(u.pn / 8) * MC * D * 2; const int colt = (u.pn % 8) * 256;
#pragma unroll
        for (int ai = 0; ai < 2; ++ai)
#pragma unroll
            for (int m = 0; m < 4; ++m) { const unsigned row = (u.pm - 128) * 256 + 128 * ai + 64 * wr + 16 * m + fr;
#pragma unroll
                for (int bj = 0; bj < 2; ++bj) *(v4u*)(Op + (size_t)((row * D + colt + 128 * bj + 32 * wc + 8 * fq) * 2u)) = pack8(acc[ai][bj][m][0], acc[ai][bj][m][1]);
                asm volatile("" ::: "memory"); }
    }
};
template <bool DRY = false> struct EpiMulG {
    static constexpr bool PERM = true; bf16* PO;
    __device__ __forceinline__ void operator()(const f32x4 (&acc)[2][2][4][2], const pg8::Unit& u, int wr, int wc, int fr, int fq) const {
#pragma unroll
        for (int ai = 0; ai < 2; ++ai)
#pragma unroll
            for (int m = 0; m < 4; ++m) { const unsigned row = u.pm * 256 + 128 * ai + 64 * wr + 16 * m + fr;
#pragma unroll
                for (int bj = 0; bj < 2; ++bj) { v4u* ptr = (v4u*)((char*)PO + (size_t)((row * D + u.pn * 256 + 128 * bj + 32 * wc + 8 * fq) * 2u));
                    const v4u o = *ptr; const f32x4 a = acc[ai][bj][m][0], b = acc[ai][bj][m][1];
                    v4u w; w.x = pk2(bflo(o.x) * a.x, bfhi(o.x) * a.y); w.y = pk2(bflo(o.y) * a.z, bfhi(o.y) * a.w); w.z = pk2(bflo(o.z) * b.x, bfhi(o.z) * b.y); w.w = pk2(bflo(o.w) * b.z, bfhi(o.w) * b.w);
                    if (!DRY || w.x == 0x12345678u) *ptr = w; }
                asm volatile("" ::: "memory"); }
    }
};

__device__ __forceinline__ void phase_rowstats(Frame& F, const float* xl, const float* xc, float* RSTD, int r0) {
    int tid_ = threadIdx.x; asm volatile("" : "+v"(tid_)); const int LANE = tid_ & 63, WAVE = __builtin_amdgcn_readfirstlane(tid_ >> 6);
    const int gw = F.vcu * NWAVES + WAVE, NGW = F.G * NWAVES;
    for (int r = r0 + gw; r < MT; r += NGW) {
        const float* xr = r < ML ? xl + (size_t)r * D : xc + (size_t)(r - ML) * D; float ss = 0.f;
#pragma unroll
        for (int j = 0; j < 8; ++j) { const f32x4 v = *(const f32x4*)(xr + 256 * j + 4 * LANE); ss += (v.x * v.x + v.y * v.y) + (v.z * v.z + v.w * v.w); }
        const float rstd = 1.0f / sqrtf(wave_sum(ss) * (1.f / D) + NORM_EPS);
        if (LANE == 0) RSTD[r] = rstd;
    }
}
__device__ __forceinline__ void phase_mix(Frame& F, const ModRef& MR, const float* xl, const float* xc, const float* RSTD, const float* nw, const float* mu, bf16* XM) {
    int tid_ = threadIdx.x; asm volatile("" : "+v"(tid_)); const int TID = tid_, LANE = tid_ & 63, WAVE = __builtin_amdgcn_readfirstlane(tid_ >> 6);
    LAS float* TA = (LAS float*)(F.lds); LAS float* TB = (LAS float*)(F.lds + 24576); LAS float* TM = (LAS float*)(F.lds + 49152);
    for (int i = TID; i < 3 * D / 4; i += NWAVES * 64) { const int who = i / (D / 4), d = (i % (D / 4)) * 4;
        const f32x4 sh = modvF(MR, 1, who, 3 * D + d), sc = modvF(MR, 1, who, 4 * D + d), g = *(const f32x4*)(nw + d);
        *(LAS f32x4*)(TA + who * D + d) = g * (sc + 1.f); *(LAS f32x4*)(TB + who * D + d) = sh; }
    for (int i = TID; i < 6 * D / 4; i += NWAVES * 64) *(LAS f32x4*)(TM + 4 * i) = *(const f32x4*)(mu + 4 * i);
    __syncthreads();
    const int gw = F.vcu * NWAVES + WAVE, NGW = F.G * NWAVES;
    for (int r = gw; r < MT; r += NGW) {
        const int who = who_of_row(r);
        const bool isl = r < ML; const int t = isl ? (r & (SEQ - 1)) : ((r - ML) & (CTXL - 1));
        const float* xr = isl ? xl + (size_t)r * D : xc + (size_t)(r - ML) * D;
        const float rs = RSTD[r];
#pragma unroll
        for (int j = 0; j < 4; ++j) {
            int dt; bool ok;
            if (isl) { const int gx = t & 63, gy = t >> 6; if (j == 0) { dt = -1; ok = gx > 0; } else if (j == 1) { dt = 1; ok = gx < 63; } else if (j == 2) { dt = -64; ok = gy > 0; } else { dt = 64; ok = gy < SEQ / 64 - 1; } }
            else { if ((j & 1) == 0) { dt = -1; ok = t > 0; } else { dt = 1; ok = t < CTXL - 1; } }
            const int d = 512 * j + 8 * LANE;
            const f32x4 a0 = *(const LAS f32x4*)(TA + who * D + d), a1 = *(const LAS f32x4*)(TA + who * D + d + 4), b0 = *(const LAS f32x4*)(TB + who * D + d), b1 = *(const LAS f32x4*)(TB + who * D + d + 4);
            const f32x4 x0 = *(const f32x4*)(xr + d), x1 = *(const f32x4*)(xr + d + 4);
            const f32x4 h0 = x0 * rs * a0 + b0, h1 = x1 * rs * a1 + b1;
            f32x4 s0 = {0.f, 0.f, 0.f, 0.f}, s1 = s0;
            if (ok) { const float rn = RSTD[r + dt]; const float* xn = xr + (ptrdiff_t)dt * D; const f32x4 y0 = *(const f32x4*)(xn + d), y1 = *(const f32x4*)(xn + d + 4); s0 = y0 * rn * a0 + b0; s1 = y1 * rn * a1 + b1; }
            const f32x4 d0 = s0 - h0, d1 = s1 - h1;
#pragma unroll
            for (int p = 0; p < 6; ++p) { const f32x4 m0 = *(const LAS f32x4*)(TM + p * D + d), m1 = *(const LAS f32x4*)(TM + p * D + d + 4);
                *(v4u*)((char*)XM + (size_t)p * XM_STRIDE + ((size_t)r * D + d) * 2) = pack8(h0 + d0 * m0, h1 + d1 * m1); }
        }
    }
}

constexpr int SCAN_BLK = 12544, SC_WQ = 80, SCAN_NW = 14;
constexpr int SC_NSLOT = 4, SC_SLOT = SCAN_BLK;
constexpr int SC_NPROD_A = 5, SC_NPROD_B = 8, SC_QA = 24, SC_QA0 = 6;
constexpr int SC_WF = 0, SC_CONST = 24576, SC_CTL = SC_CONST + 1280, SC_RING = SC_CTL + 128, SC_PROD_A = SC_RING + SC_NSLOT * SC_SLOT, SC_PROD_B = SC_RING, SC_PSTRIDE = 14592;
constexpr int BLK_AR = 0, BLK_G = 4096, BLK_BK = 6144, BLK_VF = 10240, BLK_PCF = 12288;
static_assert(SC_PROD_A + SC_NPROD_A * SC_PSTRIDE <= LDSCTL_OFF && SC_PROD_B + SC_NPROD_B * SC_PSTRIDE <= LDSCTL_OFF && 4608 + 3072 <= 8192 && 8192 + 6400 <= SC_PSTRIDE, "scan LDS map");
__device__ __forceinline__ int scan_row(int b, int z, int s) { if (s < CTXL) return ML + b * CTXL + (z ? CTXL - 1 - s : s); const int sp = s - CTXL; return b * SEQ + (z ? SEQ - 1 - sp : sp); }
__device__ __forceinline__ int sc_chain(int b) { return ((b & 7) | ((b >> 4) << 3)) & 127; }
__device__ __forceinline__ int sc_half(int b) { return (b >> 3) & 1; }
__device__ __forceinline__ int win_lo(int w) { return w == 0 ? 0 : 16 + SC_WQ * (w - 1); }
__device__ __forceinline__ int win_n(int w) { return w == 0 ? 16 : (w == SCAN_NW - 1 ? 1024 - SC_WQ * (SCAN_NW - 2) : SC_WQ); }
template <int N> __device__ __forceinline__ float dpp_row_shr(float v) { return __int_as_float(__builtin_amdgcn_update_dpp(0, __float_as_int(v), 0x110 + N, 0xf, 0xf, true)); }
__device__ __forceinline__ bf16x8 pack_frag(float a0, float a1, float a2, float a3, float a4, float a5, float a6, float a7) { v4u w; w.x = pk2(a0, a1); w.y = pk2(a2, a3); w.z = pk2(a4, a5); w.w = pk2(a6, a7); return __builtin_bit_cast(bf16x8, w); }
#define MFMA32(a, b, c) __builtin_amdgcn_mfma_f32_32x32x16_bf16((a), (b), (c), 0, 0, 0)
#define MFMA16(a, b, c) __builtin_amdgcn_mfma_f32_16x16x32_bf16((a), (b), (c), 0, 0, 0)

__device__ __forceinline__ void scan_setup(const Frame& F, const Args& AR, int tid) {
    const int chain = sc_chain(blockIdx.x), h = (chain >> 1) & 31, z = chain & 1;
    const bf16* W2UP = (const bf16*)(F.ws + WS_WSMALL + WSM_W2UP); const bf16* A2UP = (const bf16*)(F.ws + WS_WSMALL + WSM_A2UP);
    for (int i = tid; i < 2 * 12 * 64; i += NWAVES * 64) { const int which = i / 768, f = (i / 64) % 12, ln = i & 63, ks = f >> 2, mt = f & 3, tau = ln & 15, g = ln >> 4;
        *(LAS v4u*)(F.lds + SC_WF + i * 16) = *(const v4u*)((which ? A2UP : W2UP) + ((size_t)(z * D + h * 64 + 16 * mt + tau)) * LORA + 32 * ks + 8 * g); }
    for (int i = tid; i < 5 * 64; i += NWAVES * 64) { const int k = i / 64, c = h * 64 + (i & 63);
        ((LAS float*)(F.lds + SC_CONST))[i] = k == 0 ? AR.in[13][z * D + c] : k == 1 ? AR.in[16][z * D + c] : k == 2 ? AR.in[21][c] : k == 3 ? AR.in[22][c] : AR.in[23][c]; }
}
__device__ __forceinline__ void scan_produce(const Frame& F, int w, int pw, int lane_in, bool isA) {
    int lane = lane_in;
    LAS unsigned char* scr = F.lds + (isA ? SC_PROD_A : SC_PROD_B) + pw * SC_PSTRIDE;
    const int nq = win_n(w), lo = win_lo(w), qa = (nq == 16) ? SC_QA0 : (nq * 3) / 8;
    const int nhalf = isA ? qa : nq - qa;
    const bf16* RKV = (const bf16*)(F.ws + WS_ACT + ACT_XM + 3 * XM_STRIDE);
    const bf16* TWb = (const bf16*)(F.ws + WS_ACT + ACT_LR); const bf16* TAb = (const bf16*)(F.ws + WS_ACT + ACT_LR + LR_STRIDE);
    unsigned char* wbuf = F.ws + WS_ACT + ACT_WBUF + (size_t)(w & 1) * WBUF_STRIDE;
    float* SA = (float*)(F.ws + WS_SA);
    const int chain = sc_chain(blockIdx.x), b = chain >> 6, h = (chain >> 1) & 31, z = chain & 1, q0 = isA ? 0 : qa;
    if (blockIdx.x >= 256) return;
    v2u r2n[4], k2n[4], v2n[4]; bf16x8 bwn[3], ban[3];
    const bf16* RK0 = w == 0 ? (const bf16*)(F.ws + WS_RKVC) - (size_t)ML * D : RKV; const size_t RKS = w == 0 ? (size_t)MC * D : (size_t)MT * D;
#define SC_LOADS(qq) do { const int row_ = scan_row(b, z, (lo + (qq)) * 16 + (lane & 15)); \
        const unsigned ob_ = ((unsigned)row_ * D + h * 64 + 4 * (lane >> 4)) * 2u, ol_ = ((unsigned)row_ * 256 + z * 96 + 8 * (lane >> 4)) * 2u; \
        _Pragma("unroll") for (int mt = 0; mt < 4; ++mt) { \
            r2n[mt] = *(const v2u*)((const char*)RK0 + (size_t)(ob_ + 32u * mt)); k2n[mt] = *(const v2u*)((const char*)(RK0 + RKS) + (size_t)(ob_ + 32u * mt)); v2n[mt] = *(const v2u*)((const char*)(RK0 + 2 * RKS) + (size_t)(ob_ + 32u * mt)); } \
        _Pragma("unroll") for (int ks = 0; ks < 3; ++ks) { bwn[ks] = *(const bf16x8*)((const char*)TWb + (size_t)(ol_ + 64u * ks)); ban[ks] = *(const bf16x8*)((const char*)TAb + (size_t)(ol_ + 64u * ks)); } } while (0)
    volatile LAS unsigned* tctr = (volatile LAS unsigned*)(F.lds + SC_CTL + 8);
#define SC_GRAB() ({ unsigned v_ = 0; if (lane == 0) v_ = __hip_atomic_fetch_add((LAS unsigned*)(F.lds + SC_CTL + 8), 1u, __ATOMIC_RELAXED, __HIP_MEMORY_SCOPE_WORKGROUP); (int)__builtin_amdgcn_readfirstlane(v_); })
    int qi = pw, qn = SC_GRAB();
    (void)tctr;
    if (qi < nhalf) SC_LOADS(q0 + qi);
#pragma unroll 1
    for (; qi < nhalf; qi = qn, qn = SC_GRAB()) {
        asm volatile("" : "+v"(lane));
        const int tau = lane & 15, g = lane >> 4;
        const int q = q0 + qi;
        const int row = scan_row(b, z, (lo + q) * 16 + tau);
        unsigned char* blk = wbuf + ((size_t)chain * SC_WQ + q) * SCAN_BLK;
        v2u r2[4], k2[4], v2[4]; bf16x8 bw[3], ba[3];
#pragma unroll
        for (int mt = 0; mt < 4; ++mt) { r2[mt] = r2n[mt]; k2[mt] = k2n[mt]; v2[mt] = v2n[mt]; }
#pragma unroll
        for (int ks = 0; ks < 3; ++ks) { bw[ks] = bwn[ks]; ba[ks] = ban[ks]; }
        if (qn < nhalf) SC_LOADS(q0 + qn);
        f32x4 lw[4], la[4];
#pragma unroll
        for (int mt = 0; mt < 4; ++mt) { lw[mt] = (f32x4){0.f, 0.f, 0.f, 0.f}; la[mt] = lw[mt]; }
        {
            bf16x8 wf[12];
#pragma unroll
            for (int f_ = 0; f_ < 12; ++f_) wf[f_] = *(const LAS bf16x8*)(F.lds + SC_WF + (f_ * 64 + lane) * 16);
            asm volatile("" : "+v"(wf[0]), "+v"(wf[1]), "+v"(wf[2]), "+v"(wf[3]), "+v"(wf[4]), "+v"(wf[5]), "+v"(wf[6]), "+v"(wf[7]), "+v"(wf[8]), "+v"(wf[9]), "+v"(wf[10]), "+v"(wf[11]));
            bf16x8 af[12];
#pragma unroll
            for (int f_ = 0; f_ < 12; ++f_) af[f_] = *(const LAS bf16x8*)(F.lds + SC_WF + ((12 + f_) * 64 + lane) * 16);
#pragma unroll
            for (int ks = 0; ks < 3; ++ks)
#pragma unroll
                for (int mt = 0; mt < 4; ++mt) lw[mt] = MFMA16(wf[ks * 4 + mt], bw[ks], lw[mt]);
            asm volatile("" : "+v"(af[0]), "+v"(af[1]), "+v"(af[2]), "+v"(af[3]), "+v"(af[4]), "+v"(af[5]), "+v"(af[6]), "+v"(af[7]), "+v"(af[8]), "+v"(af[9]), "+v"(af[10]), "+v"(af[11]));
#pragma unroll
            for (int ks = 0; ks < 3; ++ks)
#pragma unroll
                for (int mt = 0; mt < 4; ++mt) la[mt] = MFMA16(af[ks * 4 + mt], ba[ks], la[mt]);
        }
        LAS unsigned char* Xs = scr; LAS unsigned char* Ys = scr + 4096;
        LAS bf16* BKs = (LAS bf16*)(scr + 8192); LAS bf16* VFs = (LAS bf16*)(scr + 8192 + 4096); LAS float* PCs = (LAS float*)(scr + 8192 + 6144);
        float lnw[16], asg[16], kk[16], kd[16]; float ss = 0.f, sap = 0.f;
        f32x4 cw0[4], ca0[4], ckk[4], cka[4], crk[4];
#pragma unroll
        for (int mt = 0; mt < 4; ++mt) { const LAS float* cst = (const LAS float*)(F.lds + SC_CONST) + 16 * mt + 4 * g;
            cw0[mt] = *(const LAS f32x4*)(cst); ca0[mt] = *(const LAS f32x4*)(cst + 64); ckk[mt] = *(const LAS f32x4*)(cst + 128); cka[mt] = *(const LAS f32x4*)(cst + 192); crk[mt] = *(const LAS f32x4*)(cst + 256); }
        asm volatile("" : "+v"(cw0[0]), "+v"(cw0[1]), "+v"(cw0[2]), "+v"(cw0[3]), "+v"(ca0[0]), "+v"(ca0[1]), "+v"(ca0[2]), "+v"(ca0[3]), "+v"(ckk[0]), "+v"(ckk[1]), "+v"(ckk[2]), "+v"(ckk[3]), "+v"(cka[0]), "+v"(cka[1]), "+v"(cka[2]), "+v"(cka[3]), "+v"(crk[0]), "+v"(crk[1]), "+v"(crk[2]), "+v"(crk[3]));
#pragma unroll
        for (int mt = 0; mt < 4; ++mt) {
            const f32x4 w0 = cw0[mt], a0 = ca0[mt], kkc = ckk[mt], kac = cka[mt], rkc = crk[mt];
            const float rv[4] = {bflo(r2[mt].x), bfhi(r2[mt].x), bflo(r2[mt].y), bfhi(r2[mt].y)}, kv[4] = {bflo(k2[mt].x), bfhi(k2[mt].x), bflo(k2[mt].y), bfhi(k2[mt].y)};
#pragma unroll
            for (int e = 0; e < 4; ++e) { const int i = 4 * mt + e;
                lnw[i] = -0.6065306597126334f * sigmoidf_(w0[e] + lw[mt][e]);
                asg[i] = sigmoidf_(a0[e] + la[mt][e]);
                const float kr = kv[e] * kkc[e]; kk[i] = kr; ss += kr * kr;
                kd[i] = kv[e] * (1.f + (asg[i] - 1.f) * kac[e]);
                sap += rv[e] * rkc[e] * kv[e] * kac[e] * asg[i]; } }
        ss += __shfl_xor(ss, 16); ss += __shfl_xor(ss, 32); sap += __shfl_xor(sap, 16); sap += __shfl_xor(sap, 32);
        const float inv = __builtin_amdgcn_rsqf(fmaxf(ss, 1e-24f));
        if (g == 0) SA[((size_t)z * MT + row) * 32 + h] = sap;
        float ec_[16], eC_[16];
#pragma unroll
        for (int i = 0; i < 16; ++i) { float c = lnw[i]; c += dpp_row_shr<1>(c); c += dpp_row_shr<2>(c); c += dpp_row_shr<4>(c); c += dpp_row_shr<8>(c); ec_[i] = __expf(c); }
#pragma unroll
        for (int i = 0; i < 16; ++i) eC_[i] = __shfl(ec_[i], (lane & 48) | 15);
        { const int hh0 = (tau >> 2) & 1, jj0 = 4 * (tau >> 3) + (tau & 3), hh1 = tau >> 3, jj1 = tau & 7;
          LAS bf16* bkb0 = BKs + (4 * g + 32 * hh0) * 8 + jj0; LAS bf16* bkb1 = BKs + 512 + (4 * g + 32 * hh1) * 8 + jj1; LAS bf16* vfb = VFs + (4 * g + 32 * hh1) * 8 + jj1;
#pragma unroll
          for (int mt = 0; mt < 4; ++mt) {
            float at[4], rt[4], bt[4], kt[4];
            const float rv[4] = {bflo(r2[mt].x), bfhi(r2[mt].x), bflo(r2[mt].y), bfhi(r2[mt].y)};
            const unsigned short vraw[4] = {(unsigned short)(v2[mt].x & 0xffffu), (unsigned short)(v2[mt].x >> 16), (unsigned short)(v2[mt].y & 0xffffu), (unsigned short)(v2[mt].y >> 16)};
#pragma unroll
            for (int e = 0; e < 4; ++e) { const int i = 4 * mt + e;
                const float ec = ec_[i], en = __builtin_amdgcn_rcpf(ec);
                const float eprev = __int_as_float(__builtin_amdgcn_update_dpp(0x3f800000, __float_as_int(ec), 0x111, 0xf, 0xf, false));
                const float er = eC_[i] * en;
                const float kki = kk[i] * inv, bb = kki * asg[i];
                at[e] = -kki * eprev; rt[e] = rv[e] * ec; bt[e] = bb * en; kt[e] = kd[i] * en;
                const int eo = ((mt >> 1) * 2) * 512 + (16 * (mt & 1) + e) * 8;
                const unsigned wbk = pk2(bb * er, kd[i] * er);
                bkb0[eo] = (bf16)(wbk & 0xffffu); bkb1[eo] = (bf16)(wbk >> 16);
                vfb[(mt >> 1) * 512 + (16 * (mt & 1) + e) * 8] = vraw[e]; }
            const int jb = (4 * (g >> 1)) * 2, cb = (((2 * mt + (g >> 1)) ^ (tau & 7)) << 4) + 8 * (g & 1);
            v2u wa; wa.x = pk2(at[0], at[1]); wa.y = pk2(at[2], at[3]);
            v2u wq; wq.x = pk2(rt[0], rt[1]); wq.y = pk2(rt[2], rt[3]);
            v2u wb; wb.x = pk2(bt[0], bt[1]); wb.y = pk2(bt[2], bt[3]);
            v2u wk; wk.x = pk2(kt[0], kt[1]); wk.y = pk2(kt[2], kt[3]);
            *(v2u*)(blk + BLK_AR + (mt * 64 + tau + 32 * (g & 1)) * 16 + jb) = wa;
            *(v2u*)(blk + BLK_AR + (mt * 64 + 16 + tau + 32 * (g & 1)) * 16 + jb) = wq;
            *(LAS v2u*)(Xs + tau * 128 + cb) = wa; *(LAS v2u*)(Xs + (16 + tau) * 128 + cb) = wq;
            *(LAS v2u*)(Ys + tau * 128 + cb) = wb; *(LAS v2u*)(Ys + (16 + tau) * 128 + cb) = wk;
          }
          if (tau == 0) {
#pragma unroll
              for (int i = 0; i < 16; ++i) { const int j = 16 * (i >> 2) + 4 * g + (i & 3), mtp = j >> 5, jl = j & 31, hq = (jl >> 2) & 1, qq = (jl & 3) + 4 * (jl >> 3); PCs[(hq * 2 + mtp) * 16 + qq] = eC_[i]; } }
        }
        LDS_WAIT();
        f32x16 dm;
#pragma unroll
        for (int i = 0; i < 16; ++i) dm[i] = 0.f;
        { const int r31 = lane & 31, hh = lane >> 5;
#pragma unroll
          for (int ks = 0; ks < 4; ++ks) { const int co = ((2 * ks + hh) ^ (r31 & 7)) << 4; const bf16x8 xa = *(const LAS bf16x8*)(Xs + r31 * 128 + co), yb = *(const LAS bf16x8*)(Ys + r31 * 128 + co); dm = MFMA32(xa, yb, dm); }
          LDS_WAIT();
          LAS float* Dm = (LAS float*)scr;
#pragma unroll
          for (int q_ = 0; q_ < 16; ++q_) Dm[((q_ & 3) + 8 * (q_ >> 2) + 4 * hh) * 36 + r31] = dm[q_];
        }
        LDS_WAIT();
        float xs[16], os[16];
        { const LAS float* Dm = (const LAS float*)scr; const int c = lane & 31, cc = (c - 16) & 15; const bool lo16 = c < 16;
          float ak[16], rk[16];
#pragma unroll
          for (int t = 0; t < 16; ++t) { ak[t] = Dm[t * 36 + 16 + cc]; rk[t] = Dm[(16 + t) * 36 + 16 + cc]; }
          asm volatile("" : "+v"(ak[0]), "+v"(ak[1]), "+v"(ak[2]), "+v"(ak[3]), "+v"(ak[4]), "+v"(ak[5]), "+v"(ak[6]), "+v"(ak[7]), "+v"(ak[8]), "+v"(ak[9]), "+v"(ak[10]), "+v"(ak[11]), "+v"(ak[12]), "+v"(ak[13]), "+v"(ak[14]), "+v"(ak[15]));
          asm volatile("" : "+v"(rk[0]), "+v"(rk[1]), "+v"(rk[2]), "+v"(rk[3]), "+v"(rk[4]), "+v"(rk[5]), "+v"(rk[6]), "+v"(rk[7]), "+v"(rk[8]), "+v"(rk[9]), "+v"(rk[10]), "+v"(rk[11]), "+v"(rk[12]), "+v"(rk[13]), "+v"(rk[14]), "+v"(rk[15]) :: "memory");
#pragma unroll
          for (int t = 0; t < 16; ++t) { const float one = (t == c) ? 1.f : 0.f, akm = (cc < t) ? ak[t] : 0.f, rkm = (cc <= t) ? rk[t] : 0.f; xs[t] = lo16 ? one : akm; os[t] = lo16 ? 0.f : rkm; }
#pragma unroll
          for (int tb = 0; tb < 4; ++tb) {
              f32x4 ar[4][4];
#pragma unroll
              for (int r = 0; r < 4; ++r)
#pragma unroll
                  for (int u4 = 0; u4 <= tb; ++u4) ar[r][u4] = *(const LAS f32x4*)(Dm + (4 * tb + r) * 36 + 4 * u4);
#pragma unroll
              for (int r = 0; r < 4; ++r) { if (tb == 0) asm volatile("" : "+v"(ar[r][0]) :: "memory"); else if (tb == 1) asm volatile("" : "+v"(ar[r][0]), "+v"(ar[r][1]) :: "memory"); else if (tb == 2) asm volatile("" : "+v"(ar[r][0]), "+v"(ar[r][1]), "+v"(ar[r][2]) :: "memory"); else asm volatile("" : "+v"(ar[r][0]), "+v"(ar[r][1]), "+v"(ar[r][2]), "+v"(ar[r][3]) :: "memory"); }
#pragma unroll
              for (int r = 0; r < 4; ++r) { const int t = 4 * tb + r;
#pragma unroll
                  for (int tau_ = 0; tau_ < t; ++tau_) xs[t] += ar[r][tau_ >> 2][tau_ & 3] * xs[tau_]; }
              asm volatile("" : "+v"(xs[4 * tb]), "+v"(xs[4 * tb + 1]), "+v"(xs[4 * tb + 2]), "+v"(xs[4 * tb + 3]) :: "memory");
          }
#pragma unroll
          for (int tb = 0; tb < 4; ++tb) {
              f32x4 ar[4][4];
#pragma unroll
              for (int r = 0; r < 4; ++r)
#pragma unroll
                  for (int u4 = 0; u4 <= tb; ++u4) ar[r][u4] = *(const LAS f32x4*)(Dm + (16 + 4 * tb + r) * 36 + 4 * u4);
#pragma unroll
              for (int r = 0; r < 4; ++r) { if (tb == 0) asm volatile("" : "+v"(ar[r][0]) :: "memory"); else if (tb == 1) asm volatile("" : "+v"(ar[r][0]), "+v"(ar[r][1]) :: "memory"); else if (tb == 2) asm volatile("" : "+v"(ar[r][0]), "+v"(ar[r][1]), "+v"(ar[r][2]) :: "memory"); else asm volatile("" : "+v"(ar[r][0]), "+v"(ar[r][1]), "+v"(ar[r][2]), "+v"(ar[r][3]) :: "memory"); }
#pragma unroll
              for (int r = 0; r < 4; ++r) { const int t = 4 * tb + r;
#pragma unroll
                  for (int tau_ = 0; tau_ <= t; ++tau_) os[t] += ar[r][tau_ >> 2][tau_ & 3] * xs[tau_]; }
              asm volatile("" : "+v"(os[4 * tb]), "+v"(os[4 * tb + 1]), "+v"(os[4 * tb + 2]), "+v"(os[4 * tb + 3]) :: "memory");
          }
        }
        LDS_WAIT();
        { LAS bf16* Gs = (LAS bf16*)(scr + 4608);
          if (lane < 32) { const int c = lane;
              int ks, hh, jj; if (c < 16) { ks = 0; hh = (c >> 2) & 1; jj = 4 * (c >> 3) + (c & 3); } else { ks = 2; hh = (c - 16) >> 3; jj = (c - 16) & 7; }
#pragma unroll
              for (int t = 0; t < 16; ++t) { Gs[(ks * 64 + t + 32 * hh) * 8 + jj] = (bf16)(pk2(xs[t], 0.f) & 0xffffu); Gs[(ks * 64 + 16 + t + 32 * hh) * 8 + jj] = (bf16)(pk2(os[t], 0.f) & 0xffffu); } }
        }
        LDS_WAIT();
        { v4u cg[2], cbk[7];
          cg[0] = *(const LAS v4u*)(scr + 4608 + lane * 16); cg[1] = *(const LAS v4u*)(scr + 4608 + (2 * 64 + lane) * 16);
#pragma unroll
          for (int i = 0; i < 6; ++i) cbk[i] = *(const LAS v4u*)(scr + 8192 + (i * 64 + lane) * 16);
          cbk[6] = *(const LAS v4u*)(scr + 8192 + (6 * 64 + (lane & 15)) * 16);
          asm volatile("" : "+v"(cg[0]), "+v"(cg[1]), "+v"(cbk[0]), "+v"(cbk[1]), "+v"(cbk[2]), "+v"(cbk[3]), "+v"(cbk[4]), "+v"(cbk[5]), "+v"(cbk[6]));
#pragma unroll
          for (int i = 0; i < 2; ++i) *(v4u*)(blk + BLK_G + (i * 64 + lane) * 16) = cg[i];
#pragma unroll
          for (int i = 0; i < 6; ++i) *(v4u*)(blk + BLK_BK + (i * 64 + lane) * 16) = cbk[i];
          if (lane < 16) *(v4u*)(blk + BLK_BK + (6 * 64 + lane) * 16) = cbk[6]; }
    }
#undef SC_LOADS
#undef SC_GRAB
}

__device__ __forceinline__ void scan_consume(const Frame& F, int w  , int lane, int ih) {
    const int nq = win_n(w), lo = win_lo(w);
    const unsigned char* wbuf = F.ws + WS_ACT + ACT_WBUF + (size_t)(w & 1) * WBUF_STRIDE;
    float* SST = (float*)(F.ws + WS_SST);
    const int r31 = lane & 31, hh = lane >> 5;
    for (int p = blockIdx.x; p < 256; p += 256) {
        const int chain = sc_chain(p), b = chain >> 6, h = (chain >> 1) & 31, z = chain & 1; const int sp_ = chain * 2 + ih;
        bf16* YB = (bf16*)(F.ws + WS_ACT + (z ? ACT_YB1 : ACT_YB0));
        f32x16 st0, st1;
        if (w == 0) {
#pragma unroll
            for (int i = 0; i < 16; ++i) { st0[i] = 0.f; st1[i] = 0.f; } }
        else {
#pragma unroll
            for (int i = 0; i < 16; ++i) { st0[i] = SST[((size_t)sp_ * 32 + i) * 64 + lane]; st1[i] = SST[((size_t)sp_ * 32 + 16 + i) * 64 + lane]; } }
        volatile LAS unsigned* ctl = (volatile LAS unsigned*)(F.lds + SC_CTL);
        bf16x8 gmid;
        { unsigned e8[8];
#pragma unroll
          for (int jj = 0; jj < 8; ++jj) { const int pi = 8 * (jj >> 2) + 4 * hh + (jj & 3); e8[jj] = (r31 >= 16 && r31 - 16 == pi) ? 0x3f80u : 0u; }
          v4u m_; m_.x = e8[0] | (e8[1] << 16); m_.y = e8[2] | (e8[3] << 16); m_.z = e8[4] | (e8[5] << 16); m_.w = e8[6] | (e8[7] << 16); gmid = __builtin_bit_cast(bf16x8, m_); }
        unsigned yoff[8];
#pragma unroll
        for (int q_ = 8; q_ < 16; ++q_) { const int t = (q_ & 3) + 8 * ((q_ >> 2) & 1) + 4 * hh; yoff[q_ - 8] = (unsigned)((z ? 15 - t : t) * D + h * 64 + 32 * ih + r31) * 2u; }
#pragma unroll 1
        for (int q = 0; q < nq; ++q) {
            { unsigned sp = 0; _Pragma("unroll 1") while ((int)ctl[0] <= q) { __builtin_amdgcn_s_sleep(1); if (++sp > (1u << 24)) break; } }
            asm volatile("" ::: "memory");
            const LAS unsigned char* sl = F.lds + SC_RING + (q % SC_NSLOT) * SC_SLOT;
            bf16x8 arf[4], gf[3], bkf[2][2], vf; f32x4 pc[8];
#pragma unroll
            for (int ks = 0; ks < 4; ++ks) arf[ks] = *(const LAS bf16x8*)(sl + BLK_AR + (ks * 64 + lane) * 16);
            gf[0] = *(const LAS bf16x8*)(sl + BLK_G + lane * 16); gf[2] = *(const LAS bf16x8*)(sl + BLK_G + (64 + lane) * 16); gf[1] = gmid;
#pragma unroll
            for (int mj = 0; mj < 2; ++mj)
#pragma unroll
                for (int ks = 0; ks < 2; ++ks) bkf[mj][ks] = *(const LAS bf16x8*)(sl + BLK_BK + ((mj * 2 + ks) * 64 + lane) * 16);
            vf = *(const LAS bf16x8*)(sl + BLK_VF + (ih * 64 + lane) * 16);
#pragma unroll
            for (int i = 0; i < 8; ++i) pc[i] = *(const LAS f32x4*)(sl + BLK_PCF + hh * 128 + i * 16);
            LDS_WAIT();
            asm volatile("" ::: "memory"); if (lane == 0) ctl[ih ? 4 : 1] = (unsigned)(q + 1);
            const bf16x8 s0 = pack_frag(st0[0], st0[1], st0[2], st0[3], st0[4], st0[5], st0[6], st0[7]), s1 = pack_frag(st0[8], st0[9], st0[10], st0[11], st0[12], st0[13], st0[14], st0[15]);
            const bf16x8 s2 = pack_frag(st1[0], st1[1], st1[2], st1[3], st1[4], st1[5], st1[6], st1[7]), s3 = pack_frag(st1[8], st1[9], st1[10], st1[11], st1[12], st1[13], st1[14], st1[15]);
            const f32x16 zero16 = {0.f, 0.f, 0.f, 0.f, 0.f, 0.f, 0.f, 0.f, 0.f, 0.f, 0.f, 0.f, 0.f, 0.f, 0.f, 0.f};
            f32x16 zz = MFMA32(arf[0], s0, zero16);
            zz = MFMA32(arf[1], s1, zz);
            zz = MFMA32(arf[2], s2, zz);
            zz = MFMA32(arf[3], s3, zz);
#pragma unroll
            for (int i = 0; i < 16; ++i) { st0[i] *= pc[i >> 2][i & 3]; st1[i] *= pc[4 + (i >> 2)][i & 3]; }
            f32x16 oo = MFMA32(gf[2], vf, zero16);
            oo = MFMA32(gf[0], pack_frag(zz[0], zz[1], zz[2], zz[3], zz[4], zz[5], zz[6], zz[7]), oo);
            oo = MFMA32(gf[1], pack_frag(zz[8], zz[9], zz[10], zz[11], zz[12], zz[13], zz[14], zz[15]), oo);
            st0 = MFMA32(bkf[0][1], vf, st0); st1 = MFMA32(bkf[1][1], vf, st1);
            const bf16x8 uf = pack_frag(oo[0], oo[1], oo[2], oo[3], oo[4], oo[5], oo[6], oo[7]);
            st0 = MFMA32(bkf[0][0], uf, st0); st1 = MFMA32(bkf[1][0], uf, st1);
            if (w > 0) {
                const int sp0 = (lo + q) * 16 - CTXL;
                const int rlow = __builtin_amdgcn_readfirstlane(b * SEQ + (z ? SEQ - 1 - sp0 - 15 : sp0));
                char* yb = (char*)YB + (size_t)rlow * (D * 2);
#pragma unroll
                for (int q_ = 8; q_ < 16; ++q_) *(bf16*)(yb + yoff[q_ - 8]) = (bf16)(pk2(oo[q_], 0.f) & 0xffffu); }
        }
#pragma unroll
        for (int i = 0; i < 16; ++i) { SST[((size_t)sp_ * 32 + i) * 64 + lane] = st0[i]; SST[((size_t)sp_ * 32 + 16 + i) * 64 + lane] = st1[i]; }
    }
}
__device__ __forceinline__ void scan_loader(const Frame& F, int w, int lane) {
    const int nq = win_n(w);
    const int p = blockIdx.x; if (p >= 256) return;
    const unsigned char* cbase = F.ws + WS_ACT + ACT_WBUF + (size_t)(w & 1) * WBUF_STRIDE + (size_t)sc_chain(p) * SC_WQ * SCAN_BLK + lane * 16;
    volatile LAS unsigned* ctl = (volatile LAS unsigned*)(F.lds + SC_CTL);
#pragma unroll 1
    for (int q = 0; q < nq; ++q) {
        { unsigned sp = 0; while (q - (int)ctl[1] >= SC_NSLOT || q - (int)ctl[4] >= SC_NSLOT) { __builtin_amdgcn_s_sleep(1); if (++sp > (1u << 24)) break; } }
        asm volatile("" ::: "memory");
        const unsigned char* src = cbase + (size_t)q * SCAN_BLK; LAS unsigned char* dst = F.lds + SC_RING + (q % SC_NSLOT) * SC_SLOT;
#pragma unroll
        for (int i_ = 0; i_ < 12; ++i_) __builtin_amdgcn_global_load_lds((const unsigned*)(src + i_ * 1024), (LAS unsigned*)(dst + i_ * 1024), 16, 0, 0);
        if (lane < 16) __builtin_amdgcn_global_load_lds((const unsigned*)(src + BLK_PCF), (LAS unsigned*)(dst + BLK_PCF), 16, 0, 0);
        asm volatile("s_waitcnt vmcnt(26)" ::: "memory");
        if (lane == 0 && q >= 1) ctl[0] = (unsigned)(q - 1);
    }
    asm volatile("s_waitcnt vmcnt(0)" ::: "memory");
    if (lane == 0) ctl[0] = (unsigned)nq;
}
__device__ __forceinline__ void phase_scan_step(Frame& F, const Args& AR, int w) {
    int tid_ = threadIdx.x; asm volatile("" : "+v"(tid_)); const int LANE = tid_ & 63, WAVE = __builtin_amdgcn_readfirstlane(tid_ >> 6);
    if (w == 0) scan_setup(F, AR, tid_);
    const bool isA = sc_half(blockIdx.x) == 0;
    if (tid_ < 8) ((volatile LAS unsigned*)(F.lds + SC_CTL))[tid_] = tid_ == 2 ? (unsigned)(isA ? SC_NPROD_A : SC_NPROD_B) : 0u;
    __syncthreads();
    if (isA) {
        if (WAVE <= 1) { if (w >= 1) scan_consume(F, w - 1, LANE, WAVE); }
        else if (WAVE == 2) { if (w >= 1) scan_loader(F, w - 1, LANE); }
        else { if (w < SCAN_NW) scan_produce(F, w, WAVE - 3, LANE, true); }
    } else { if (w < SCAN_NW) scan_produce(F, w, WAVE, LANE, false); }
}
__device__ __forceinline__ void phase_combine(Frame& F, const Args& AR, bf16* PO) {
    int tid_ = threadIdx.x; asm volatile("" : "+v"(tid_)); const int TID = tid_, LANE = tid_ & 63, WAVE = __builtin_amdgcn_readfirstlane(tid_ >> 6);
    const bf16* RKV = (const bf16*)(F.ws + WS_ACT + ACT_XM + 3 * XM_STRIDE);
    const bf16* YB0 = (const bf16*)(F.ws + WS_ACT + ACT_YB0); const bf16* YB1 = (const bf16*)(F.ws + WS_ACT + ACT_YB1);
    const float* SA = (const float*)(F.ws + WS_SA);
    LAS float* TC = (LAS float*)F.lds;
    for (int i = TID; i < D / 4; i += NWAVES * 64) { const f32x4 rk = *(const f32x4*)(AR.in[23] + 4 * i), ka = *(const f32x4*)(AR.in[22] + 4 * i);
        *(LAS f32x4*)(TC + 4 * i) = rk * (1.f - ka); *(LAS f32x4*)(TC + D + 4 * i) = *(const f32x4*)(AR.in[24] + 4 * i); *(LAS f32x4*)(TC + 2 * D + 4 * i) = *(const f32x4*)(AR.in[25] + 4 * i); }
    __syncthreads();
    const int gw = F.vcu * NWAVES + WAVE, NGW = F.G * NWAVES;
    for (int r = gw; r < ML; r += NGW) {
        v4u ya[4], yb[4], rq[4], kq[4], vq[4];
#pragma unroll
        for (int c = 0; c < 4; ++c) { const size_t o = (size_t)r * D + 512 * c + 8 * LANE;
            ya[c] = *(const v4u*)(YB0 + o); yb[c] = *(const v4u*)(YB1 + o); rq[c] = *(const v4u*)(RKV + o); kq[c] = *(const v4u*)(RKV + (size_t)MT * D + o); vq[c] = *(const v4u*)(RKV + 2 * (size_t)MT * D + o); }
#pragma unroll
        for (int c = 0; c < 4; ++c) { const int d = 512 * c + 8 * LANE, hd = d >> 6;
            const unsigned aw[4] = {ya[c].x, ya[c].y, ya[c].z, ya[c].w}, bw[4] = {yb[c].x, yb[c].y, yb[c].z, yb[c].w}, rw[4] = {rq[c].x, rq[c].y, rq[c].z, rq[c].w}, kw[4] = {kq[c].x, kq[c].y, kq[c].z, kq[c].w}, vw[4] = {vq[c].x, vq[c].y, vq[c].z, vq[c].w};
            float y[8]; float sum = 0.f, s0 = 0.f;
            const f32x4 t0 = *(const LAS f32x4*)(TC + d), t1 = *(const LAS f32x4*)(TC + d + 4); const float tk[8] = {t0.x, t0.y, t0.z, t0.w, t1.x, t1.y, t1.z, t1.w};
#pragma unroll
            for (int e = 0; e < 4; ++e) { y[2 * e] = bflo(aw[e]) + bflo(bw[e]); y[2 * e + 1] = bfhi(aw[e]) + bfhi(bw[e]); sum += y[2 * e] + y[2 * e + 1];
                s0 += bflo(rw[e]) * bflo(kw[e]) * tk[2 * e] + bfhi(rw[e]) * bfhi(kw[e]) * tk[2 * e + 1]; }
            sum += __shfl_xor(sum, 1); sum += __shfl_xor(sum, 2); sum += __shfl_xor(sum, 4);
            s0 += __shfl_xor(s0, 1); s0 += __shfl_xor(s0, 2); s0 += __shfl_xor(s0, 4);
            const float mean = sum * (1.f / 64.f); float vs = 0.f;
#pragma unroll
            for (int i = 0; i < 8; ++i) { const float dl = y[i] - mean; vs += dl * dl; }
            vs += __shfl_xor(vs, 1); vs += __shfl_xor(vs, 2); vs += __shfl_xor(vs, 4);
            const float rstd = 1.0f / sqrtf(vs * (1.f / 64.f) + GN_EPS);
            const float sb = s0 + 0.5f * (SA[(size_t)r * 32 + hd] + SA[((size_t)MT + r) * 32 + hd]);
            const f32x4 l0 = *(const LAS f32x4*)(TC + D + d), l1 = *(const LAS f32x4*)(TC + D + d + 4), b0 = *(const LAS f32x4*)(TC + 2 * D + d), b1 = *(const LAS f32x4*)(TC + 2 * D + d + 4);
            const float lw_[8] = {l0.x, l0.y, l0.z, l0.w, l1.x, l1.y, l1.z, l1.w}, lb_[8] = {b0.x, b0.y, b0.z, b0.w, b1.x, b1.y, b1.z, b1.w};
            float o[8];
#pragma unroll
            for (int e = 0; e < 4; ++e) { o[2 * e] = (y[2 * e] - mean) * rstd * lw_[2 * e] + lb_[2 * e] + sb * bflo(vw[e]); o[2 * e + 1] = (y[2 * e + 1] - mean) * rstd * lw_[2 * e + 1] + lb_[2 * e + 1] + sb * bfhi(vw[e]); }
            v4u w_; w_.x = pk2(o[0], o[1]); w_.y = pk2(o[2], o[3]); w_.z = pk2(o[4], o[5]); w_.w = pk2(o[6], o[7]);
            *(v4u*)(PO + (size_t)r * D + d) = w_; }
    }
}

template <class RowMap, bool BLK = false>
__device__ __forceinline__ void transpose_item(const float* W, int K, int N, bf16* WT, const RowMap& rm, LAS float* scr, int item, int lane) {
    const int nblk = N / 32, kb = item / nblk, nb = item % nblk, k0 = 64 * kb, n0 = 32 * nb;
#pragma unroll 8
    for (int i = 0; i < 32; ++i) { const int kk = 2 * i + (lane >> 5); scr[kk * 33 + (lane & 31)] = W[(size_t)(k0 + kk) * N + n0 + (lane & 31)]; }
    LDS_WAIT(); asm volatile("" ::: "memory");
    const int c = lane & 7;
#pragma unroll
    for (int j = 0; j < 4; ++j) { const int n = (lane >> 3) + 8 * j; const LAS float* s = scr + (8 * c) * 33 + n;
        v4u o; o.x = pk2(s[0 * 33], s[1 * 33]); o.y = pk2(s[2 * 33], s[3 * 33]); o.z = pk2(s[4 * 33], s[5 * 33]); o.w = pk2(s[6 * 33], s[7 * 33]);
        const int nr = rm(n0 + n);
        if (BLK) *(v4u*)(WT + ((size_t)(nr >> 8) * (K / 64) + (k0 >> 6)) * 16384 + (size_t)(nr & 255) * 64 + 8 * c) = o;
        else *(v4u*)(WT + (size_t)nr * K + k0 + 8 * c) = o; }
    LDS_WAIT(); asm volatile("" ::: "memory");
}
struct RmId { __device__ __forceinline__ int operator()(int n) const { return n; } };
struct RmW13 { __device__ __forceinline__ int operator()(int n) const { const int bj = n >= DFF ? 1 : 0, j = n - bj * DFF; return 256 * (j >> 7) + 128 * bj + (j & 127); } };

__device__ __forceinline__ void p0_prologue(Frame& F, const Args& AR) {
    int tid_ = threadIdx.x; asm volatile("" : "+v"(tid_)); const int TID = tid_, LANE = tid_ & 63, WAVE = __builtin_amdgcn_readfirstlane(tid_ >> 6);
    const float* x_c = AR.in[1]; const float* c_ctx = AR.in[3]; const float* mod_w = AR.in[4];
    for (int i = blockIdx.x * (NWAVES * 64) + TID; i < 6 * 262144 / 4; i += F.G * NWAVES * 64) ((f32x4*)(F.ws + WS_PS))[i] = (f32x4){0.f, 0.f, 0.f, 0.f};
    {
        LAS float* sil = (LAS float*)(F.lds);
        LAS f32x4* red = (LAS f32x4*)(F.lds + 24576);
        for (int i = TID; i < 3 * D; i += NWAVES * 64) { const int who = i / D, k = i % D; const float v = who < 2 ? x_c[who * D + k] : c_ctx[k]; sil[i] = v * sigmoidf_(v); }
        __syncthreads();
        for (int t = blockIdx.x; t < 576; t += F.G) {
            const int q = t & 3, cb = (t >> 2) % 72, layer = t / 288;
            const int r0 = q * 512 + WAVE * 64;
            const float* wp = mod_w + ((size_t)layer * D + r0) * NMODV + cb * 256 + LANE * 4;
            f32x4 a0 = {0.f, 0.f, 0.f, 0.f}, a1 = a0, a2 = a0;
#pragma unroll 8
            for (int r = 0; r < 64; ++r) { const f32x4 w = *(const f32x4*)(wp + (size_t)r * NMODV); a0 += w * sil[r0 + r]; a1 += w * sil[D + r0 + r]; a2 += w * sil[2 * D + r0 + r]; }
            red[(WAVE * 3 + 0) * 64 + LANE] = a0; red[(WAVE * 3 + 1) * 64 + LANE] = a1; red[(WAVE * 3 + 2) * 64 + LANE] = a2;
            __syncthreads();
            if (WAVE < 3) { f32x4 s = {0.f, 0.f, 0.f, 0.f};
#pragma unroll
                for (int w = 0; w < 8; ++w) s += red[(w * 3 + WAVE) * 64 + LANE];
                *(f32x4*)((float*)(F.ws + WS_MODP) + ((size_t)(q * 2 + layer) * 3 + WAVE) * NMODV + cb * 256 + LANE * 4) = s; }
            __syncthreads();
        }
    }
    LAS float* scr = (LAS float*)(F.lds + WAVE * 16384);
    const int gw = F.vcu * NWAVES + WAVE, NGW = F.G * NWAVES;
    {
        constexpr int I13 = (D / 64) * (2 * DFF / 32), I2 = (DFF / 64) * (D / 32), IDD = (D / 64) * (D / 32);
        constexpr int NIT = 4 * I13 + 4 * I2 + 5 * IDD + 2 * (D / 64) * (256 / 32) / 1;
        for (int it = gw; it < NIT; it += NGW) {
            int r = it;
            if (r < 4 * I13) { const int lf = r / I13; r -= lf * I13; const int l = lf >> 1, f = lf & 1;
                transpose_item<RmW13, true>(AR.in[7] + (size_t)lf * D * 2 * DFF, D, 2 * DFF, (bf16*)(F.ws + (l ? WS_WL1 : WS_WL0) + (size_t)f * 44 * MiB), RmW13(), scr, r, LANE); continue; }
            r -= 4 * I13;
            if (r < 4 * I2) { const int lf = r / I2; r -= lf * I2; const int l = lf >> 1, f = lf & 1;
                transpose_item<RmId, true>(AR.in[8] + (size_t)lf * DFF * D, DFF, D, (bf16*)(F.ws + (l ? WS_WL1 : WS_WL0) + 88 * MiB + (size_t)f * 22 * MiB), RmId(), scr, r, LANE); continue; }
            r -= 4 * I2;
            if (r < IDD) { transpose_item(AR.in[9], D, D, (bf16*)(F.ws + WS_WFO), RmId(), scr, r, LANE); continue; }
            r -= IDD;
            if (r < 3 * IDD) { const int p = r / IDD; r -= p * IDD; transpose_item(AR.in[12] + (size_t)p * D * D, D, D, (bf16*)(F.ws + WS_WRKV + (size_t)p * 8 * MiB), RmId(), scr, r, LANE); continue; }
            r -= 3 * IDD;
            if (r < IDD) { transpose_item(AR.in[26], D, D, (bf16*)(F.ws + WS_WRO), RmId(), scr, r, LANE); continue; }
            r -= IDD;
            if (r < 256) { transpose_item(AR.in[19], D, 256, (bf16*)(F.ws + WS_WSMALL + WSM_G1T), RmId(), scr, r, LANE); continue; }
            r -= 256;
            transpose_item(AR.in[20], 256, D, (bf16*)(F.ws + WS_WSMALL + WSM_G2T), RmId(), scr, r, LANE);
        }
    }
    {
        const int gt = (F.vcu * NWAVES + WAVE) * 64 + LANE, NGT = F.G * NWAVES * 64;
        for (int i = gt; i < 2 * 256 * D; i += NGT) { const int which = i / (256 * D), rr = (i / D) % 256, k = i % D;
            float v = 0.f; if (rr < 192) { const int z = rr / 96, r = rr % 96; v = AR.in[which ? 17 : 14][((size_t)z * D + k) * LORA + r]; }
            ((bf16*)(F.ws + WS_WSMALL + (which ? WSM_A1CAT : WSM_W1CAT)))[(size_t)rr * D + k] = (bf16)(pk2(v, 0.f) & 0xffffu); }
        for (int i = gt; i < 2 * 2 * D * LORA; i += NGT) { const int which = i / (2 * D * LORA), j = i % (2 * D * LORA), z = j / (D * LORA), n = (j / LORA) % D, r = j % LORA;
            const float v = AR.in[which ? 18 : 15][((size_t)z * LORA + r) * D + n];
            ((bf16*)(F.ws + WS_WSMALL + (which ? WSM_A2UP : WSM_W2UP)))[j] = (bf16)(pk2(v, 0.f) & 0xffffu); }
        for (int i = gt; i < MC * D / 4; i += NGT) ((f32x4*)(F.ws + WS_XC))[i] = ((const f32x4*)AR.in[2])[i];
        const float RS128 = 0.08838834764831845f;
        bf16* dm = (bf16*)(F.ws + WS_TAB + TAB_DMAT); bf16* m1 = (bf16*)(F.ws + WS_TAB + TAB_M1); bf16* m2 = (bf16*)(F.ws + WS_TAB + TAB_M2); bf16* m3 = (bf16*)(F.ws + WS_TAB + TAB_M3);
        f32x2* tw = (f32x2*)(F.ws + WS_TAB + TAB_TW);
        for (int i = gt; i < 512 * 256; i += NGT) { const int r = i >> 8, ch = i & 255, cs = r >> 8, kc = r & 255; float s, c; sincospif((float)((kc * ch) & 255) * (1.f / 128.f), &s, &c);
            dm[i] = (bf16)(pk2((cs ? s : c) * 0.0625f, 0.f) & 0xffffu); }
        for (int i = gt; i < 256 * 256; i += NGT) { const int r = i >> 8, ci = i & 255, ri = r >> 7, k1 = r & 127, cs = ci >> 7, n1 = ci & 127; float s, c; sincospif((float)((k1 * n1) & 127) * (1.f / 64.f), &s, &c);
            const float v1 = ri == 0 ? (cs == 0 ? c : -s) : (cs == 0 ? s : c);
            m1[i] = (bf16)(pk2(v1 * RS128, 0.f) & 0xffffu);
            const float v2 = r < 128 ? (cs == 0 ? c : -s) : 0.f;
            m2[i] = (bf16)(pk2(v2 * RS128, 0.f) & 0xffffu); }
        for (int i = gt; i < 256 * 512; i += NGT) { const int k = i >> 9, ci = i & 511, cs = ci >> 8, n = ci & 255; float s, c; sincospif((float)((k * n) & 255) * (1.f / 128.f), &s, &c);
            m3[i] = (bf16)(pk2((cs ? -s : c) * 0.0625f, 0.f) & 0xffffu); }
        for (int i = gt; i < 128 * 128; i += NGT) { const int k1 = i >> 7, n2 = i & 127; float s, c; sincospif((float)(k1 * n2) * (1.f / 8192.f), &s, &c); tw[i] = (f32x2){c, s}; }
    }
}

template <bool BLK = false, bool FIRST = false> __device__ __forceinline__ void phase_norm(Frame& F, const float* xl, const float* xc, int r0, int Mrows, const float* nw, int layer, int sidx, bf16* HN) {
    int tid_ = threadIdx.x; asm volatile("" : "+v"(tid_)); const int TID = tid_, LANE = tid_ & 63, WAVE = __builtin_amdgcn_readfirstlane(tid_ >> 6);
    LAS float* TA = (LAS float*)(F.lds);
    LAS float* TB = (LAS float*)(F.lds + 24576);
    for (int i = TID; i < 3 * D / 4; i += NWAVES * 64) { const int who = i / (D / 4), d = (i % (D / 4)) * 4;
        const ModRef MR{(const float*)(F.ws + WS_MODP), F.modb, (const float*)(F.ws + WS_MODV)};
        const f32x4 sh = FIRST ? modv4(MR, layer, who, sidx * D + d) : modvF(MR, layer, who, sidx * D + d), sc = FIRST ? modv4(MR, layer, who, (sidx + 1) * D + d) : modvF(MR, layer, who, (sidx + 1) * D + d), g = *(const f32x4*)(nw + d);
        *(LAS f32x4*)(TA + who * D + d) = g * (sc + 1.f); *(LAS f32x4*)(TB + who * D + d) = sh; }
    if (FIRST) {
        const ModRef MR{(const float*)(F.ws + WS_MODP), F.modb, nullptr}; float* MV = (float*)(F.ws + WS_MODV);
        for (int i = F.vcu * (NWAVES * 64) + TID; i < 6 * NMODV / 4; i += F.G * NWAVES * 64) { const int lw = i / (NMODV / 4), c = (i % (NMODV / 4)) * 4; *(f32x4*)(MV + (size_t)lw * NMODV + c) = modv4(MR, lw / 3, lw % 3, c); }
    }
    __syncthreads();
    const int gw = F.vcu * NWAVES + WAVE, NGW = F.G * NWAVES;
    for (int r = r0 + gw; r < Mrows; r += NGW) {
        const int who = who_of_row(r);
        const float* xr = r < ML ? xl + (size_t)r * D : xc + (size_t)(r - ML) * D;
        f32x4 v[4][2]; float ss = 0.f;
#pragma unroll
        for (int j = 0; j < 4; ++j)
#pragma unroll
            for (int h = 0; h < 2; ++h) { v[j][h] = *(const f32x4*)(xr + 512 * j + 8 * LANE + 4 * h); ss += (v[j][h].x * v[j][h].x + v[j][h].y * v[j][h].y) + (v[j][h].z * v[j][h].z + v[j][h].w * v[j][h].w); }
        const float rstd = 1.0f / sqrtf(wave_sum(ss) * (1.f / D) + NORM_EPS);
#pragma unroll
        for (int j = 0; j < 4; ++j) { const int d = 512 * j + 8 * LANE;
            const f32x4 a0 = *(const LAS f32x4*)(TA + who * D + d), a1 = *(const LAS f32x4*)(TA + who * D + d + 4), b0 = *(const LAS f32x4*)(TB + who * D + d), b1 = *(const LAS f32x4*)(TB + who * D + d + 4);
            const f32x4 o0 = v[j][0] * rstd * a0 + b0, o1 = v[j][1] * rstd * a1 + b1;
            v4u w; w.x = pk2(o0.x, o0.y); w.y = pk2(o0.z, o0.w); w.z = pk2(o1.x, o1.y); w.w = pk2(o1.z, o1.w);
            if (BLK) *(v4u*)(HN + ((size_t)(r >> 8) * (D / 64) + (d >> 6)) * 16384 + (size_t)(r & 255) * 64 + (d & 63)) = w;
            else *(v4u*)(HN + (size_t)r * D + d) = w; }
    }
}
__device__ __forceinline__ void phase_final(Frame& F, float* x, const float* w) {
    int tid_ = threadIdx.x; asm volatile("" : "+v"(tid_)); const int TID = tid_, LANE = tid_ & 63, WAVE = __builtin_amdgcn_readfirstlane(tid_ >> 6);
    const int gw = F.vcu * NWAVES + WAVE, NGW = F.G * NWAVES;
    for (int r = gw; r < ML; r += NGW) {
        float* xr = x + (size_t)r * D;
        f32x4 v[8]; float ss = 0.f;
#pragma unroll
        for (int j = 0; j < 8; ++j) { v[j] = *(const f32x4*)(xr + 256 * j + 4 * LANE); ss += (v[j].x * v[j].x + v[j].y * v[j].y) + (v[j].z * v[j].z + v[j].w * v[j].w); }
        const float rstd = 1.0f / sqrtf(wave_sum(ss) * (1.f / D) + NORM_EPS);
#pragma unroll
        for (int j = 0; j < 8; ++j) { const f32x4 g = *(const f32x4*)(w + 256 * j + 4 * LANE); *(f32x4*)(xr + 256 * j + 4 * LANE) = v[j] * rstd * g; }
    }
}

#if MK_DEBUG
__device__ __forceinline__ void dbg_flag(unsigned* ctl, unsigned code) { atomicMax(ctl + CW_DBG, code); }
__device__ __forceinline__ bool dbg_bad(float got, float ref, float atol, float rtol) { const float e = fabsf(got - ref); return !(e <= atol + rtol * fabsf(ref)); }
__device__ __forceinline__ unsigned dbg_hash(unsigned x) { x ^= x >> 16; x *= 0x7feb352du; x ^= x >> 15; x *= 0x846ca68bu; x ^= x >> 16; return x; }
__device__ __noinline__ void dbg_check_mod(unsigned char* ws, const float* c, const float* c_ctx, const float* mod_w, const float* modb) {
    const int lane = threadIdx.x & 63, gw = blockIdx.x * 8 + (threadIdx.x >> 6);
    if (gw >= 96) return;
    const unsigned h = dbg_hash(gw * 2654435761u + 17u); const int layer = h & 1, who = (h >> 1) % 3, col = ((h >> 4) % NMODV) & ~3;
    float s = 0.f;
    for (int k = lane; k < D; k += 64) { const float v = who < 2 ? c[who * D + k] : c_ctx[k]; s += v / (1.f + expf(-v)) * mod_w[((size_t)layer * D + k) * NMODV + col]; }
    s = wave_sum(s) + modb[(size_t)layer * NMODV + col];
    const ModRef MR{(const float*)(ws + WS_MODP), modb};
    const f32x4 g = modv4(MR, layer, who, col);
    if (lane == 0 && dbg_bad(g.x, s, 2e-3f, 2e-3f)) dbg_flag((unsigned*)(ws + WS_CTL), 1u);
}
__device__ __noinline__ void dbg_check_hn(unsigned char* ws, const float* x, const float* ctx, const float* nw, const float* modb, int layer, int sidx, unsigned code) {
    const int lane = threadIdx.x & 63, gw = blockIdx.x * 8 + (threadIdx.x >> 6);
    if (gw >= 64) return;
    const int r = (gw < 48) ? (int)(dbg_hash(gw + 99u) % ML) : ML + (int)(dbg_hash(gw + 7u) % MC);
    const float* xr = r < ML ? x + (size_t)r * D : ctx + (size_t)(r - ML) * D; const int who = who_of_row(r);
    float ss = 0.f; for (int d = lane; d < D; d += 64) ss += xr[d] * xr[d];
    const float rstd = 1.0f / sqrtf(wave_sum(ss) / D + NORM_EPS);
    const ModRef MR{(const float*)(ws + WS_MODP), modb}; const bf16* HN = (const bf16*)(ws + WS_ACT + ACT_HN);
    bool bad = false;
    for (int d4 = lane * 4; d4 < D; d4 += 256) { const f32x4 sh = modv4(MR, layer, who, sidx * D + d4), sc = modv4(MR, layer, who, (sidx + 1) * D + d4);
        for (int e = 0; e < 4; ++e) { const float ref = xr[d4 + e] * rstd * nw[d4 + e] * (1.f + sc[e]) + sh[e]; bad |= dbg_bad(bf2f(HN[(size_t)r * D + d4 + e]), ref, 0.03f, 0.01f); } }
    if (bad) dbg_flag((unsigned*)(ws + WS_CTL), code);
}
__device__ __noinline__ void dbg_check_h(unsigned char* ws, const float* w13) {
    const int lane = threadIdx.x & 63, gw = blockIdx.x * 8 + (threadIdx.x >> 6);
    if (gw >= 512) return;
    const unsigned h = dbg_hash(gw + 1234u); const int r = (gw & 7) == 7 ? ML + (int)(h % MC) : (int)(h % ML), j = (int)((h >> 7) % DFF);
    const bf16* HN = (const bf16*)(ws + WS_ACT + ACT_HN); const bf16* HB = (const bf16*)(ws + WS_ACT + ACT_H);
    float g = 0.f, u = 0.f;
    for (int k = lane; k < D; k += 64) { const float a = bf2f(HN[(size_t)r * D + k]); g += a * w13[(size_t)k * 2 * DFF + j]; u += a * w13[(size_t)k * 2 * DFF + DFF + j]; }
    g = wave_sum(g); u = wave_sum(u);
    const float ref = g / (1.f + expf(-g)) * u;
    if (lane == 0 && dbg_bad(bf2f(HB[(size_t)r * DFF + j]), ref, 0.03f, 0.03f)) dbg_flag((unsigned*)(ws + WS_CTL), 3u);
}
__device__ __noinline__ void dbg_check_w2(unsigned char* ws, const float* x, const float* ctx, const float* out, const float* w2, const float* modb) {
    const int lane = threadIdx.x & 63, gw = blockIdx.x * 8 + (threadIdx.x >> 6);
    if (gw >= 512) return;
    const unsigned h = dbg_hash(gw + 4321u); const int r = (gw & 7) == 7 ? ML + (int)(h % MC) : (int)(h % ML), col = (int)((h >> 7) % D) & ~3;
    const bf16* HB = (const bf16*)(ws + WS_ACT + ACT_H);
    float a = 0.f; for (int j = lane; j < DFF; j += 64) a += bf2f(HB[(size_t)r * DFF + j]) * w2[(size_t)j * D + col];
    a = wave_sum(a);
    const ModRef MR{(const float*)(ws + WS_MODP), modb}; const f32x4 gt = modv4(MR, 0, who_of_row(r), 2 * D + col);
    const float base = r < ML ? x[(size_t)r * D + col] : ctx[(size_t)(r - ML) * D + col];
    const float got = r < ML ? out[(size_t)r * D + col] : ((const float*)(ws + WS_XC))[(size_t)(r - ML) * D + col];
    if (lane == 0 && dbg_bad(got, base + 0.5f * gt.x * a, 0.02f, 0.01f)) dbg_flag((unsigned*)(ws + WS_CTL), 4u);
}
__device__ __noinline__ void dbg_check_fourier(unsigned char* ws, const float* xl, const float* nw, const float* modb, LAS float* red) {
    const int lane = threadIdx.x & 63, wave = threadIdx.x >> 6;
    if (blockIdx.x >= 40) return;
    const unsigned h = dbg_hash(blockIdx.x + 555u); const bool isc = blockIdx.x >= 32;
    const int L = isc ? CTXL : SEQ, b = h & 1, k = (int)((h >> 1) % (unsigned)L), g = (h >> 17) & 7, ch = (h >> 20) & 255;
    const float* xb = isc ? (const float*)(ws + WS_XC) + (size_t)b * CTXL * D : xl + (size_t)b * SEQ * D; const int who = isc ? 2 : b;
    const ModRef MR{(const float*)(ws + WS_MODP), modb};
    const int c0 = g * 256 + lane * 4; const f32x4 sh = modv4(MR, 0, who, 3 * D + c0), sc = modv4(MR, 0, who, 4 * D + c0);
    float acc = 0.f;
    for (int n = wave; n < L; n += 8) { const float* xr = xb + (size_t)n * D;
        float ss = 0.f; for (int d = lane; d < D; d += 64) ss += xr[d] * xr[d];
        const float rstd = 1.0f / sqrtf(wave_sum(ss) / D + NORM_EPS);
        const float fl = (float)((k * n) % L) / (float)L;
        for (int e = 0; e < 4; ++e) { const int c = lane * 4 + e; float hv = xr[c0 + e] * rstd * nw[c0 + e] * (1.f + sc[e]) + sh[e]; hv = bflo(pk2(hv, 0.f));
            acc += hv * cospif(2.f * (fl + (float)((ch * c) & 255) * (1.f / 256.f))); } }
    acc = wave_sum(acc); if (lane == 0) red[wave] = acc; __syncthreads();
    if (threadIdx.x == 0) { float t = 0.f; for (int w = 0; w < 8; ++w) t += red[w]; t *= isc ? (1.f / 256.f) : (1.f / 2048.f);
        const size_t row = isc ? (size_t)ML + b * CTXL + k : (size_t)b * SEQ + k; const float got = bf2f(((const bf16*)(ws + WS_ACT + ACT_HN))[row * D + g * 256 + ch]);
        if (dbg_bad(got, t, 0.04f, 0.02f)) dbg_flag((unsigned*)(ws + WS_CTL), isc ? 6u : 5u); }
}
__device__ __noinline__ void dbg_check_rkv(unsigned char* ws, const float* wrkv) {
    const int lane = threadIdx.x & 63, gw = blockIdx.x * 8 + (threadIdx.x >> 6);
    if (gw >= 768) return;
    const unsigned h = dbg_hash(gw + 777u); const int wsel = gw % 3, r = (gw & 7) == 7 ? ML + (int)(h % MC) : (int)(h % ML), col = (int)((h >> 9) % D);
    const bf16* A = (const bf16*)(ws + WS_ACT + ACT_XM + (size_t)wsel * XM_STRIDE); const bf16* O = (const bf16*)(ws + WS_ACT + ACT_XM + (size_t)(3 + wsel) * XM_STRIDE);
    float a = 0.f; for (int k = lane; k < D; k += 64) a += bf2f(A[(size_t)r * D + k]) * wrkv[((size_t)wsel * D + k) * D + col];
    a = wave_sum(a);
    if (lane == 0 && dbg_bad(bf2f(O[(size_t)r * D + col]), a, 0.03f, 0.02f)) dbg_flag((unsigned*)(ws + WS_CTL), 8u);
}
__device__ __noinline__ void dbg_check_lora(unsigned char* ws, const float* w1, const float* a1, const float* g1) {
    const int lane = threadIdx.x & 63, gw = blockIdx.x * 8 + (threadIdx.x >> 6);
    if (gw >= 768) return;
    const unsigned h = dbg_hash(gw + 888u); const int which = gw % 3, r = (gw & 7) == 7 ? ML + (int)(h % MC) : (int)(h % ML);
    const int col = which == 2 ? (int)((h >> 9) % 256) : (int)((h >> 9) % 192);
    const bf16* A = (const bf16*)(ws + WS_ACT + ACT_XM + (size_t)(3 + which) * XM_STRIDE); const bf16* O = (const bf16*)(ws + WS_ACT + ACT_LR + (size_t)which * LR_STRIDE);
    float a = 0.f;
    for (int k = lane; k < D; k += 64) { const float wv = which == 2 ? g1[(size_t)k * 256 + col] : (which ? a1 : w1)[((size_t)(col / 96) * D + k) * LORA + (col % 96)]; a += bf2f(A[(size_t)r * D + k]) * wv; }
    a = wave_sum(a); const float ref = which == 0 ? tanhf(a) : (which == 2 ? 1.f / (1.f + expf(-a)) : a);
    if (lane == 0 && dbg_bad(bf2f(O[(size_t)r * 256 + col]), ref, 0.02f, 0.02f)) dbg_flag((unsigned*)(ws + WS_CTL), 9u);
}
__device__ __noinline__ void dbg_check_scan(unsigned char* ws, const float* p_w0, const float* p_a0, const float* p_kk, const float* p_ka, const float* p_w2, const float* p_a2) {
    const int lane = threadIdx.x & 63, gw = blockIdx.x * 8 + (threadIdx.x >> 6);
    if (gw >= 64) return;
    const unsigned hsh = dbg_hash(gw + 31337u); const int chain = hsh & 127, i = (hsh >> 8) & 63, b = chain >> 6, hd = (chain >> 1) & 31, z = chain & 1;
    const bf16* RKV = (const bf16*)(ws + WS_ACT + ACT_XM + 3 * XM_STRIDE);
    const bf16* TWb = (const bf16*)(ws + WS_ACT + ACT_LR); const bf16* TAb = (const bf16*)(ws + WS_ACT + ACT_LR + LR_STRIDE);
    const bf16* YB = (const bf16*)(ws + WS_ACT + (z ? ACT_YB1 : ACT_YB0));
    const int ch = hd * 64 + lane;
    const float w0 = p_w0[z * D + ch], a0 = p_a0[z * D + ch], kkc = p_kk[ch], kac = p_ka[ch];
    float st = 0.f; float worst = 0.f;
    for (int s_ = 0; s_ < CTXL + SEQ; ++s_) {
        const int row = scan_row(b, z, s_);
        float lwv = 0.f, lav = 0.f;
        for (int r = 0; r < LORA; ++r) { lwv += bf2f(TWb[(size_t)row * 256 + z * 96 + r]) * p_w2[((size_t)z * LORA + r) * D + ch]; lav += bf2f(TAb[(size_t)row * 256 + z * 96 + r]) * p_a2[((size_t)z * LORA + r) * D + ch]; }
        const float xw = w0 + lwv, logw = -log1pf(expf(-xw)) - 0.5f, dec = expf(-expf(logw));
        const float asig = 1.f / (1.f + expf(-(a0 + lav)));
        const float rj = bf2f(RKV[(size_t)row * D + ch]), kj = bf2f(RKV[(size_t)MT * D + (size_t)row * D + ch]), vi = bf2f(RKV[2 * (size_t)MT * D + (size_t)row * D + hd * 64 + i]);
        const float kr = kj * kkc; const float nrm = wave_sum(kr * kr); const float kkj = kr / sqrtf(fmaxf(nrm, 1e-24f));
        const float aj = -kkj, bj = kkj * asig, kdj = kj * (1.f + (asig - 1.f) * kac);
        const float sa = wave_sum(st * aj);
        st = st * dec + sa * bj + vi * kdj;
        const float y = wave_sum(st * rj);
        if (s_ >= CTXL) { const float got = bf2f(YB[(size_t)row * D + hd * 64 + i]); const float e = fabsf(got - y) / (0.05f + 0.03f * fabsf(y)); worst = fmaxf(worst, e); }
    }
    if (lane == 0 && !(worst <= 1.f)) dbg_flag((unsigned*)(ws + WS_CTL), 10u);
}
__device__ __noinline__ void dbg_check_combine(unsigned char* ws, const float* p_ka, const float* p_rk, const float* p_lnw, const float* p_lnb) {
    const int lane = threadIdx.x & 63, gw = blockIdx.x * 8 + (threadIdx.x >> 6);
    if (gw >= 256) return;
    const unsigned hsh = dbg_hash(gw + 4242u); const int r = (int)(hsh % ML), hd = (hsh >> 20) & 31, ch = hd * 64 + lane;
    const bf16* RKV = (const bf16*)(ws + WS_ACT + ACT_XM + 3 * XM_STRIDE);
    const float y = bf2f(((const bf16*)(ws + WS_ACT + ACT_YB0))[(size_t)r * D + ch]) + bf2f(((const bf16*)(ws + WS_ACT + ACT_YB1))[(size_t)r * D + ch]);
    const float mean = wave_sum(y) / 64.f, var = wave_sum((y - mean) * (y - mean)) / 64.f;
    const float rj = bf2f(RKV[(size_t)r * D + ch]), kj = bf2f(RKV[(size_t)MT * D + (size_t)r * D + ch]), vj = bf2f(RKV[2 * (size_t)MT * D + (size_t)r * D + ch]);
    const float* SA = (const float*)(ws + WS_SA);
    const float sb = wave_sum(rj * p_rk[ch] * kj * (1.f - p_ka[ch])) + 0.5f * (SA[(size_t)r * 32 + hd] + SA[((size_t)MT + r) * 32 + hd]);
    const float ref = (y - mean) / sqrtf(var + GN_EPS) * p_lnw[ch] + p_lnb[ch] + sb * vj;
    const float got = bf2f(((const bf16*)(ws + WS_ACT + ACT_PO))[(size_t)r * D + ch]);
    if (dbg_bad(got, ref, 0.03f, 0.02f)) dbg_flag((unsigned*)(ws + WS_CTL), 12u);
}
__device__ __noinline__ void dbg_final(unsigned char* ws, float* out) {
    const unsigned code = __hip_atomic_load((unsigned*)(ws + WS_CTL) + CW_DBG, __ATOMIC_RELAXED, __HIP_MEMORY_SCOPE_AGENT);
    if (code) for (size_t i = (size_t)blockIdx.x * 512 + threadIdx.x; i < (size_t)ML * D; i += (size_t)gridDim.x * 512) out[i] = 1000.f * code;
}
#define DBG_PHASE(stmt) PH_BEGIN stmt; PH_END
#else
#define DBG_PHASE(stmt)
#endif

constexpr int NPH = 46;
__global__ void __launch_bounds__(NWAVES * 64, 2) mk_fwd(const Args args) {
    const Args& AR = args;
    extern __shared__ __attribute__((aligned(16))) unsigned char lds[];
    Frame F;
    F.lds = (LAS unsigned char*)lds;
    F.MISC = (volatile LAS unsigned*)(F.lds + LDSCTL_OFF);
    F.G = gridDim.x; { const int bx = blockIdx.x; F.vcu = (F.G % 8 == 0) ? (bx % 8) * (F.G / 8) + bx / 8 : bx; }
    F.ws = args.ws; F.ctl = (unsigned*)(args.ws + WS_CTL); F.out = args.out;
    F.modb = args.in[5];
    if (threadIdx.x < 16) ((LAS unsigned*)(F.lds + LDSCTL_OFF))[threadIdx.x] = 0u;
    __syncthreads();
    XcdBarrier bar; bar.bar = F.ctl + CW_BAR; bar.x = 0; bar.st = nullptr;
    if (!MK_PER_PHASE) bar = xcd_barrier_post(F.ctl + CW_BAR, F.MISC + 8);
    const int lo = args.ph_lo, hi = args.ph_hi;
    int ph = 0;
#define PH_BEGIN if (ph >= lo && ph < hi) {
#define PH_END   if (ph + 1 < hi) { if (MK_PER_PHASE) { if (threadIdx.x == 0) __hip_atomic_store(F.ctl + 0, 0xBADu, __ATOMIC_RELAXED, __HIP_MEMORY_SCOPE_AGENT); } else { xcd_barrier(bar); if (MK_PROBE & 16384) xcd_barrier(bar); } } } ++ph;

    float* XC = (float*)(F.ws + WS_XC);
    const ModRef MR{(const float*)(F.ws + WS_MODP), args.in[5], (const float*)(F.ws + WS_MODV)};
    bf16* HN = (bf16*)(F.ws + WS_ACT + ACT_HN);
    bf16* HB = (bf16*)(F.ws + WS_ACT + ACT_H);
    bf16* HNA = (bf16*)(F.ws + WS_ACT + 500 * MiB);
    float* PSB = (float*)(F.ws + WS_PS); float* RSTD = (float*)(F.ws + WS_RSTD);

    REP(16) PH_BEGIN p0_prologue(F, args); PH_END
    DBG_PHASE(dbg_check_mod(F.ws, AR.in[1], AR.in[3], AR.in[4], AR.in[5]))

#define FFN_STAGE(s_) do { constexpr int s = (s_); constexpr int layer = s >> 1, f = s & 1; constexpr int Mrows = (s == 3) ? ML : MT; \
        const float* srcL = (s == 0) ? AR.in[0] : F.out; const float* srcC = XC; \
        bf16* HNs = (s & 1) ? HNA : HN;        \
        if (s == 0) { REP(4) PH_BEGIN phase_norm<true, true>(F, srcL, srcC, 0, Mrows, AR.in[6] + (size_t)(layer * 3 + (f ? 2 : 0)) * D, layer, f ? 6 : 0, HNs); PH_END } \
        else if (s != 3) { PH_BEGIN phase_norm<true>(F, srcL, srcC, ML, Mrows, AR.in[6] + (size_t)(layer * 3 + (f ? 2 : 0)) * D, layer, f ? 6 : 0, HNs); PH_END }        \
        if (s == 0) { DBG_PHASE(dbg_check_hn(F.ws, AR.in[0], AR.in[2], AR.in[6], AR.in[5], 0, 0, 2u)) } \
          \
        PH_BEGIN { \
            OpBlk A{HNs, D / 64, true}, B{(const bf16*)(F.ws + (layer ? WS_WL1 : WS_WL0) + (size_t)f * 44 * MiB), D / 64, false}; \
            pg8::StaticOrder S; S.init(64, DFF / 128, F.G, (int)blockIdx.x, pg8::WGM, 0); \
            EpiSwiGLU E{HB}; \
            pg8::gemm_phase(F.lds + RING_OFF, D, A, B, S, E); \
        } PH_END \
        if (s == 0) { DBG_PHASE(dbg_check_h(F.ws, AR.in[7])) } \
          \
        constexpr int NX = (s == 0) ? 2 : (s == 1) ? 1 : (s == 2) ? 3 : 4; constexpr int site = (s == 0) ? 0 : (s == 1) ? 2 : (s == 2) ? 3 : 5; \
        const float* nwn = (s == 0) ? AR.in[6] + (size_t)(0 * 3 + 1) * D : (s == 1) ? AR.in[6] + (size_t)(1 * 3 + 0) * D : AR.in[27]; \
        PH_BEGIN { \
            { OpHBlk A{HB, -1, 0}; OpBlk B{(const bf16*)(F.ws + (layer ? WS_WL1 : WS_WL0) + 88 * MiB + (size_t)f * 22 * MiB), HKT, false}; \
              pg8::StaticOrder S; S.init(64, D / 256, F.G, (int)blockIdx.x, 4, 0, 1); \
              EpiResidNorm<false, true, NX> E{MR, srcL, F.out, nullptr, layer, f ? 8 : 2, nwn, (s == 0) ? 0 : 1, (s == 0) ? 3 : 0, HN, RSTD, PSB + (size_t)site * 262144, F.ctl + CW_PCNT + site * 1024, F.lds + RING_BYTES}; \
              pg8::gemm_phase(F.lds + RING_OFF, DFF, A, B, S, E); } \
            { OpBlk A{HNs, D / 64, true}, B{(const bf16*)(F.ws + (layer ? WS_WL1 : WS_WL0) + (size_t)f * 44 * MiB), D / 64, false}; \
              pg8::StaticOrder S; S.init(Mrows / 256 - 64, DFF / 128, F.G, (int)blockIdx.x, pg8::WGM, 64); \
              EpiSwiGLU E{HB}; \
              pg8::gemm_phase(F.lds + RING_OFF, D, A, B, S, E); } \
        } PH_END \
        PH_BEGIN { \
            OpHBlk A{HB, -1, 0}; OpBlk B{(const bf16*)(F.ws + (layer ? WS_WL1 : WS_WL0) + 88 * MiB + (size_t)f * 22 * MiB), HKT, false}; \
            pg8::StaticOrder S; S.init(64, D / 256, F.G, (int)blockIdx.x, 4, 64, 1); \
            EpiResidNorm<false, true, NX> E{MR, srcL, F.out, nullptr, layer, f ? 8 : 2, nwn, (s == 0) ? 0 : 1, (s == 0) ? 3 : 0, HN, RSTD, PSB + (size_t)site * 262144, F.ctl + CW_PCNT + site * 1024, F.lds + RING_BYTES}; \
            pg8::gemm_phase(F.lds + RING_OFF, DFF, A, B, S, E); \
            if (Mrows > ML) { OpHBlk Ac{HB, 128, HKT / 4}; OpBlkK Bc{(const bf16*)(F.ws + (layer ? WS_WL1 : WS_WL0) + 88 * MiB + (size_t)f * 22 * MiB), HKT}; \
                OrderCtxK Sc{F.G, (int)blockIdx.x}; EpiCtxAtomic<false, true> Ec{MR, XC, nullptr, layer, f ? 8 : 2}; \
                pg8::gemm_phase(F.lds + RING_OFF, DFF / 4, Ac, Bc, Sc, Ec); } \
        } PH_END \
        if (s == 0) { DBG_PHASE(dbg_check_w2(F.ws, AR.in[0], AR.in[2], F.out, AR.in[8], AR.in[5])) } \
    } while (0)

    FFN_STAGE(0);
        {
            bf16* YT = (bf16*)(F.ws + WS_ACT + ACT_YT); bf16* T2 = (bf16*)(F.ws + WS_ACT + ACT_T2); bf16* YC = (bf16*)(F.ws + WS_ACT + ACT_YC);
            PH_BEGIN phase_norm<false>(F, F.out, XC, ML, MT, AR.in[6] + (size_t)(0 * 3 + 1) * D, 0, 3, HN); PH_END
            REP(64) PH_BEGIN {
                { OpFixed A{(const bf16*)(F.ws + WS_TAB + TAB_DMAT), 256, 1}; OpChanL B{HN}; pg8::StaticOrder S; S.init(16, 128, F.G, (int)blockIdx.x); EpiChanL E{YT};
                  pg8::gemm_phase(F.lds + RING_OFF, 256, A, B, S, E); }
                { OpFixed A{(const bf16*)(F.ws + WS_TAB + TAB_DMAT), 256, 1}; OpChanC B{HN}; pg8::StaticOrder S; S.init(16, 2, F.G, (int)blockIdx.x); EpiChanC E{YC};
                  pg8::gemm_phase(F.lds + RING_OFF, 256, A, B, S, E); }
            } PH_END
            REP(64) PH_BEGIN {
                { OpFixed A{(const bf16*)(F.ws + WS_TAB + TAB_M1), 256, 0}; pg8::OpPlain B{YT, 256, false}; pg8::StaticOrder S; S.init(1, 2048, F.G, (int)blockIdx.x); EpiStage1 E{T2, (const float*)(F.ws + WS_TAB + TAB_TW)};
                  pg8::gemm_phase(F.lds + RING_OFF, 256, A, B, S, E); }
                { OpFixed A{(const bf16*)(F.ws + WS_TAB + TAB_M3), 512, 0}; pg8::OpPlain B{YC, 512, false}; pg8::StaticOrder S; S.init(1, 16, F.G, (int)blockIdx.x); EpiCtxDft E{HN};
                  pg8::gemm_phase(F.lds + RING_OFF, 512, A, B, S, E); }
            } PH_END
            REP(64) PH_BEGIN {
                OpFixed A{(const bf16*)(F.ws + WS_TAB + TAB_M2), 256, 0}; OpStage2B B{T2}; pg8::StaticOrder S; S.init(1, 2048, F.G, (int)blockIdx.x); EpiStage2 E{HN};
                pg8::gemm_phase(F.lds + RING_OFF, 256, A, B, S, E);
            } PH_END
            DBG_PHASE(dbg_check_fourier(F.ws, F.out, AR.in[6] + D, AR.in[5], (LAS float*)F.lds))
            PH_BEGIN {
                pg8::OpPlain A{HN, D, true}, B{(const bf16*)(F.ws + WS_WFO), D, false};
                pg8::StaticOrder S; S.init(ML / 256, D / 256, F.G, (int)blockIdx.x, 4);
                EpiResidNorm<true, false, 1> E{MR, F.out, F.out, AR.in[10], 0, 5, AR.in[6] + (size_t)(0 * 3 + 2) * D, 0, 6, HNA, RSTD, PSB + (size_t)1 * 262144, F.ctl + CW_PCNT + 1 * 1024, F.lds + RING_BYTES};
                pg8::gemm_phase(F.lds + RING_OFF, D, A, B, S, E);
                OpKSplit Ac{HN + (size_t)ML * D, D, D / 4, true}, Bc{(const bf16*)(F.ws + WS_WFO), D, D / 4, false};
                OrderCtxK Sc{F.G, (int)blockIdx.x}; EpiCtxAtomic<true, false> Ec{MR, XC, AR.in[10], 0, 5};
                pg8::gemm_phase(F.lds + RING_OFF, D / 4, Ac, Bc, Sc, Ec);
            } PH_END
        }
    FFN_STAGE(1);
    FFN_STAGE(2);
    {
        bf16* XM = (bf16*)(F.ws + WS_ACT + ACT_XM); bf16* LR = (bf16*)(F.ws + WS_ACT + ACT_LR); bf16* PO = (bf16*)(F.ws + WS_ACT + ACT_PO);
        REP(8) PH_BEGIN phase_rowstats(F, F.out, XC, RSTD, ML); PH_END
        REP(4096) PH_BEGIN phase_mix(F, MR, F.out, XC, RSTD, AR.in[6] + (size_t)(1 * 3 + 1) * D, AR.in[11], XM); PH_END
        REP(128) PH_BEGIN {
            OpXM A{XM, 1, 3}; OpWSel B{(const bf16*)(F.ws + WS_WSMALL), 1, 1 * MiB}; pg8::StaticOrder S; S.init(MT / 256, 3, F.G, (int)blockIdx.x); EpiLora E{LR};
            pg8::gemm_phase(F.lds + RING_OFF, D, A, B, S, E);
            { OpXM Ac{XM, 8, 0}; OpWSel Bc{(const bf16*)(F.ws + WS_WRKV), 8, 8 * MiB}; pg8::StaticOrder Sc; Sc.init(2, 24, F.G, (int)((blockIdx.x + F.G - 140) % F.G), pg8::WGM, 128); EpiRkvC Ec{(bf16*)(F.ws + WS_RKVC)};
              pg8::gemm_phase(F.lds + RING_OFF, D, Ac, Bc, Sc, Ec); }
        } PH_END
        DBG_PHASE(dbg_check_lora(F.ws, AR.in[14], AR.in[17], AR.in[19]))
        REP(512) PH_BEGIN {
            OpXM A{XM, 8, 0}; OpWSel B{(const bf16*)(F.ws + WS_WRKV), 8, 8 * MiB}; pg8::StaticOrder S; S.init(ML / 256, 24, F.G, (int)blockIdx.x); EpiRkv E{XM};
            pg8::gemm_phase(F.lds + RING_OFF, D, A, B, S, E);
        } PH_END
        DBG_PHASE(dbg_check_rkv(F.ws, AR.in[12]))
        REP(1)
#pragma unroll 1
        for (int w = 0; w <= SCAN_NW; ++w) { PH_BEGIN phase_scan_step(F, args, w); PH_END }
        DBG_PHASE(dbg_check_scan(F.ws, AR.in[13], AR.in[16], AR.in[21], AR.in[22], AR.in[15], AR.in[18]))
        REP(256) PH_BEGIN phase_combine(F, args, PO); PH_END
        DBG_PHASE(dbg_check_combine(F.ws, AR.in[22], AR.in[23], AR.in[24], AR.in[25]))
        PH_BEGIN {
            pg8::OpPlain A{(const bf16*)((const char*)LR + 2 * LR_STRIDE), 256, true}, B{(const bf16*)(F.ws + WS_WSMALL + WSM_G2T), 256, false};
            pg8::StaticOrder S; S.init(ML / 256, D / 256, F.G, (int)blockIdx.x); EpiMulG<> E{PO};
            if (MK_PROBE & 32768) { EpiMulG<true> Ed{PO}; pg8::gemm_phase(F.lds + RING_OFF, 256, A, B, S, Ed); }
            pg8::gemm_phase(F.lds + RING_OFF, 256, A, B, S, E);
        } PH_END
        PH_BEGIN {
            pg8::OpPlain A{PO, D, true}, B{(const bf16*)(F.ws + WS_WRO), D, false};
            pg8::StaticOrder S; S.init(ML / 256, D / 256, F.G, (int)blockIdx.x, 4);
            EpiResidNorm<false, false, 1> E{MR, F.out, F.out, nullptr, 1, 5, AR.in[6] + (size_t)(1 * 3 + 2) * D, 1, 6, HNA, RSTD, PSB + (size_t)4 * 262144, F.ctl + CW_PCNT + 4 * 1024, F.lds + RING_BYTES};
            pg8::gemm_phase(F.lds + RING_OFF, D, A, B, S, E);
        } PH_END
    }
    FFN_STAGE(3);
    DBG_PHASE(dbg_final(F.ws, F.out))
#undef PH_BEGIN
#undef PH_END
}

extern "C" void kernel_launch(void* const* d_in, const int* in_sizes, int n_in, void* d_out, int out_size, void* d_ws, size_t ws_size, hipStream_t stream) {
    static int grid = 0;
    if (grid == 0) {
        if (n_in != 28 || out_size != ML * D || ws_size < WS_END) { fprintf(stderr, "kernel_launch: unexpected shapes (n_in %d, out %d, ws %zu < %zu)\n", n_in, out_size, ws_size, (size_t)WS_END); grid = -1; return; }
        int dev = 0, cus = 0, per_cu = 0;
        if (hipGetDevice(&dev) != hipSuccess || hipDeviceGetAttribute(&cus, hipDeviceAttributeMultiprocessorCount, dev) != hipSuccess) { grid = -1; return; }
        if (hipFuncSetAttribute((const void*)mk_fwd, hipFuncAttributeMaxDynamicSharedMemorySize, LDS_BYTES) != hipSuccess) { fprintf(stderr, "kernel_launch: hipFuncSetAttribute failed\n"); grid = -1; return; }
        if (hipOccupancyMaxActiveBlocksPerMultiprocessor(&per_cu, (const void*)mk_fwd, NWAVES * 64, LDS_BYTES) != hipSuccess || per_cu < 1)
            fprintf(stderr, "kernel_launch: occupancy query reports %d per CU\n", per_cu);
        (void)hipGetLastError();
        grid = cus;
        if (cus != 256) { fprintf(stderr, "kernel_launch: built for a 256-CU device (the scan phase maps its 256 chains-halves onto 256 workgroups); found %d CUs, nothing launched\n", cus); grid = -1; return; }
    }
    if (grid < 0) return;
    if (hipMemsetAsync((char*)d_ws + WS_CTL, 0, CTL_ZERO_BYTES, stream) != hipSuccess) return;
    Args a{};
    for (int i = 0; i < 28; ++i) a.in[i] = (const float*)d_in[i];
    a.out = (float*)d_out; a.ws = (unsigned char*)d_ws;
#if MK_PER_PHASE
    for (int p = 0; p < NPH; ++p) { a.ph_lo = p; a.ph_hi = p + 1; hipLaunchKernelGGL(mk_fwd, dim3(grid), dim3(NWAVES * 64), LDS_BYTES, stream, a); }
#else
    a.ph_lo = 0; a.ph_hi = 100000;
    hipLaunchKernelGGL(mk_fwd, dim3(grid), dim3(NWAVES * 64), LDS_BYTES, stream, a);
#endif
}
```

```cpp
#include <hip/hip_runtime.h>
#include <cstdio>
#include <cstdint>

#ifndef MK_PER_PHASE
#define MK_PER_PHASE 0
#endif
#ifndef MK_PROBE
#define MK_PROBE 0
#endif
#define REP(mask) _Pragma("unroll 1") for (int rep_ = 0; rep_ < ((MK_PROBE & (mask)) ? 2 : 1); ++rep_)
#ifndef MK_DEBUG
#define MK_DEBUG 0
#endif

#define GAS __attribute__((address_space(1)))
#define LAS __attribute__((address_space(3)))
typedef unsigned short bf16;
typedef unsigned v4u __attribute__((ext_vector_type(4)));
typedef unsigned v2u __attribute__((ext_vector_type(2)));
typedef float f32x4 __attribute__((ext_vector_type(4)));
typedef float f32x2 __attribute__((ext_vector_type(2)));
typedef float f32x16 __attribute__((ext_vector_type(16)));
typedef short bf16x8 __attribute__((ext_vector_type(8)));
typedef __bf16 bf2_t __attribute__((ext_vector_type(2)));

constexpr int D = 2048, NBATCH = 2, SEQ = 16384, CTXL = 256, DFF = 5632, NMODV = 9 * 2048, NH = 32, HD = 64;
constexpr int ML = NBATCH * SEQ, MC = NBATCH * CTXL, MT = ML + MC;
constexpr int LORA = 96;
constexpr int HKT = DFF / 64;
constexpr int NWAVES = 8;
constexpr float NORM_EPS = 1e-6f, GN_EPS = 64e-5f;

constexpr size_t MiB = 1u << 20;
constexpr size_t WS_CTL = 0, CTL_ZERO_BYTES = 64 * 1024;
constexpr size_t WS_MODP = 1 * MiB;
constexpr size_t WS_TAB = 3 * MiB;
constexpr size_t TAB_DMAT = 0, TAB_M1 = 262144, TAB_M2 = 393216, TAB_M3 = 524288, TAB_TW = 786432;
constexpr size_t WS_RSTD = 4 * MiB;
constexpr size_t WS_SA = 5 * MiB;
constexpr size_t WS_XC = 14 * MiB;
constexpr size_t WS_WSMALL = 18 * MiB;
constexpr size_t WSM_W1CAT = 0, WSM_A1CAT = 1 * MiB, WSM_G1T = 2 * MiB, WSM_W2UP = 3 * MiB, WSM_A2UP = 4 * MiB, WSM_G2T = 5 * MiB;
constexpr size_t WS_WFO = 24 * MiB, WS_WRO = 32 * MiB, WS_WRKV = 40 * MiB;
constexpr size_t WS_WL0 = 64 * MiB, WS_WL1 = 196 * MiB;
constexpr size_t WS_ACT = 328 * MiB;
constexpr size_t ACT_HN = 0, ACT_H = 130 * MiB;
constexpr size_t ACT_YT = 130 * MiB, ACT_T2 = 386 * MiB, ACT_YC = 642 * MiB;
constexpr size_t ACT_XM = 0, XM_STRIDE = 130 * MiB, ACT_LR = 780 * MiB, LR_STRIDE = 17039360;
constexpr size_t ACT_WBUF = 0, WBUF_STRIDE = 123 * MiB, ACT_YB0 = 248 * MiB, ACT_YB1 = 829 * MiB, ACT_PO = 0;
constexpr size_t WS_SST = WS_ACT + 957 * MiB;
constexpr size_t WS_RKVC = WS_SST + 2 * MiB;
constexpr size_t WS_PS = WS_RKVC + 6 * MiB;
constexpr size_t WS_MODV = WS_PS + 6 * MiB;
constexpr size_t WS_END = WS_MODV + 1 * MiB;
static_assert(WS_END <= 1476395008ull, "workspace map exceeds the guaranteed minimum");
static_assert((size_t)MT * D * 2 == 130 * MiB, "XM size");

constexpr int CW_DBG = 8;
constexpr int CW_BAR = 4096;
constexpr int CW_PCNT = 8192;

#define LDS_WAIT() asm volatile("s_waitcnt lgkmcnt(0)" ::: "memory")
#define VM_WAIT() asm volatile("s_waitcnt vmcnt(0)" ::: "memory")
__device__ __forceinline__ unsigned pk2(float lo, float hi) { f32x2 v = {lo, hi}; bf2_t b = __builtin_convertvector(v, bf2_t); return __builtin_bit_cast(unsigned, b); }
__device__ __forceinline__ float bf2f(bf16 b) { return __uint_as_float(((unsigned)b) << 16); }
__device__ __forceinline__ float bflo(unsigned w) { return __uint_as_float(w << 16); }
__device__ __forceinline__ float bfhi(unsigned w) { return __uint_as_float(w & 0xffff0000u); }
__device__ __forceinline__ float wave_sum(float v) {
#pragma unroll
    for (int o = 1; o < 64; o <<= 1) v += __shfl_xor(v, o);
    return v;
}
__device__ __forceinline__ float sigmoidf_(float x) { return __builtin_amdgcn_rcpf(1.f + __expf(-x)); }

#define XB_TMO      128
#define XB_XCNT(j)  (256  + 64 * (j))
#define XB_XSUB(j)  (1280 + 64 * (j))
#define XB_XGEN(j)  (2304 + 64 * (j))
#define XB_TOP      3328
#define XB_TOPGEN   3392
#define XCD_BAR_WORDS 3456
#define XB_SPIN_CAP (1u << 22)

__device__ __forceinline__ unsigned xb_ld(unsigned* p)              { return __hip_atomic_load(p, __ATOMIC_RELAXED, __HIP_MEMORY_SCOPE_AGENT); }
__device__ __forceinline__ unsigned xb_add(unsigned* p, unsigned v) { return __hip_atomic_fetch_add(p, v, __ATOMIC_RELAXED, __HIP_MEMORY_SCOPE_AGENT); }
__device__ __forceinline__ unsigned xb_xcc_id() { return (unsigned)__builtin_amdgcn_s_getreg((3 << 11) | 20) & 0xFu; }
#define XB_SPIN(cond, bar) do { unsigned _sp = 0; while (cond) { __builtin_amdgcn_s_sleep(1); \
    if ((++_sp & 255u) == 0u) { if (xb_ld(&(bar)[XB_TMO])) break; if (_sp > XB_SPIN_CAP) { atomicAdd(&(bar)[XB_TMO], 1u); break; } } } } while (0)

struct XcdBarrier { unsigned* bar; unsigned x; volatile LAS unsigned* st; };

__device__ __forceinline__ XcdBarrier xcd_barrier_post(unsigned* bar, volatile LAS unsigned* st) {
    XcdBarrier b; b.bar = bar; b.x = xb_xcc_id(); b.st = st;
    if (threadIdx.x == 0) (void)xb_add(&bar[XB_XCNT(b.x)], 1u);
    return b;
}
__device__ __forceinline__ void xcd_barrier_complete(unsigned* bar, unsigned x, unsigned& nloc, unsigned& nx) {
    const unsigned G = gridDim.x * gridDim.y * gridDim.z;
    unsigned sum, cnt, mine, sp = 0u;
    for (;;) {
        sum = 0u; cnt = 0u; mine = 0u;
#pragma unroll
        for (unsigned j = 0; j < 16; ++j) { const unsigned c = xb_ld(&bar[XB_XCNT(j)]); sum += c; cnt += (c > 0u) ? 1u : 0u; mine = (j == x) ? c : mine; }
        if (sum == G) break;
        __builtin_amdgcn_s_sleep(1);
        if ((++sp & 255u) == 0u) { if (xb_ld(&bar[XB_TMO])) break; if (sp > XB_SPIN_CAP) { atomicAdd(&bar[XB_TMO], 1u); break; } }
    }
    nloc = mine > 0u ? mine : 1u; nx = cnt > 0u ? cnt : 1u;
}
__device__ __forceinline__ void xcd_barrier(const XcdBarrier& b) {
    asm volatile("s_waitcnt vmcnt(0)" ::: "memory");
    __syncthreads();
    if (threadIdx.x == 0) {
        unsigned* bar = b.bar;
        __builtin_amdgcn_s_waitcnt(0);
        unsigned nloc = b.st[0], nx = b.st[1];
        if (nloc == 0u) { xcd_barrier_complete(bar, b.x, nloc, nx); b.st[0] = nloc; b.st[1] = nx; }
        const unsigned old = xb_add(&bar[XB_XSUB(b.x)], 1u);
        const unsigned gen = old / nloc;
        if (old + 1u == (gen + 1u) * nloc) {
            __builtin_amdgcn_fence(__ATOMIC_RELEASE, "agent");
            asm volatile("s_waitcnt vmcnt(0)" ::: "memory");
            const unsigned og = xb_add(&bar[XB_TOP], 1u);
            const unsigned tg = og / nx;
            if (og + 1u == (tg + 1u) * nx) xb_add(&bar[XB_TOPGEN], 1u);
            else XB_SPIN(xb_ld(&bar[XB_TOPGEN]) == tg, bar);
            __builtin_amdgcn_fence(__ATOMIC_ACQUIRE, "agent");
            xb_add(&bar[XB_XGEN(b.x)], 1u);
            asm volatile("s_waitcnt vmcnt(0)" ::: "memory");
        } else {
            XB_SPIN(xb_ld(&bar[XB_XGEN(b.x)]) == gen, bar);
            __builtin_amdgcn_fence(__ATOMIC_ACQUIRE, "agent");
            asm volatile("s_waitcnt vmcnt(0)" ::: "memory");
        }
    }
    __syncthreads();
}

namespace pg8 {
constexpr int BM = 256, BK = 64, HALF = 128, HTB = HALF * BK * 2, STAGE_BYTES = 8 * HTB, NXCD = 8, WGM = 8;
__host__ __device__ __forceinline__ int lds_byte(int r, int c) { const int st = (r >> 4) * 2 + (c >> 5), rr = r & 15, cc = c & 31, ob = rr * 64 + cc * 2; return st * 1024 + (ob ^ (((ob >> 9) & 1) << 5)); }
__host__ __device__ __forceinline__ void stage_rc(int b, int& R, int& C) { const int st = b / 1024, sb = b % 1024, swz = sb ^ (((sb >> 9) & 1) << 5); R = (st >> 1) * 16 + swz / 64; C = (st & 1) * 32 + (swz % 64) / 2; }
__host__ __device__ __forceinline__ int perm32(int rho) { const int n = rho >> 4, i = rho & 15; return 8 * (i >> 2) + 4 * n + (i & 3); }

struct Unit { int pm, pn; };
struct StaticOrder {
    int nM, nN, nwg, G, c, wgm, pm0, rev;
    __host__ __device__ void init(int nM_, int nN_, int G_, int c_, int wgm_ = WGM, int pm0_ = 0, int rev_ = 0) { nM = nM_; nN = nN_; nwg = nM * nN; G = G_; c = c_; wgm = wgm_; pm0 = pm0_; rev = rev_; }
    __host__ __device__ bool next(int i, Unit& u) const {
        const long L = (long)i * G + c; if (L >= nwg) return false;
        int wgid = (int)L; { const int q = nwg / NXCD, r = nwg % NXCD, xcd = wgid % NXCD, off = wgid / NXCD; wgid = (xcd < r ? xcd * (q + 1) : r * (q + 1) + (xcd - r) * q) + off; }
        const int nig = wgm * nN, gid = wgid / nig, fm = gid * wgm, gsz = (nM - fm) < wgm ? (nM - fm) : wgm;
        const int pmi = fm + ((wgid % nig) % gsz); u.pm = pm0 + (rev ? nM - 1 - pmi : pmi); u.pn = (wgid % nig) / gsz; return true;
    }
};
struct OpPlain {
    const bf16* base; int ld; bool isA;
    __device__ __forceinline__ const char* tile(const Unit& u) const { return (const char*)base + (size_t)(isA ? u.pm : u.pn) * 256 * ld * 2; }
    __device__ __forceinline__ unsigned voff(int R, int C) const { return (unsigned)(R * ld + C) * 2u; }
    __device__ __forceinline__ size_t hstep() const { return (size_t)HALF * ld * 2; }
    __device__ __forceinline__ size_t kstep() const { return 128; }
};

template <class AOp, class BOp, class Epi, class Sched>
__device__ __forceinline__ void gemm_phase(LAS unsigned char* lds, const int K, const AOp& Aop, const BOp& Bop, const Sched& S, const Epi& E) {
    int tid = threadIdx.x; asm volatile("" : "+v"(tid));
    const int wid = __builtin_amdgcn_readfirstlane(tid >> 6), lane = tid & 63, wr = wid >> 2, wc = wid & 3, fr = lane & 15, fq = lane >> 4;
    int nt = K / BK; asm volatile("" : "+s"(nt));
    unsigned voffA[2], voffB[2];
#pragma unroll
    for (int i = 0; i < 2; ++i) { int R, C; stage_rc(tid * 16 + i * 8192, R, C); const int Rb = Epi::PERM ? ((R & ~31) + perm32(R & 31)) : R;
        voffA[i] = Aop.voff(R, C); voffB[i] = Bop.voff(Rb, C); }
    const size_t kstepA = Aop.kstep(), kstepB = Bop.kstep();
    const size_t hstepA = Aop.hstep(), hstepB = Bop.hstep();
    const unsigned ldsw = (unsigned)wid * 1024u;
    const int aoff = lds_byte(wr * 64 + fr, fq * 8), boff = lds_byte(wc * 32 + fr, fq * 8);
#define PG8_SA(b, h) (((b) * 2 + (h)) * HTB)
#define PG8_SB(b, h) ((4 + (b) * 2 + (h)) * HTB)
#define PG8_STAGE(bufoff, gbase, voff) do { _Pragma("unroll") for (int _i = 0; _i < 2; ++_i) \
        __builtin_amdgcn_global_load_lds((const unsigned*)((const char*)(gbase) + (voff)[_i]), (LAS unsigned*)(lds + (bufoff) + ldsw + _i * 8192), 16, 0, 0); } while (0)
#define PG8_LDA(dst, b, h) do { _Pragma("unroll") for (int m = 0; m < 4; ++m) _Pragma("unroll") for (int k = 0; k < 2; ++k) dst[m][k] = *(const LAS bf16x8*)(lds + PG8_SA(b, h) + aoff + m * 2048 + k * 1024); } while (0)
#define PG8_LDB(dst, b, h) do { _Pragma("unroll") for (int n = 0; n < 2; ++n) _Pragma("unroll") for (int k = 0; k < 2; ++k) dst[n][k] = *(const LAS bf16x8*)(lds + PG8_SB(b, h) + boff + n * 2048 + k * 1024); } while (0)
#define PG8_MMA(ai, bj, At, Bt) do { __builtin_amdgcn_s_setprio(1); _Pragma("unroll") for (int m = 0; m < 4; ++m) _Pragma("unroll") for (int n = 0; n < 2; ++n) _Pragma("unroll") for (int k = 0; k < 2; ++k) \
        acc[ai][bj][m][n] = __builtin_amdgcn_mfma_f32_16x16x32_bf16(Bt[n][k], At[m][k], acc[ai][bj][m][n], 0, 0, 0); __builtin_amdgcn_s_setprio(0); } while (0)
#define PG8_WAIT_V(n) asm volatile("s_waitcnt vmcnt(" #n ")" ::: "memory")
#define PG8_WAIT_L(n) asm volatile("s_waitcnt lgkmcnt(" #n ")" ::: "memory")
#define PG8_BAR __builtin_amdgcn_s_barrier()
#define PG8_SCHED __builtin_amdgcn_sched_barrier(0)
    Unit cur, nxt; int ui = 0;
    if (!S.next(0, cur)) return;
    f32x4 acc[2][2][4][2];
#pragma unroll
    for (int a = 0; a < 2; ++a)
#pragma unroll
        for (int b = 0; b < 2; ++b)
#pragma unroll
            for (int m = 0; m < 4; ++m)
#pragma unroll
                for (int n = 0; n < 2; ++n) acc[a][b][m][n] = (f32x4){0.f, 0.f, 0.f, 0.f};
    bf16x8 At[4][2], B0[2][2], B1[2][2];
    const char* cA = Aop.tile(cur); const char* cB = Bop.tile(cur);
    PG8_STAGE(PG8_SB(0, 0), cB, voffB); PG8_STAGE(PG8_SB(0, 1), cB + hstepB, voffB); PG8_STAGE(PG8_SA(0, 0), cA, voffA); PG8_STAGE(PG8_SA(0, 1), cA + hstepA, voffA);
    if (wr == 1) PG8_BAR;
    PG8_WAIT_V(2); PG8_BAR;
    PG8_STAGE(PG8_SB(1, 0), cB + kstepB, voffB); PG8_STAGE(PG8_SA(1, 0), cA + kstepA, voffA); PG8_STAGE(PG8_SB(1, 1), cB + hstepB + kstepB, voffB);
    PG8_WAIT_V(6); PG8_BAR;
    for (;;) {
        const bool has_next = S.next(ui + 1, nxt);
        const char* nA = has_next ? Aop.tile(nxt) : cA; const char* nB = has_next ? Bop.tile(nxt) : cB;
#pragma unroll 1
        for (int t = 0; t < nt; t += 2) {
            const bool last = (t == nt - 2);
            const char* a1 = cA + (size_t)(t + 1) * kstepA;
            const char* a2 = last ? nA : cA + (size_t)(t + 2) * kstepA; const char* b2 = last ? nB : cB + (size_t)(t + 2) * kstepB;
            const char* a3 = a2 + kstepA; const char* b3 = b2 + kstepB;
            PG8_LDB(B0, 0, 0); PG8_LDB(B1, 0, 1); PG8_SCHED; PG8_LDA(At, 0, 0); PG8_STAGE(PG8_SA(1, 1), a1 + hstepA, voffA);
            PG8_WAIT_V(8); PG8_WAIT_L(0); PG8_BAR; PG8_MMA(0, 0, At, B0); PG8_MMA(0, 1, At, B1); PG8_BAR; PG8_SCHED;
            PG8_LDA(At, 0, 1); PG8_STAGE(PG8_SB(0, 0), b2, voffB); PG8_STAGE(PG8_SB(0, 1), b2 + hstepB, voffB); PG8_STAGE(PG8_SA(0, 0), a2, voffA);
            PG8_WAIT_V(8); PG8_WAIT_L(0); PG8_BAR; PG8_MMA(1, 0, At, B0); PG8_MMA(1, 1, At, B1); PG8_BAR; PG8_SCHED;
            PG8_LDB(B0, 1, 0); PG8_LDB(B1, 1, 1); PG8_SCHED; PG8_LDA(At, 1, 0); PG8_STAGE(PG8_SA(0, 1), a2 + hstepA, voffA);
            PG8_WAIT_V(8); PG8_WAIT_L(0); PG8_BAR; PG8_MMA(0, 0, At, B0); PG8_MMA(0, 1, At, B1); PG8_BAR; PG8_SCHED;
            PG8_LDA(At, 1, 1); PG8_STAGE(PG8_SB(1, 0), b3, voffB); PG8_STAGE(PG8_SB(1, 1), b3 + hstepB, voffB); PG8_STAGE(PG8_SA(1, 0), a3, voffA);
            PG8_WAIT_V(8); PG8_WAIT_L(0); PG8_BAR; PG8_MMA(1, 0, At, B0); PG8_MMA(1, 1, At, B1); PG8_BAR; PG8_SCHED;
        }
        if (wr == 0) PG8_BAR;
        E(acc, cur, wr, wc, fr, fq);
        if (!has_next) break;
#pragma unroll
        for (int a = 0; a < 2; ++a)
#pragma unroll
            for (int b = 0; b < 2; ++b)
#pragma unroll
                for (int m = 0; m < 4; ++m)
#pragma unroll
                    for (int n = 0; n < 2; ++n) acc[a][b][m][n] = (f32x4){0.f, 0.f, 0.f, 0.f};
        cur = nxt; cA = nA; cB = nB; ++ui;
        if (wr == 1) PG8_BAR;
    }
    PG8_WAIT_V(0);
    PG8_BAR;
#undef PG8_SA
#undef PG8_SB
#undef PG8_STAGE
#undef PG8_LDA
#undef PG8_LDB
#undef PG8_MMA
#undef PG8_WAIT_V
#undef PG8_WAIT_L
#undef PG8_BAR
#undef PG8_SCHED
}
}

constexpr int RING_OFF = 0, RING_BYTES = 131072;
constexpr int LDSCTL_OFF = 160 * 1024 - 64;
constexpr int LDS_BYTES = 160 * 1024;

struct Args { const float* in[28]; float* out; unsigned char* ws; int ph_lo, ph_hi; };
struct Frame {
    LAS unsigned char* lds;
    volatile LAS unsigned* MISC;
    unsigned* ctl;
    int vcu, G;
    float* out; unsigned char* ws; const float* modb;
};
struct ModRef { const float* modp; const float* modb; const float* modv; };
__device__ __forceinline__ f32x4 modv4(const ModRef& M, int layer, int who, int col  ) {
    const float* p = M.modp + ((size_t)(layer * 3 + who)) * NMODV + col;
    f32x4 s = *(const f32x4*)(M.modb + (size_t)layer * NMODV + col);
#pragma unroll
    for (int q = 0; q < 4; ++q) s += *(const f32x4*)(p + (size_t)q * 6 * NMODV);
    return s;
}
__device__ __forceinline__ f32x4 modvF(const ModRef& M, int layer, int who, int col) { return *(const f32x4*)(M.modv + ((size_t)(layer * 3 + who)) * NMODV + col); }
__device__ __forceinline__ int who_of_row(int r) { return r < SEQ ? 0 : (r < ML ? 1 : 2); }

struct EpiSwiGLU {
    static constexpr bool PERM = true;
    bf16* H;
    __device__ __forceinline__ void operator()(const f32x4 (&acc)[2][2][4][2], const pg8::Unit& u, int wr, int wc, int fr, int fq) const {
        const int rl0 = wr * 64 + fr; const size_t tb = ((size_t)u.pm * HKT + 2 * u.pn + (wc >> 1)) * 16384 + 32 * (wc & 1) + 8 * fq;
#pragma unroll
        for (int ai = 0; ai < 2; ++ai)
#pragma unroll
            for (int m = 0; m < 4; ++m) {
                bf16* rowp = H + tb + (size_t)(rl0 + ai * 128 + m * 16) * 64;
                float h[8];
#pragma unroll
                for (int n = 0; n < 2; ++n)
#pragma unroll
                    for (int e = 0; e < 4; ++e) { const float g = acc[ai][0][m][n][e], up = acc[ai][1][m][n][e]; h[4 * n + e] = g * sigmoidf_(g) * up; }
                v4u w; w.x = pk2(h[0], h[1]); w.y = pk2(h[2], h[3]); w.z = pk2(h[4], h[5]); w.w = pk2(h[6], h[7]);
                *(v4u*)rowp = w;
            }
    }
};
template <bool HAS_BIAS, bool HALF, bool DRY = false> struct EpiResid {
    static constexpr bool PERM = false;
    ModRef MR; const float* baseL; const float* baseC; float* outL; float* outC; const float* bias; int layer, gidx;
    __device__ __forceinline__ void operator()(const f32x4 (&acc)[2][2][4][2], const pg8::Unit& u, int wr, int wc, int fr, int fq) const {
        const int who = u.pm < 64 ? 0 : (u.pm < 128 ? 1 : 2);
        const bool isl = u.pm < 128;
        const int rbase = (isl ? u.pm : u.pm - 128) * 256 + wr * 64 + fr;
        const float* bp = isl ? baseL : baseC; float* op = isl ? outL : outC;
        const int col0 = u.pn * 256 + wc * 32 + 4 * fq;
        f32x4 gv[2][2], bv[2][2];
#pragma unroll
        for (int bj = 0; bj < 2; ++bj)
#pragma unroll
            for (int n = 0; n < 2; ++n) { gv[bj][n] = modvF(MR, layer, who, gidx * D + col0 + bj * 128 + n * 16) * (HALF ? 0.5f : 1.0f);
                bv[bj][n] = (f32x4){0.f, 0.f, 0.f, 0.f}; if (HAS_BIAS) bv[bj][n] = *(const f32x4*)(bias + col0 + bj * 128 + n * 16); }
#pragma unroll
        for (int ai = 0; ai < 2; ++ai) {
            f32x4 bs[4][2][2];
#pragma unroll
            for (int m = 0; m < 4; ++m)
#pragma unroll
                for (int bj = 0; bj < 2; ++bj)
#pragma unroll
                    for (int n = 0; n < 2; ++n) bs[m][bj][n] = *(const f32x4*)(bp + (size_t)(rbase + ai * 128 + m * 16) * D + col0 + bj * 128 + n * 16);
#pragma unroll
            for (int m = 0; m < 4; ++m) asm volatile("" : "+v"(bs[m][0][0]), "+v"(bs[m][0][1]), "+v"(bs[m][1][0]), "+v"(bs[m][1][1]));
#pragma unroll
            for (int m = 0; m < 4; ++m)
#pragma unroll
                for (int bj = 0; bj < 2; ++bj)
#pragma unroll
                    for (int n = 0; n < 2; ++n) { const f32x4 o_ = bs[m][bj][n] + gv[bj][n] * (acc[ai][bj][m][n] + bv[bj][n]);
                        if (!DRY || o_.x == 123456.789f) *(f32x4*)(op + (size_t)(rbase + ai * 128 + m * 16) * D + col0 + bj * 128 + n * 16) = o_; }
            asm volatile("" ::: "memory");
        }
    }
};

template <bool HAS_BIAS, bool HALF, int NX> struct EpiResidNorm {
    static constexpr bool PERM = false;
    ModRef MR; const float* baseL; float* outL; const float* bias; int layer, gidx;
    const float* nw; int nlayer, sidx; bf16* HN; float* RSTD; float* PS; unsigned* cnt; LAS unsigned char* sl;
    __device__ __forceinline__ void operator()(const f32x4 (&acc)[2][2][4][2], const pg8::Unit& u, int wr, int wc, int fr_, int fq_) const {
        int fr = fr_, fq = fq_; asm volatile("" : "+v"(fr), "+v"(fq));
        const int who = u.pm < 64 ? 0 : 1;
        const int rbase = u.pm * 256 + wr * 64 + fr;
        const int col0 = u.pn * 256 + wc * 32 + 4 * fq;
        const unsigned eo0 = (unsigned)(rbase * D + col0) * 4u;
        f32x4 xn[2][2][4][2]; float ssq[2][4];
        {
            f32x4 gv[2][2];
#pragma unroll
            for (int bj = 0; bj < 2; ++bj)
#pragma unroll
                for (int n = 0; n < 2; ++n) { gv[bj][n] = modvF(MR, layer, who, gidx * D + col0 + bj * 128 + n * 16) * (HALF ? 0.5f : 1.0f);
                    f32x4 bv = (f32x4){0.f, 0.f, 0.f, 0.f}; if (HAS_BIAS) bv = *(const f32x4*)(bias + col0 + bj * 128 + n * 16);
#pragma unroll
                    for (int ai = 0; ai < 2; ++ai)
#pragma unroll
                        for (int m = 0; m < 4; ++m) { xn[ai][bj][m][n] = acc[ai][bj][m][n]; if (HAS_BIAS) xn[ai][bj][m][n] += bv; } }
#pragma unroll
            for (int ai = 0; ai < 2; ++ai) {
                f32x4 bs[4][2][2];
#pragma unroll
                for (int m = 0; m < 4; ++m)
#pragma unroll
                    for (int bj = 0; bj < 2; ++bj)
#pragma unroll
                        for (int n = 0; n < 2; ++n) bs[m][bj][n] = *(const f32x4*)((const char*)baseL + (size_t)(eo0 + (unsigned)((ai * 128 + m * 16) * D) * 4u) + (bj * 128 + n * 16) * 4);
#pragma unroll
                for (int m = 0; m < 4; ++m) asm volatile("" : "+v"(bs[m][0][0]), "+v"(bs[m][0][1]), "+v"(bs[m][1][0]), "+v"(bs[m][1][1]));
#pragma unroll
                for (int m = 0; m < 4; ++m) { float sq = 0.f;
#pragma unroll
                    for (int bj = 0; bj < 2; ++bj)
#pragma unroll
                        for (int n = 0; n < 2; ++n) { const f32x4 o_ = bs[m][bj][n] + gv[bj][n] * xn[ai][bj][m][n];
                            *(f32x4*)((char*)outL + (size_t)(eo0 + (unsigned)((ai * 128 + m * 16) * D) * 4u) + (bj * 128 + n * 16) * 4) = o_;
                            xn[ai][bj][m][n] = o_; sq += (o_.x * o_.x + o_.y * o_.y) + (o_.z * o_.z + o_.w * o_.w); }
                    ssq[ai][m] = sq; }
                asm volatile("" ::: "memory");
            }
        }
        f32x4 a4[2][2], b4[2][2];
        if (NX != 3) {
#pragma unroll
            for (int bj = 0; bj < 2; ++bj)
#pragma unroll
                for (int n = 0; n < 2; ++n) { const int col = col0 + bj * 128 + n * 16;
                    a4[bj][n] = *(const f32x4*)(nw + col); b4[bj][n] = (f32x4){0.f, 0.f, 0.f, 0.f};
                    if (NX != 4) { a4[bj][n] = a4[bj][n] * (modvF(MR, nlayer, who, (sidx + 1) * D + col) + 1.f); b4[bj][n] = modvF(MR, nlayer, who, sidx * D + col); } }
        }
        LAS float* P = (LAS float*)sl; LAS float* RS = P + 1024;
#pragma unroll
        for (int ai = 0; ai < 2; ++ai)
#pragma unroll
            for (int m = 0; m < 4; ++m) { float v = ssq[ai][m]; v += __shfl_xor(v, 16); v += __shfl_xor(v, 32); if (fq == 0) P[wc * 256 + ai * 128 + wr * 64 + m * 16 + fr] = v; }
        LDS_WAIT(); __builtin_amdgcn_s_barrier(); asm volatile("" ::: "memory");
        const int wid = wr * 4 + wc, t = wid * 64 + fq * 16 + fr;
        if (wid < 4) {
            const float v = (P[t] + P[256 + t]) + (P[512 + t] + P[768 + t]);
            unsigned* slot = (unsigned*)PS + (size_t)u.pm * 2048 + t;
            __hip_atomic_store(slot + u.pn * 256, __float_as_uint(v) | 1u, __ATOMIC_RELAXED, __HIP_MEMORY_SCOPE_AGENT);
            float tot = 0.f;
            for (int it = 0; it < (1 << 20); ++it) { unsigned w[8]; bool ok = true;
#pragma unroll
                for (int j = 0; j < 8; ++j) { w[j] = __hip_atomic_load(slot + j * 256, __ATOMIC_RELAXED, __HIP_MEMORY_SCOPE_AGENT); ok = ok && (w[j] != 0u); }
                if (__all(ok)) { tot = ((__uint_as_float(w[0]) + __uint_as_float(w[1])) + (__uint_as_float(w[2]) + __uint_as_float(w[3]))) + ((__uint_as_float(w[4]) + __uint_as_float(w[5])) + (__uint_as_float(w[6]) + __uint_as_float(w[7]))); break; }
                __builtin_amdgcn_s_sleep(1); }
            const float rstd = 1.0f / sqrtf(tot * (1.f / D) + NORM_EPS); RS[t] = rstd;
            if (NX == 3 && u.pn == 0) RSTD[u.pm * 256 + t] = rstd; }
        LDS_WAIT(); __builtin_amdgcn_s_barrier(); asm volatile("" ::: "memory");
        if (NX == 3) return;
        asm volatile("" : "+v"(fr), "+v"(fq));
        const int rl0 = wr * 64 + fr, cb = u.pn * 256 + wc * 32 + 4 * fq;
        float rs[2][4];
#pragma unroll
        for (int ai = 0; ai < 2; ++ai)
#pragma unroll
            for (int m = 0; m < 4; ++m) rs[ai][m] = RS[ai * 128 + m * 16 + rl0];
#pragma unroll
        for (int bj = 0; bj < 2; ++bj)
#pragma unroll
            for (int n = 0; n < 2; ++n) { const int col = cb + bj * 128 + n * 16;
#pragma unroll
                for (int ai = 0; ai < 2; ++ai)
#pragma unroll
                    for (int m = 0; m < 4; ++m) { const int rl = ai * 128 + m * 16 + rl0; const f32x4 o_ = xn[ai][bj][m][n] * rs[ai][m] * a4[bj][n] + b4[bj][n];
                        if (NX == 4) *(f32x4*)((char*)outL + (unsigned)((u.pm * 256 + rl) * D + col) * 4u) = o_;
                        else { f32x2 w; w.x = __uint_as_float(pk2(o_.x, o_.y)); w.y = __uint_as_float(pk2(o_.z, o_.w));
                            if (NX == 1) *(f32x2*)((char*)HN + (unsigned)((u.pm * (D / 64) + (col >> 6)) * 16384 + rl * 64 + (col & 63)) * 2u) = w;
                            else *(f32x2*)((char*)HN + (unsigned)((u.pm * 256 + rl) * D + col) * 2u) = w; } }
                asm volatile("" ::: "memory"); }
    }
};

struct OpHBlk {
    const bf16* base; int pm0, kt0;
    __device__ __forceinline__ const char* tile(const pg8::Unit& u) const { return (const char*)base + ((size_t)(pm0 < 0 ? u.pm : pm0 + (u.pm & 1)) * HKT + (pm0 < 0 ? 0 : (u.pm >> 1) * kt0)) * 32768; }
    __device__ __forceinline__ unsigned voff(int R, int C) const { return (unsigned)(R * 64 + C) * 2u; }
    __device__ __forceinline__ size_t hstep() const { return 16384; }
    __device__ __forceinline__ size_t kstep() const { return 32768; }
};
struct OpBlk {
    const bf16* base; int nkt; bool isA;
    __device__ __forceinline__ const char* tile(const pg8::Unit& u) const { return (const char*)base + (size_t)(isA ? u.pm : u.pn) * nkt * 32768; }
    __device__ __forceinline__ unsigned voff(int R, int C) const { return (unsigned)(R * 64 + C) * 2u; }
    __device__ __forceinline__ size_t hstep() const { return 16384; }
    __device__ __forceinline__ size_t kstep() const { return 32768; }
};
struct OpBlkK {
    const bf16* base; int nkt;
    __device__ __forceinline__ const char* tile(const pg8::Unit& u) const { return (const char*)base + ((size_t)(u.pn & 7) * nkt + (size_t)(u.pn >> 3) * (nkt / 4)) * 32768; }
    __device__ __forceinline__ unsigned voff(int R, int C) const { return (unsigned)(R * 64 + C) * 2u; }
    __device__ __forceinline__ size_t hstep() const { return 16384; }
    __device__ __forceinline__ size_t kstep() const { return 32768; }
};
struct OrderCtxK { int G, c; __device__ __forceinline__ bool next(int i, pg8::Unit& u) const { const int L = i * G + c; if (L >= 64) return false; const int kq = L >> 4; u.pm = (L & 1) + 2 * kq; u.pn = ((L >> 1) & 7) + 8 * kq; return true; } };
struct OpKSplit {
    const bf16* base; int ld, klen; bool isA;
    __device__ __forceinline__ const char* tile(const pg8::Unit& u) const { const int t = isA ? (u.pm & 1) : (u.pn & 7), kq = isA ? (u.pm >> 1) : (u.pn >> 3); return (const char*)base + ((size_t)t * 256 * ld + (size_t)kq * klen) * 2; }
    __device__ __forceinline__ unsigned voff(int R, int C) const { return (unsigned)(R * ld + C) * 2u; }
    __device__ __forceinline__ size_t hstep() const { return (size_t)128 * ld * 2; }
    __device__ __forceinline__ size_t kstep() const { return 128; }
};
template <bool HAS_BIAS, bool HALF> struct EpiCtxAtomic {
    static constexpr bool PERM = false;
    ModRef MR; float* XC; const float* bias; int layer, gidx;
    __device__ __forceinline__ void operator()(const f32x4 (&acc)[2][2][4][2], const pg8::Unit& u, int wr, int wc, int fr, int fq) const {
        const int panel = u.pm & 1, ct = u.pn & 7, kq = u.pn >> 3;
        const int rbase = panel * 256 + wr * 64 + fr, col0 = ct * 256 + wc * 32 + 4 * fq;
#pragma unroll
        for (int bj = 0; bj < 2; ++bj)
#pragma unroll
            for (int n = 0; n < 2; ++n) {
                const f32x4 gv = modvF(MR, layer, 2, gidx * D + col0 + bj * 128 + n * 16) * (HALF ? 0.5f : 1.0f);
                f32x4 bv = {0.f, 0.f, 0.f, 0.f}; if (HAS_BIAS) { if (kq == 0) bv = *(const f32x4*)(bias + col0 + bj * 128 + n * 16); }
#pragma unroll
                for (int ai = 0; ai < 2; ++ai)
#pragma unroll
                    for (int m = 0; m < 4; ++m) { float* op = XC + (size_t)(rbase + ai * 128 + m * 16) * D + col0 + bj * 128 + n * 16; const f32x4 v = gv * (acc[ai][bj][m][n] + bv);
#pragma unroll
                        for (int e = 0; e < 4; ++e) (void)__hip_atomic_fetch_add(op + e, v[e], __ATOMIC_RELAXED, __HIP_MEMORY_SCOPE_AGENT); }
            }
    }
};

struct OpFixed {
    const bf16* base; int ld; int alt;
    __device__ __forceinline__ const char* tile(const pg8::Unit& u) const { return (const char*)base + (size_t)(alt ? (u.pm & 1) : 0) * 256 * ld * 2; }
    __device__ __forceinline__ unsigned voff(int R, int C) const { return (unsigned)(R * ld + C) * 2u; }
    __device__ __forceinline__ size_t hstep() const { return (size_t)128 * ld * 2; }
    __device__ __forceinline__ size_t kstep() const { return 128; }
};
struct OpChanL {
    const bf16* hn;
    __device__ __forceinline__ const char* tile(const pg8::Unit& u) const { return (const char*)hn + ((size_t)((u.pn >> 6) * SEQ + 2 * (u.pn & 63)) * D + (u.pm >> 1) * 256) * 2; }
    __device__ __forceinline__ unsigned voff(int R, int C) const { return (unsigned)(128 * R * D + C) * 2u; }
    __device__ __forceinline__ size_t hstep() const { return (size_t)D * 2; }
    __device__ __forceinline__ size_t kstep() const { return 128; }
};
struct OpChanC {
    const bf16* hn;
    __device__ __forceinline__ const char* tile(const pg8::Unit& u) const { return (const char*)hn + ((size_t)(ML + u.pn * CTXL) * D + (u.pm >> 1) * 256) * 2; }
    __device__ __forceinline__ unsigned voff(int R, int C) const { return (unsigned)(R * D + C) * 2u; }
    __device__ __forceinline__ size_t hstep() const { return (size_t)128 * D * 2; }
    __device__ __forceinline__ size_t kstep() const { return 128; }
};
struct OpStage2B {
    const bf16* T2;
    __device__ __forceinline__ const char* tile(const pg8::Unit& u) const { return (const char*)T2 + ((size_t)(u.pn >> 7) * 256 * 128 + (u.pn & 127)) * 512; }
    __device__ __forceinline__ unsigned voff(int R, int C) const { return (unsigned)R * 65536u + (unsigned)C * 2u; }
    __device__ __forceinline__ size_t hstep() const { return (size_t)128 * 65536; }
    __device__ __forceinline__ size_t kstep() const { return 128; }
};
__device__ __forceinline__ v4u pack8(const f32x4& a, const f32x4& b) { v4u w; w.x = pk2(a.x, a.y); w.y = pk2(a.z, a.w); w.z = pk2(b.x, b.y); w.w = pk2(b.z, b.w); return w; }
struct EpiChanL {
    static constexpr bool PERM = true; bf16* YT;
    __device__ __forceinline__ void operator()(const f32x4 (&acc)[2][2][4][2], const pg8::Unit& u, int wr, int wc, int fr, int fq) const {
        const int g = u.pm >> 1, cs = u.pm & 1, b = u.pn >> 6, n2p = u.pn & 63;
#pragma unroll
        for (int ai = 0; ai < 2; ++ai)
#pragma unroll
            for (int m = 0; m < 4; ++m) { const int kc = 128 * ai + 64 * wr + 16 * m + fr;
#pragma unroll
                for (int bj = 0; bj < 2; ++bj) { const unsigned idx = ((((unsigned)(b * 8 + g) * 256u + kc) * 128u + (2 * n2p + bj)) * 2u + cs) * 128u + 32 * wc + 8 * fq;
                    *(v4u*)((char*)YT + (size_t)(idx * 2u)) = pack8(acc[ai][bj][m][0], acc[ai][bj][m][1]); }
                asm volatile("" ::: "memory"); }
    }
};
struct EpiChanC {
    static constexpr bool PERM = true; bf16* YC;
    __device__ __forceinline__ void operator()(const f32x4 (&acc)[2][2][4][2], const pg8::Unit& u, int wr, int wc, int fr, int fq) const {
        const int g = u.pm >> 1, cs = u.pm & 1, b = u.pn;
#pragma unroll
        for (int ai = 0; ai < 2; ++ai)
#pragma unroll
            for (int m = 0; m < 4; ++m) { const int kc = 128 * ai + 64 * wr + 16 * m + fr;
#pragma unroll
                for (int bj = 0; bj < 2; ++bj) { const unsigned idx = (((unsigned)(b * 8 + g) * 256u + kc) * 2u + cs) * 256u + 128 * bj + 32 * wc + 8 * fq;
                    *(v4u*)((char*)YC + (size_t)(idx * 2u)) = pack8(acc[ai][bj][m][0], acc[ai][bj][m][1]); }
                asm volatile("" ::: "memory"); }
    }
};
struct EpiStage1 {
    static constexpr bool PERM = true; bf16* T2; const float* tw;
    __device__ __forceinline__ void operator()(const f32x4 (&acc)[2][2][4][2], const pg8::Unit& u, int wr, int wc, int fr, int fq) const {
#pragma unroll
        for (int m = 0; m < 4; ++m) { const int k1 = 64 * wr + 16 * m + fr, n20 = 32 * wc + 8 * fq;
#pragma unroll
            for (int n = 0; n < 2; ++n) {
                const f32x4 t0 = *(const f32x4*)((const char*)tw + (size_t)((unsigned)(k1 * 128 + n20 + 4 * n) * 8u));
                const f32x4 t1 = *(const f32x4*)((const char*)tw + (size_t)((unsigned)(k1 * 128 + n20 + 4 * n) * 8u + 16u));
#pragma unroll
                for (int bj = 0; bj < 2; ++bj) { const int chq = 2 * u.pn + bj;
                    const f32x4 tr = acc[0][bj][m][n], ti = acc[1][bj][m][n];
                    const f32x4 c = {t0.x, t0.z, t1.x, t1.z}, sn = {t0.y, t0.w, t1.y, t1.w};
                    const f32x4 ur = tr * c - ti * sn, ui = tr * sn + ti * c;
                    const unsigned idx = (((unsigned)chq * 128u + k1) * 2u) * 128u + n20 + 4 * n;
                    v2u w0; w0.x = pk2(ur.x, ur.y); w0.y = pk2(ur.z, ur.w); v2u w1; w1.x = pk2(ui.x, ui.y); w1.y = pk2(ui.z, ui.w);
                    *(v2u*)((char*)T2 + (size_t)(idx * 2u)) = w0; *(v2u*)((char*)T2 + (size_t)(idx * 2u + 256u)) = w1; }
                asm volatile("" ::: "memory"); } }
    }
};
struct EpiStage2 {
    static constexpr bool PERM = true; bf16* FO;
    __device__ __forceinline__ void operator()(const f32x4 (&acc)[2][2][4][2], const pg8::Unit& u, int wr, int wc, int fr, int fq) const {
        const int bg = u.pn >> 7, k1 = u.pn & 127, b = bg >> 3, g = bg & 7;
#pragma unroll
        for (int m = 0; m < 4; ++m) { const int k2 = 64 * wr + 16 * m + fr; const unsigned row = (unsigned)b * SEQ + k1 + 128 * k2;
#pragma unroll
            for (int bj = 0; bj < 2; ++bj) *(v4u*)((char*)FO + (size_t)((row * D + g * 256 + 128 * bj + 32 * wc + 8 * fq) * 2u)) = pack8(acc[0][bj][m][0], acc[0][bj][m][1]);
            asm volatile("" ::: "memory"); }
    }
};
struct EpiCtxDft {
    static constexpr bool PERM = true; bf16* FO;
    __device__ __forceinline__ void operator()(const f32x4 (&acc)[2][2][4][2], const pg8::Unit& u, int wr, int wc, int fr, int fq) const {
        const int b = u.pn >> 3, g = u.pn & 7;
#pragma unroll
        for (int ai = 0; ai < 2; ++ai)
#pragma unroll
            for (int m = 0; m < 4; ++m) { const int k = 128 * ai + 64 * wr + 16 * m + fr; const unsigned row = (unsigned)ML + b * CTXL + k;
#pragma unroll
                for (int bj = 0; bj < 2; ++bj) *(v4u*)((char*)FO + (size_t)((row * D + g * 256 + 128 * bj + 32 * wc + 8 * fq) * 2u)) = pack8(acc[ai][bj][m][0], acc[ai][bj][m][1]);
                asm volatile("" ::: "memory"); }
    }
};

struct OpXM {
    const bf16* base; int div, add;
    __device__ __forceinline__ const char* tile(const pg8::Unit& u) const { return (const char*)base + (size_t)(add + u.pn / div) * XM_STRIDE + (size_t)u.pm * 256 * D * 2; }
    __device__ __forceinline__ unsigned voff(int R, int C) const { return (unsigned)(R * D + C) * 2u; }
    __device__ __forceinline__ size_t hstep() const { return (size_t)128 * D * 2; }
    __device__ __forceinline__ size_t kstep() const { return 128; }
};
struct OpWSel {
    const bf16* base; int div; size_t stride;
    __device__ __forceinline__ const char* tile(const pg8::Unit& u) const { return (const char*)base + (size_t)(u.pn / div) * stride + (size_t)(u.pn % div) * 256 * D * 2; }
    __device__ __forceinline__ unsigned voff(int R, int C) const { return (unsigned)(R * D + C) * 2u; }
    __device__ __forceinline__ size_t hstep() const { return (size_t)128 * D * 2; }
    __device__ __forceinline__ size_t kstep() const { return 128; }
};
struct EpiLora {
    static constexpr bool PERM = true; bf16* LR;
    __device__ __forceinline__ void operator()(const f32x4 (&acc)[2][2][4][2], const pg8::Unit& u, int wr, int wc, int fr, int fq) const {
        const int which = u.pn; bf16* O = (bf16*)((char*)LR + (size_t)which * LR_STRIDE);
#pragma unroll
        for (int ai = 0; ai < 2; ++ai)
#pragma unroll
            for (int m = 0; m < 4; ++m) { const unsigned row = u.pm * 256 + 128 * ai + 64 * wr + 16 * m + fr;
#pragma unroll
                for (int bj = 0; bj < 2; ++bj) { f32x4 a = acc[ai][bj][m][0], b = acc[ai][bj][m][1];
                    if (which == 0) {
#pragma unroll
                        for (int e = 0; e < 4; ++e) { a[e] = 1.f - 2.f * __builtin_amdgcn_rcpf(1.f + __expf(2.f * a[e])); b[e] = 1.f - 2.f * __builtin_amdgcn_rcpf(1.f + __expf(2.f * b[e])); } }
                    else if (which == 2) {
#pragma unroll
                        for (int e = 0; e < 4; ++e) { a[e] = sigmoidf_(a[e]); b[e] = sigmoidf_(b[e]); } }
                    *(v4u*)((char*)O + (size_t)((row * 256u + 128 * bj + 32 * wc + 8 * fq) * 2u)) = pack8(a, b); }
                asm volatile("" ::: "memory"); }
    }
};
struct EpiRkv {
    static constexpr bool PERM = true; bf16* XM;
    __device__ __forceinline__ void operator()(const f32x4 (&acc)[2][2][4][2], const pg8::Unit& u, int wr, int wc, int fr, int fq) const {
        char* O = (char*)XM + (size_t)(3 + u.pn / 8) * XM_STRIDE; const int colt = (u.pn % 8) * 256;
#pragma unroll
        for (int ai = 0; ai < 2; ++ai)
#pragma unroll
            for (int m = 0; m < 4; ++m) { const unsigned row = u.pm * 256 + 128 * ai + 64 * wr + 16 * m + fr;
#pragma unroll
                for (int bj = 0; bj < 2; ++bj) *(v4u*)(O + (size_t)((row * D + colt + 128 * bj + 32 * wc + 8 * fq) * 2u)) = pack8(acc[ai][bj][m][0], acc[ai][bj][m][1]);
                asm volatile("" ::: "memory"); }
    }
};
struct EpiRkvC {
    static constexpr bool PERM = true; bf16* O;
    __device__ __forceinline__ void operator()(const f32x4 (&acc)[2][2][4][2], const pg8::Unit& u, int wr, int wc, int fr, int fq) const {
        char* Op = (char*)O + (size_t)(u.pn / 8) * MC * D * 2; const int colt = (u.pn % 8) * 256;
#pragma unroll
        for (int ai = 0; ai < 2; ++ai)
#pragma unroll
            for (int m = 0; m < 4; ++m) { const unsigned row = (u.pm - 128) * 256 + 128 * ai + 64 * wr + 16 * m + fr;
#pragma unroll
                for (int bj = 0; bj < 2; ++bj) *(v4u*)(Op + (size_t)((row * D + colt + 128 * bj + 32 * wc + 8 * fq) * 2u)) = pack8(acc[ai][bj][m][0], acc[ai][bj][m][1]);
                asm volatile("" ::: "memory"); }
    }
};
template <bool DRY = false> struct EpiMulG {
    static constexpr bool PERM = true; bf16* PO;
    __device__ __forceinline__ void operator()(const f32x4 (&acc)[2][2][4][2], const pg8::Unit& u, int wr, int wc, int fr, int fq) const {
#pragma unroll
        for (int ai = 0; ai < 2; ++ai)
#pragma unroll
            for (int m = 0; m < 4; ++m) { const unsigned row = u.pm * 256 + 128 * ai + 64 * wr + 16 * m + fr;
#pragma unroll
                for (int bj = 0; bj < 2; ++bj) { v4u* ptr = (v4u*)((char*)PO + (size_t)((row * D + u.pn * 256 + 128 * bj + 32 * wc + 8 * fq) * 2u));
                    const v4u o = *ptr; const f32x4 a = acc[ai][bj][m][0], b = acc[ai][bj][m][1];
                    v4u w; w.x = pk2(bflo(o.x) * a.x, bfhi(o.x) * a.y); w.y = pk2(bflo(o.y) * a.z, bfhi(o.y) * a.w); w.z = pk2(bflo(o.z) * b.x, bfhi(o.z) * b.y); w.w = pk2(bflo(o.w) * b.z, bfhi(o.w) * b.w);
                    if (!DRY || w.x == 0x12345678u) *ptr = w; }
                asm volatile("" ::: "memory"); }
    }
};

__device__ __forceinline__ void phase_rowstats(Frame& F, const float* xl, const float* xc, float* RSTD, int r0) {
    int tid_ = threadIdx.x; asm volatile("" : "+v"(tid_)); const int LANE = tid_ & 63, WAVE = __builtin_amdgcn_readfirstlane(tid_ >> 6);
    const int gw = F.vcu * NWAVES + WAVE, NGW = F.G * NWAVES;
    for (int r = r0 + gw; r < MT; r += NGW) {
        const float* xr = r < ML ? xl + (size_t)r * D : xc + (size_t)(r - ML) * D; float ss = 0.f;
#pragma unroll
        for (int j = 0; j < 8; ++j) { const f32x4 v = *(const f32x4*)(xr + 256 * j + 4 * LANE); ss += (v.x * v.x + v.y * v.y) + (v.z * v.z + v.w * v.w); }
        const float rstd = 1.0f / sqrtf(wave_sum(ss) * (1.f / D) + NORM_EPS);
        if (LANE == 0) RSTD[r] = rstd;
    }
}
__device__ __forceinline__ void phase_mix(Frame& F, const ModRef& MR, const float* xl, const float* xc, const float* RSTD, const float* nw, const float* mu, bf16* XM) {
    int tid_ = threadIdx.x; asm volatile("" : "+v"(tid_)); const int TID = tid_, LANE = tid_ & 63, WAVE = __builtin_amdgcn_readfirstlane(tid_ >> 6);
    LAS float* TA = (LAS float*)(F.lds); LAS float* TB = (LAS float*)(F.lds + 24576); LAS float* TM = (LAS float*)(F.lds + 49152);
    for (int i = TID; i < 3 * D / 4; i += NWAVES * 64) { const int who = i / (D / 4), d = (i % (D / 4)) * 4;
        const f32x4 sh = modvF(MR, 1, who, 3 * D + d), sc = modvF(MR, 1, who, 4 * D + d), g = *(const f32x4*)(nw + d);
        *(LAS f32x4*)(TA + who * D + d) = g * (sc + 1.f); *(LAS f32x4*)(TB + who * D + d) = sh; }
    for (int i = TID; i < 6 * D / 4; i += NWAVES * 64) *(LAS f32x4*)(TM + 4 * i) = *(const f32x4*)(mu + 4 * i);
    __syncthreads();
    const int gw = F.vcu * NWAVES + WAVE, NGW = F.G * NWAVES;
    for (int r = gw; r < MT; r += NGW) {
        const int who = who_of_row(r);
        const bool isl = r < ML; const int t = isl ? (r & (SEQ - 1)) : ((r - ML) & (CTXL - 1));
        const float* xr = isl ? xl + (size_t)r * D : xc + (size_t)(r - ML) * D;
        const float rs = RSTD[r];
#pragma unroll
        for (int j = 0; j < 4; ++j) {
            int dt; bool ok;
            if (isl) { const int gx = t & 63, gy = t >> 6; if (j == 0) { dt = -1; ok = gx > 0; } else if (j == 1) { dt = 1; ok = gx < 63; } else if (j == 2) { dt = -64; ok = gy > 0; } else { dt = 64; ok = gy < SEQ / 64 - 1; } }
            else { if ((j & 1) == 0) { dt = -1; ok = t > 0; } else { dt = 1; ok = t < CTXL - 1; } }
            const int d = 512 * j + 8 * LANE;
            const f32x4 a0 = *(const LAS f32x4*)(TA + who * D + d), a1 = *(const LAS f32x4*)(TA + who * D + d + 4), b0 = *(const LAS f32x4*)(TB + who * D + d), b1 = *(const LAS f32x4*)(TB + who * D + d + 4);
            const f32x4 x0 = *(const f32x4*)(xr + d), x1 = *(const f32x4*)(xr + d + 4);
            const f32x4 h0 = x0 * rs * a0 + b0, h1 = x1 * rs * a1 + b1;
            f32x4 s0 = {0.f, 0.f, 0.f, 0.f}, s1 = s0;
            if (ok) { const float rn = RSTD[r + dt]; const float* xn = xr + (ptrdiff_t)dt * D; const f32x4 y0 = *(const f32x4*)(xn + d), y1 = *(const f32x4*)(xn + d + 4); s0 = y0 * rn * a0 + b0; s1 = y1 * rn * a1 + b1; }
            const f32x4 d0 = s0 - h0, d1 = s1 - h1;
#pragma unroll
            for (int p = 0; p < 6; ++p) { const f32x4 m0 = *(const LAS f32x4*)(TM + p * D + d), m1 = *(const LAS f32x4*)(TM + p * D + d + 4);
                *(v4u*)((char*)XM + (size_t)p * XM_STRIDE + ((size_t)r * D + d) * 2) = pack8(h0 + d0 * m0, h1 + d1 * m1); }
        }
    }
}

constexpr int SCAN_BLK = 12544, SC_WQ = 80, SCAN_NW = 14;
constexpr int SC_NSLOT = 4, SC_SLOT = SCAN_BLK;
constexpr int SC_NPROD_A = 5, SC_NPROD_B = 8, SC_QA = 24, SC_QA0 = 6;
constexpr int SC_WF = 0, SC_CONST = 24576, SC_CTL = SC_CONST + 1280, SC_RING = SC_CTL + 128, SC_PROD_A = SC_RING + SC_NSLOT * SC_SLOT, SC_PROD_B = SC_RING, SC_PSTRIDE = 14592;
constexpr int BLK_AR = 0, BLK_G = 4096, BLK_BK = 6144, BLK_VF = 10240, BLK_PCF = 12288;
static_assert(SC_PROD_A + SC_NPROD_A * SC_PSTRIDE <= LDSCTL_OFF && SC_PROD_B + SC_NPROD_B * SC_PSTRIDE <= LDSCTL_OFF && 4608 + 3072 <= 8192 && 8192 + 6400 <= SC_PSTRIDE, "scan LDS map");
__device__ __forceinline__ int scan_row(int b, int z, int s) { if (s < CTXL) return ML + b * CTXL + (z ? CTXL - 1 - s : s); const int sp = s - CTXL; return b * SEQ + (z ? SEQ - 1 - sp : sp); }
__device__ __forceinline__ int sc_chain(int b) { return ((b & 7) | ((b >> 4) << 3)) & 127; }
__device__ __forceinline__ int sc_half(int b) { return (b >> 3) & 1; }
__device__ __forceinline__ int win_lo(int w) { return w == 0 ? 0 : 16 + SC_WQ * (w - 1); }
__device__ __forceinline__ int win_n(int w) { return w == 0 ? 16 : (w == SCAN_NW - 1 ? 1024 - SC_WQ * (SCAN_NW - 2) : SC_WQ); }
template <int N> __device__ __forceinline__ float dpp_row_shr(float v) { return __int_as_float(__builtin_amdgcn_update_dpp(0, __float_as_int(v), 0x110 + N, 0xf, 0xf, true)); }
__device__ __forceinline__ bf16x8 pack_frag(float a0, float a1, float a2, float a3, float a4, float a5, float a6, float a7) { v4u w; w.x = pk2(a0, a1); w.y = pk2(a2, a3); w.z = pk2(a4, a5); w.w = pk2(a6, a7); return __builtin_bit_cast(bf16x8, w); }
#define MFMA32(a, b, c) __builtin_amdgcn_mfma_f32_32x32x16_bf16((a), (b), (c), 0, 0, 0)
#define MFMA16(a, b, c) __builtin_amdgcn_mfma_f32_16x16x32_bf16((a), (b), (c), 0, 0, 0)

__device__ __forceinline__ void scan_setup(const Frame& F, const Args& AR, int tid) {
    const int chain = sc_chain(blockIdx.x), h = (chain >> 1) & 31, z = chain & 1;
    const bf16* W2UP = (const bf16*)(F.ws + WS_WSMALL + WSM_W2UP); const bf16* A2UP = (const bf16*)(F.ws + WS_WSMALL + WSM_A2UP);
    for (int i = tid; i < 2 * 12 * 64; i += NWAVES * 64) { const int which = i / 768, f = (i / 64) % 12, ln = i & 63, ks = f >> 2, mt = f & 3, tau = ln & 15, g = ln >> 4;
        *(LAS v4u*)(F.lds + SC_WF + i * 16) = *(const v4u*)((which ? A2UP : W2UP) + ((size_t)(z * D + h * 64 + 16 * mt + tau)) * LORA + 32 * ks + 8 * g); }
    for (int i = tid; i < 5 * 64; i += NWAVES * 64) { const int k = i / 64, c = h * 64 + (i & 63);
        ((LAS float*)(F.lds + SC_CONST))[i] = k == 0 ? AR.in[13][z * D + c] : k == 1 ? AR.in[16][z * D + c] : k == 2 ? AR.in[21][c] : k == 3 ? AR.in[22][c] : AR.in[23][c]; }
}
__device__ __forceinline__ void scan_produce(const Frame& F, int w, int pw, int lane_in, bool isA) {
    int lane = lane_in;
    LAS unsigned char* scr = F.lds + (isA ? SC_PROD_A : SC_PROD_B) + pw * SC_PSTRIDE;
    const int nq = win_n(w), lo = win_lo(w), qa = (nq == 16) ? SC_QA0 : (nq * 3) / 8;
    const int nhalf = isA ? qa : nq - qa;
    const bf16* RKV = (const bf16*)(F.ws + WS_ACT + ACT_XM + 3 * XM_STRIDE);
    const bf16* TWb = (const bf16*)(F.ws + WS_ACT + ACT_LR); const bf16* TAb = (const bf16*)(F.ws + WS_ACT + ACT_LR + LR_STRIDE);
    unsigned char* wbuf = F.ws + WS_ACT + ACT_WBUF + (size_t)(w & 1) * WBUF_STRIDE;
    float* SA = (float*)(F.ws + WS_SA);
    const int chain = sc_chain(blockIdx.x), b = chain >> 6, h = (chain >> 1) & 31, z = chain & 1, q0 = isA ? 0 : qa;
    if (blockIdx.x >= 256) return;
    v2u r2n[4], k2n[4], v2n[4]; bf16x8 bwn[3], ban[3];
    const bf16* RK0 = w == 0 ? (const bf16*)(F.ws + WS_RKVC) - (size_t)ML * D : RKV; const size_t RKS = w == 0 ? (size_t)MC * D : (size_t)MT * D;
#define SC_LOADS(qq) do { const int row_ = scan_row(b, z, (lo + (qq)) * 16 + (lane & 15)); \
        const unsigned ob_ = ((unsigned)row_ * D + h * 64 + 4 * (lane >> 4)) * 2u, ol_ = ((unsigned)row_ * 256 + z * 96 + 8 * (lane >> 4)) * 2u; \
        _Pragma("unroll") for (int mt = 0; mt < 4; ++mt) { \
            r2n[mt] = *(const v2u*)((const char*)RK0 + (size_t)(ob_ + 32u * mt)); k2n[mt] = *(const v2u*)((const char*)(RK0 + RKS) + (size_t)(ob_ + 32u * mt)); v2n[mt] = *(const v2u*)((const char*)(RK0 + 2 * RKS) + (size_t)(ob_ + 32u * mt)); } \
        _Pragma("unroll") for (int ks = 0; ks < 3; ++ks) { bwn[ks] = *(const bf16x8*)((const char*)TWb + (size_t)(ol_ + 64u * ks)); ban[ks] = *(const bf16x8*)((const char*)TAb + (size_t)(ol_ + 64u * ks)); } } while (0)
    volatile LAS unsigned* tctr = (volatile LAS unsigned*)(F.lds + SC_CTL + 8);
#define SC_GRAB() ({ unsigned v_ = 0; if (lane == 0) v_ = __hip_atomic_fetch_add((LAS unsigned*)(F.lds + SC_CTL + 8), 1u, __ATOMIC_RELAXED, __HIP_MEMORY_SCOPE_WORKGROUP); (int)__builtin_amdgcn_readfirstlane(v_); })
    int qi = pw, qn = SC_GRAB();
    (void)tctr;
    if (qi < nhalf) SC_LOADS(q0 + qi);
#pragma unroll 1
    for (; qi < nhalf; qi = qn, qn = SC_GRAB()) {
        asm volatile("" : "+v"(lane));
        const int tau = lane & 15, g = lane >> 4;
        const int q = q0 + qi;
        const int row = scan_row(b, z, (lo + q) * 16 + tau);
        unsigned char* blk = wbuf + ((size_t)chain * SC_WQ + q) * SCAN_BLK;
        v2u r2[4], k2[4], v2[4]; bf16x8 bw[3], ba[3];
#pragma unroll
        for (int mt = 0; mt < 4; ++mt) { r2[mt] = r2n[mt]; k2[mt] = k2n[mt]; v2[mt] = v2n[mt]; }
#pragma unroll
        for (int ks = 0; ks < 3; ++ks) { bw[ks] = bwn[ks]; ba[ks] = ban[ks]; }
        if (qn < nhalf) SC_LOADS(q0 + qn);
        f32x4 lw[4], la[4];
#pragma unroll
        for (int mt = 0; mt < 4; ++mt) { lw[mt] = (f32x4){0.f, 0.f, 0.f, 0.f}; la[mt] = lw[mt]; }
        {
            bf16x8 wf[12];
#pragma unroll
            for (int f_ = 0; f_ < 12; ++f_) wf[f_] = *(const LAS bf16x8*)(F.lds + SC_WF + (f_ * 64 + lane) * 16);
            asm volatile("" : "+v"(wf[0]), "+v"(wf[1]), "+v"(wf[2]), "+v"(wf[3]), "+v"(wf[4]), "+v"(wf[5]), "+v"(wf[6]), "+v"(wf[7]), "+v"(wf[8]), "+v"(wf[9]), "+v"(wf[10]), "+v"(wf[11]));
            bf16x8 af[12];
#pragma unroll
            for (int f_ = 0; f_ < 12; ++f_) af[f_] = *(const LAS bf16x8*)(F.lds + SC_WF + ((12 + f_) * 64 + lane) * 16);
#pragma unroll
            for (int ks = 0; ks < 3; ++ks)
#pragma unroll
                for (int mt = 0; mt < 4; ++mt) lw[mt] = MFMA16(wf[ks * 4 + mt], bw[ks], lw[mt]);
            asm volatile("" : "+v"(af[0]), "+v"(af[1]), "+v"(af[2]), "+v"(af[3]), "+v"(af[4]), "+v"(af[5]), "+v"(af[6]), "+v"(af[7]), "+v"(af[8]), "+v"(af[9]), "+v"(af[10]), "+v"(af[11]));
#pragma unroll
            for (int ks = 0; ks < 3; ++ks)
#pragma unroll
                for (int mt = 0; mt < 4; ++mt) la[mt] = MFMA16(af[ks * 4 + mt], ba[ks], la[mt]);
        }
        LAS unsigned char* Xs = scr; LAS unsigned char* Ys = scr + 4096;
        LAS bf16* BKs = (LAS bf16*)(scr + 8192); LAS bf16* VFs = (LAS bf16*)(scr + 8192 + 4096); LAS float* PCs = (LAS float*)(scr + 8192 + 6144);
        float lnw[16], asg[16], kk[16], kd[16]; float ss = 0.f, sap = 0.f;
        f32x4 cw0[4], ca0[4], ckk[4], cka[4], crk[4];
#pragma unroll
        for (int mt = 0; mt < 4; ++mt) { const LAS float* cst = (const LAS float*)(F.lds + SC_CONST) + 16 * mt + 4 * g;
            cw0[mt] = *(const LAS f32x4*)(cst); ca0[mt] = *(const LAS f32x4*)(cst + 64); ckk[mt] = *(const LAS f32x4*)(cst + 128); cka[mt] = *(const LAS f32x4*)(cst + 192); crk[mt] = *(const LAS f32x4*)(cst + 256); }
        asm volatile("" : "+v"(cw0[0]), "+v"(cw0[1]), "+v"(cw0[2]), "+v"(cw0[3]), "+v"(ca0[0]), "+v"(ca0[1]), "+v"(ca0[2]), "+v"(ca0[3]), "+v"(ckk[0]), "+v"(ckk[1]), "+v"(ckk[2]), "+v"(ckk[3]), "+v"(cka[0]), "+v"(cka[1]), "+v"(cka[2]), "+v"(cka[3]), "+v"(crk[0]), "+v"(crk[1]), "+v"(crk[2]), "+v"(crk[3]));
#pragma unroll
        for (int mt = 0; mt < 4; ++mt) {
            const f32x4 w0 = cw0[mt], a0 = ca0[mt], kkc = ckk[mt], kac = cka[mt], rkc = crk[mt];
            const float rv[4] = {bflo(r2[mt].x), bfhi(r2[mt].x), bflo(r2[mt].y), bfhi(r2[mt].y)}, kv[4] = {bflo(k2[mt].x), bfhi(k2[mt].x), bflo(k2[mt].y), bfhi(k2[mt].y)};
#pragma unroll
            for (int e = 0; e < 4; ++e) { const int i = 4 * mt + e;
                lnw[i] = -0.6065306597126334f * sigmoidf_(w0[e] + lw[mt][e]);
                asg[i] = sigmoidf_(a0[e] + la[mt][e]);
                const float kr = kv[e] * kkc[e]; kk[i] = kr; ss += kr * kr;
                kd[i] = kv[e] * (1.f + (asg[i] - 1.f) * kac[e]);
                sap += rv[e] * rkc[e] * kd[i]; } }
        ss += __shfl_xor(ss, 16); ss += __shfl_xor(ss, 32); sap += __shfl_xor(sap, 16); sap += __shfl_xor(sap, 32);
        const float inv = __builtin_amdgcn_rsqf(fmaxf(ss, 1e-24f));
        if (g == 0) SA[((size_t)z * MT + row) * 32 + h] = sap;
        float ec_[16], eC_[16];
#pragma unroll
        for (int i = 0; i < 16; ++i) { float c = lnw[i]; c += dpp_row_shr<1>(c); c += dpp_row_shr<2>(c); c += dpp_row_shr<4>(c); c += dpp_row_shr<8>(c); ec_[i] = __expf(c); }
#pragma unroll
        for (int i = 0; i < 16; ++i) eC_[i] = __shfl(ec_[i], (lane & 48) | 15);
        { const int hh0 = (tau >> 2) & 1, jj0 = 4 * (tau >> 3) + (tau & 3), hh1 = tau >> 3, jj1 = tau & 7;
          LAS bf16* bkb0 = BKs + (4 * g + 32 * hh0) * 8 + jj0; LAS bf16* bkb1 = BKs + 512 + (4 * g + 32 * hh1) * 8 + jj1; LAS bf16* vfb = VFs + (4 * g + 32 * hh1) * 8 + jj1;
#pragma unroll
          for (int mt = 0; mt < 4; ++mt) {
            float at[4], rt[4], bt[4], kt[4];
            const float rv[4] = {bflo(r2[mt].x), bfhi(r2[mt].x), bflo(r2[mt].y), bfhi(r2[mt].y)};
            const unsigned short vraw[4] = {(unsigned short)(v2[mt].x & 0xffffu), (unsigned short)(v2[mt].x >> 16), (unsigned short)(v2[mt].y & 0xffffu), (unsigned short)(v2[mt].y >> 16)};
#pragma unroll
            for (int e = 0; e < 4; ++e) { const int i = 4 * mt + e;
                const float ec = ec_[i], en = __builtin_amdgcn_rcpf(ec);
                const float eprev = __int_as_float(__builtin_amdgcn_update_dpp(0x3f800000, __float_as_int(ec), 0x111, 0xf, 0xf, false));
                const float er = eC_[i] * en;
                const float kki = kk[i] * inv, bb = kki * asg[i];
                at[e] = -kki * eprev; rt[e] = rv[e] * ec; bt[e] = bb * en; kt[e] = kd[i] * en;
                const int eo = ((mt >> 1) * 2) * 512 + (16 * (mt & 1) + e) * 8;
                const unsigned wbk = pk2(bb * er, kd[i] * er);
                bkb0[eo] = (bf16)(wbk & 0xffffu); bkb1[eo] = (bf16)(wbk >> 16);
                vfb[(mt >> 1) * 512 + (16 * (mt & 1) + e) * 8] = vraw[e]; }
            const int jb = (4 * (g >> 1)) * 2, cb = (((2 * mt + (g >> 1)) ^ (tau & 7)) << 4) + 8 * (g & 1);
            v2u wa; wa.x = pk2(at[0], at[1]); wa.y = pk2(at[2], at[3]);
            v2u wq; wq.x = pk2(rt[0], rt[1]); wq.y = pk2(rt[2], rt[3]);
            v2u wb; wb.x = pk2(bt[0], bt[1]); wb.y = pk2(bt[2], bt[3]);
            v2u wk; wk.x = pk2(kt[0], kt[1]); wk.y = pk2(kt[2], kt[3]);
            *(v2u*)(blk + BLK_AR + (mt * 64 + tau + 32 * (g & 1)) * 16 + jb) = wa;
            *(v2u*)(blk + BLK_AR + (mt * 64 + 16 + tau + 32 * (g & 1)) * 16 + jb) = wq;
            *(LAS v2u*)(Xs + tau * 128 + cb) = wa; *(LAS v2u*)(Xs + (16 + tau) * 128 + cb) = wq;
            *(LAS v2u*)(Ys + tau * 128 + cb) = wb; *(LAS v2u*)(Ys + (16 + tau) * 128 + cb) = wk;
          }
          if (tau == 0) {
#pragma unroll
              for (int i = 0; i < 16; ++i) { const int j = 16 * (i >> 2) + 4 * g + (i & 3), mtp = j >> 5, jl = j & 31, hq = (jl >> 2) & 1, qq = (jl & 3) + 4 * (jl >> 3); PCs[(hq * 2 + mtp) * 16 + qq] = eC_[i]; } }
        }
        LDS_WAIT();
        f32x16 dm;
#pragma unroll
        for (int i = 0; i < 16; ++i) dm[i] = 0.f;
        { const int r31 = lane & 31, hh = lane >> 5;
#pragma unroll
          for (int ks = 0; ks < 4; ++ks) { const int co = ((2 * ks + hh) ^ (r31 & 7)) << 4; const bf16x8 xa = *(const LAS bf16x8*)(Xs + r31 * 128 + co), yb = *(const LAS bf16x8*)(Ys + r31 * 128 + co); dm = MFMA32(xa, yb, dm); }
          LDS_WAIT();
          LAS float* Dm = (LAS float*)scr;
#pragma unroll
          for (int q_ = 0; q_ < 16; ++q_) Dm[((q_ & 3) + 8 * (q_ >> 2) + 4 * hh) * 36 + r31] = dm[q_];
        }
        LDS_WAIT();
        float xs[16], os[16];
        { const LAS float* Dm = (const LAS float*)scr; const int c = lane & 31, cc = (c - 16) & 15; const bool lo16 = c < 16;
          float ak[16], rk[16];
#pragma unroll
          for (int t = 0; t < 16; ++t) { ak[t] = Dm[t * 36 + 16 + cc]; rk[t] = Dm[(16 + t) * 36 + 16 + cc]; }
          asm volatile("" : "+v"(ak[0]), "+v"(ak[1]), "+v"(ak[2]), "+v"(ak[3]), "+v"(ak[4]), "+v"(ak[5]), "+v"(ak[6]), "+v"(ak[7]), "+v"(ak[8]), "+v"(ak[9]), "+v"(ak[10]), "+v"(ak[11]), "+v"(ak[12]), "+v"(ak[13]), "+v"(ak[14]), "+v"(ak[15]));
          asm volatile("" : "+v"(rk[0]), "+v"(rk[1]), "+v"(rk[2]), "+v"(rk[3]), "+v"(rk[4]), "+v"(rk[5]), "+v"(rk[6]), "+v"(rk[7]), "+v"(rk[8]), "+v"(rk[9]), "+v"(rk[10]), "+v"(rk[11]), "+v"(rk[12]), "+v"(rk[13]), "+v"(rk[14]), "+v"(rk[15]) :: "memory");
#pragma unroll
          for (int t = 0; t < 16; ++t) { const float one = (t == c) ? 1.f : 0.f, akm = (cc < t) ? ak[t] : 0.f, rkm = (cc <= t) ? rk[t] : 0.f; xs[t] = lo16 ? one : akm; os[t] = lo16 ? 0.f : rkm; }
#pragma unroll
          for (int tb = 0; tb < 4; ++tb) {
              f32x4 ar[4][4];
#pragma unroll
              for (int r = 0; r < 4; ++r)
#pragma unroll
                  for (int u4 = 0; u4 <= tb; ++u4) ar[r][u4] = *(const LAS f32x4*)(Dm + (4 * tb + r) * 36 + 4 * u4);
#pragma unroll
              for (int r = 0; r < 4; ++r) { if (tb == 0) asm volatile("" : "+v"(ar[r][0]) :: "memory"); else if (tb == 1) asm volatile("" : "+v"(ar[r][0]), "+v"(ar[r][1]) :: "memory"); else if (tb == 2) asm volatile("" : "+v"(ar[r][0]), "+v"(ar[r][1]), "+v"(ar[r][2]) :: "memory"); else asm volatile("" : "+v"(ar[r][0]), "+v"(ar[r][1]), "+v"(ar[r][2]), "+v"(ar[r][3]) :: "memory"); }
#pragma unroll
              for (int r = 0; r < 4; ++r) { const int t = 4 * tb + r;
#pragma unroll
                  for (int tau_ = 0; tau_ < t; ++tau_) xs[t] += ar[r][tau_ >> 2][tau_ & 3] * xs[tau_]; }
              asm volatile("" : "+v"(xs[4 * tb]), "+v"(xs[4 * tb + 1]), "+v"(xs[4 * tb + 2]), "+v"(xs[4 * tb + 3]) :: "memory");
          }
#pragma unroll
          for (int tb = 0; tb < 4; ++tb) {
              f32x4 ar[4][4];
#pragma unroll
              for (int r = 0; r < 4; ++r)
#pragma unroll
                  for (int u4 = 0; u4 <= tb; ++u4) ar[r][u4] = *(const LAS f32x4*)(Dm + (16 + 4 * tb + r) * 36 + 4 * u4);
#pragma unroll
              for (int r = 0; r < 4; ++r) { if (tb == 0) asm volatile("" : "+v"(ar[r][0]) :: "memory"); else if (tb == 1) asm volatile("" : "+v"(ar[r][0]), "+v"(ar[r][1]) :: "memory"); else if (tb == 2) asm volatile("" : "+v"(ar[r][0]), "+v"(ar[r][1]), "+v"(ar[r][2]) :: "memory"); else asm volatile("" : "+v"(ar[r][0]), "+v"(ar[r][1]), "+v"(ar[r][2]), "+v"(ar[r][3]) :: "memory"); }
#pragma unroll
              for (int r = 0; r < 4; ++r) { const int t = 4 * tb + r;
#pragma unroll
                  for (int tau_ = 0; tau_ <= t; ++tau_) os[t] += ar[r][tau_ >> 2][tau_ & 3] * xs[tau_]; }
              asm volatile("" : "+v"(os[4 * tb]), "+v"(os[4 * tb + 1]), "+v"(os[4 * tb + 2]), "+v"(os[4 * tb + 3]) :: "memory");
          }
        }
        LDS_WAIT();
        { LAS bf16* Gs = (LAS bf16*)(scr + 4608);
          if (lane < 32) { const int c = lane;
              int ks, hh, jj; if (c < 16) { ks = 0; hh = (c >> 2) & 1; jj = 4 * (c >> 3) + (c & 3); } else { ks = 2; hh = (c - 16) >> 3; jj = (c - 16) & 7; }
#pragma unroll
              for (int t = 0; t < 16; ++t) { Gs[(ks * 64 + t + 32 * hh) * 8 + jj] = (bf16)(pk2(xs[t], 0.f) & 0xffffu); Gs[(ks * 64 + 16 + t + 32 * hh) * 8 + jj] = (bf16)(pk2(os[t], 0.f) & 0xffffu); } }
        }
        LDS_WAIT();
        { v4u cg[2], cbk[7];
          cg[0] = *(const LAS v4u*)(scr + 4608 + lane * 16); cg[1] = *(const LAS v4u*)(scr + 4608 + (2 * 64 + lane) * 16);
#pragma unroll
          for (int i = 0; i < 6; ++i) cbk[i] = *(const LAS v4u*)(scr + 8192 + (i * 64 + lane) * 16);
          cbk[6] = *(const LAS v4u*)(scr + 8192 + (6 * 64 + (lane & 15)) * 16);
          asm volatile("" : "+v"(cg[0]), "+v"(cg[1]), "+v"(cbk[0]), "+v"(cbk[1]), "+v"(cbk[2]), "+v"(cbk[3]), "+v"(cbk[4]), "+v"(cbk[5]), "+v"(cbk[6]));
#pragma unroll
          for (int i = 0; i < 2; ++i) *(v4u*)(blk + BLK_G + (i * 64 + lane) * 16) = cg[i];
#pragma unroll
          for (int i = 0; i < 6; ++i) *(v4u*)(blk + BLK_BK + (i * 64 + lane) * 16) = cbk[i];
          if (lane < 16) *(v4u*)(blk + BLK_BK + (6 * 64 + lane) * 16) = cbk[6]; }
    }
#undef SC_LOADS
#undef SC_GRAB
}

__device__ __forceinline__ void scan_consume(const Frame& F, int w  , int lane, int ih) {
    const int nq = win_n(w), lo = win_lo(w);
    const unsigned char* wbuf = F.ws + WS_ACT + ACT_WBUF + (size_t)(w & 1) * WBUF_STRIDE;
    float* SST = (float*)(F.ws + WS_SST);
    const int r31 = lane & 31, hh = lane >> 5;
    for (int p = blockIdx.x; p < 256; p += 256) {
        const int chain = sc_chain(p), b = chain >> 6, h = (chain >> 1) & 31, z = chain & 1; const int sp_ = chain * 2 + ih;
        bf16* YB = (bf16*)(F.ws + WS_ACT + (z ? ACT_YB1 : ACT_YB0));
        f32x16 st0, st1;
        if (w == 0) {
#pragma unroll
            for (int i = 0; i < 16; ++i) { st0[i] = 0.f; st1[i] = 0.f; } }
        else {
#pragma unroll
            for (int i = 0; i < 16; ++i) { st0[i] = SST[((size_t)sp_ * 32 + i) * 64 + lane]; st1[i] = SST[((size_t)sp_ * 32 + 16 + i) * 64 + lane]; } }
        volatile LAS unsigned* ctl = (volatile LAS unsigned*)(F.lds + SC_CTL);
        bf16x8 gmid;
        { unsigned e8[8];
#pragma unroll
          for (int jj = 0; jj < 8; ++jj) { const int pi = 8 * (jj >> 2) + 4 * hh + (jj & 3); e8[jj] = (r31 >= 16 && r31 - 16 == pi) ? 0x3f80u : 0u; }
          v4u m_; m_.x = e8[0] | (e8[1] << 16); m_.y = e8[2] | (e8[3] << 16); m_.z = e8[4] | (e8[5] << 16); m_.w = e8[6] | (e8[7] << 16); gmid = __builtin_bit_cast(bf16x8, m_); }
        unsigned yoff[8];
#pragma unroll
        for (int q_ = 8; q_ < 16; ++q_) { const int t = (q_ & 3) + 8 * ((q_ >> 2) & 1) + 4 * hh; yoff[q_ - 8] = (unsigned)((z ? 15 - t : t) * D + h * 64 + 32 * ih + r31) * 2u; }
#pragma unroll 1
        for (int q = 0; q < nq; ++q) {
            { unsigned sp = 0; _Pragma("unroll 1") while ((int)ctl[0] <= q) { __builtin_amdgcn_s_sleep(1); if (++sp > (1u << 24)) break; } }
            asm volatile("" ::: "memory");
            const LAS unsigned char* sl = F.lds + SC_RING + (q % SC_NSLOT) * SC_SLOT;
            bf16x8 arf[4], gf[3], bkf[2][2], vf; f32x4 pc[8];
#pragma unroll
            for (int ks = 0; ks < 4; ++ks) arf[ks] = *(const LAS bf16x8*)(sl + BLK_AR + (ks * 64 + lane) * 16);
            gf[0] = *(const LAS bf16x8*)(sl + BLK_G + lane * 16); gf[2] = *(const LAS bf16x8*)(sl + BLK_G + (64 + lane) * 16); gf[1] = gmid;
#pragma unroll
            for (int mj = 0; mj < 2; ++mj)
#pragma unroll
                for (int ks = 0; ks < 2; ++ks) bkf[mj][ks] = *(const LAS bf16x8*)(sl + BLK_BK + ((mj * 2 + ks) * 64 + lane) * 16);
            vf = *(const LAS bf16x8*)(sl + BLK_VF + (ih * 64 + lane) * 16);
#pragma unroll
            for (int i = 0; i < 8; ++i) pc[i] = *(const LAS f32x4*)(sl + BLK_PCF + hh * 128 + i * 16);
            LDS_WAIT();
            asm volatile("" ::: "memory"); if (lane == 0) ctl[ih ? 4 : 1] = (unsigned)(q + 1);
            const bf16x8 s0 = pack_frag(st0[0], st0[1], st0[2], st0[3], st0[4], st0[5], st0[6], st0[7]), s1 = pack_frag(st0[8], st0[9], st0[10], st0[11], st0[12], st0[13], st0[14], st0[15]);
            const bf16x8 s2 = pack_frag(st1[0], st1[1], st1[2], st1[3], st1[4], st1[5], st1[6], st1[7]), s3 = pack_frag(st1[8], st1[9], st1[10], st1[11], st1[12], st1[13], st1[14], st1[15]);
            const f32x16 zero16 = {0.f, 0.f, 0.f, 0.f, 0.f, 0.f, 0.f, 0.f, 0.f, 0.f, 0.f, 0.f, 0.f, 0.f, 0.f, 0.f};
            f32x16 zz = MFMA32(arf[0], s0, zero16);
            zz = MFMA32(arf[1], s1, zz);
            zz = MFMA32(arf[2], s2, zz);
            zz = MFMA32(arf[3], s3, zz);
#pragma unroll
            for (int i = 0; i < 16; ++i) { st0[i] *= pc[i >> 2][i & 3]; st1[i] *= pc[4 + (i >> 2)][i & 3]; }
            f32x16 oo = MFMA32(gf[2], vf, zero16);
            oo = MFMA32(gf[0], pack_frag(zz[0], zz[1], zz[2], zz[3], zz[4], zz[5], zz[6], zz[7]), oo);
            oo = MFMA32(gf[1], pack_frag(zz[8], zz[9], zz[10], zz[11], zz[12], zz[13], zz[14], zz[15]), oo);
            st0 = MFMA32(bkf[0][1], vf, st0); st1 = MFMA32(bkf[1][1], vf, st1);
            const bf16x8 uf = pack_frag(oo[0], oo[1], oo[2], oo[3], oo[4], oo[5], oo[6], oo[7]);
            st0 = MFMA32(bkf[0][0], uf, st0); st1 = MFMA32(bkf[1][0], uf, st1);
            if (w > 0) {
                const int sp0 = (lo + q) * 16 - CTXL;
                const int rlow = __builtin_amdgcn_readfirstlane(b * SEQ + (z ? SEQ - 1 - sp0 - 15 : sp0));
                char* yb = (char*)YB + (size_t)rlow * (D * 2);
#pragma unroll
                for (int q_ = 8; q_ < 16; ++q_) *(bf16*)(yb + yoff[q_ - 8]) = (bf16)(pk2(oo[q_], 0.f) & 0xffffu); }
        }
#pragma unroll
        for (int i = 0; i < 16; ++i) { SST[((size_t)sp_ * 32 + i) * 64 + lane] = st0[i]; SST[((size_t)sp_ * 32 + 16 + i) * 64 + lane] = st1[i]; }
    }
}
__device__ __forceinline__ void scan_loader(const Frame& F, int w, int lane) {
    const int nq = win_n(w);
    const int p = blockIdx.x; if (p >= 256) return;
    const unsigned char* cbase = F.ws + WS_ACT + ACT_WBUF + (size_t)(w & 1) * WBUF_STRIDE + (size_t)sc_chain(p) * SC_WQ * SCAN_BLK + lane * 16;
    volatile LAS unsigned* ctl = (volatile LAS unsigned*)(F.lds + SC_CTL);
#pragma unroll 1
    for (int q = 0; q < nq; ++q) {
        { unsigned sp = 0; while (q - (int)ctl[1] >= SC_NSLOT || q - (int)ctl[4] >= SC_NSLOT) { __builtin_amdgcn_s_sleep(1); if (++sp > (1u << 24)) break; } }
        asm volatile("" ::: "memory");
        const unsigned char* src = cbase + (size_t)q * SCAN_BLK; LAS unsigned char* dst = F.lds + SC_RING + (q % SC_NSLOT) * SC_SLOT;
#pragma unroll
        for (int i_ = 0; i_ < 12; ++i_) __builtin_amdgcn_global_load_lds((const unsigned*)(src + i_ * 1024), (LAS unsigned*)(dst + i_ * 1024), 16, 0, 0);
        if (lane < 16) __builtin_amdgcn_global_load_lds((const unsigned*)(src + BLK_PCF), (LAS unsigned*)(dst + BLK_PCF), 16, 0, 0);
        asm volatile("s_waitcnt vmcnt(26)" ::: "memory");
        if (lane == 0 && q >= 1) ctl[0] = (unsigned)(q - 1);
    }
    asm volatile("s_waitcnt vmcnt(0)" ::: "memory");
    if (lane == 0) ctl[0] = (unsigned)nq;
}
__device__ __forceinline__ void phase_scan_step(Frame& F, const Args& AR, int w) {
    int tid_ = threadIdx.x; asm volatile("" : "+v"(tid_)); const int LANE = tid_ & 63, WAVE = __builtin_amdgcn_readfirstlane(tid_ >> 6);
    if (w == 0) scan_setup(F, AR, tid_);
    const bool isA = sc_half(blockIdx.x) == 0;
    if (tid_ < 8) ((volatile LAS unsigned*)(F.lds + SC_CTL))[tid_] = tid_ == 2 ? (unsigned)(isA ? SC_NPROD_A : SC_NPROD_B) : 0u;
    __syncthreads();
    if (isA) {
        if (WAVE <= 1) { if (w >= 1) scan_consume(F, w - 1, LANE, WAVE); }
        else if (WAVE == 2) { if (w >= 1) scan_loader(F, w - 1, LANE); }
        else { if (w < SCAN_NW) scan_produce(F, w, WAVE - 3, LANE, true); }
    } else { if (w < SCAN_NW) scan_produce(F, w, WAVE, LANE, false); }
}
__device__ __forceinline__ void phase_combine(Frame& F, const Args& AR, bf16* PO) {
    int tid_ = threadIdx.x; asm volatile("" : "+v"(tid_)); const int TID = tid_, LANE = tid_ & 63, WAVE = __builtin_amdgcn_readfirstlane(tid_ >> 6);
    const bf16* VP = (const bf16*)(F.ws + WS_ACT + ACT_XM + 5 * XM_STRIDE);
    const bf16* YB0 = (const bf16*)(F.ws + WS_ACT + ACT_YB0); const bf16* YB1 = (const bf16*)(F.ws + WS_ACT + ACT_YB1);
    const float* SA = (const float*)(F.ws + WS_SA);
    LAS float* TC = (LAS float*)F.lds;
    for (int i = TID; i < D / 4; i += NWAVES * 64) { *(LAS f32x4*)(TC + 4 * i) = *(const f32x4*)(AR.in[24] + 4 * i); *(LAS f32x4*)(TC + D + 4 * i) = *(const f32x4*)(AR.in[25] + 4 * i); }
    __syncthreads();
    const int gw = F.vcu * NWAVES + WAVE, NGW = F.G * NWAVES;
    v4u yaA[4], ybA[4], vqA[4], yaB[4], ybB[4], vqB[4]; float s0A[4], s1A[4], s0B[4], s1B[4];
#define CB_LOAD(ya, yb, vq, s0, s1, r_) do { _Pragma("unroll") for (int c = 0; c < 4; ++c) { const unsigned o = (unsigned)((r_) * D + 512 * c + 8 * LANE) * 2u; \
            ya[c] = *(const v4u*)((const char*)YB0 + o); yb[c] = *(const v4u*)((const char*)YB1 + o); vq[c] = *(const v4u*)((const char*)VP + o); \
            s0[c] = SA[(r_) * 32 + 8 * c + (LANE >> 3)]; s1[c] = SA[(MT + (r_)) * 32 + 8 * c + (LANE >> 3)]; } } while (0)
#define CB_COMP(ya, yb, vq, s0, s1, r_) do { _Pragma("unroll") for (int c = 0; c < 4; ++c) { const int d = 512 * c + 8 * LANE; \
            const unsigned aw[4] = {ya[c].x, ya[c].y, ya[c].z, ya[c].w}, bw[4] = {yb[c].x, yb[c].y, yb[c].z, yb[c].w}, vw[4] = {vq[c].x, vq[c].y, vq[c].z, vq[c].w}; \
            float y[8]; float sum = 0.f; \
            _Pragma("unroll") for (int e = 0; e < 4; ++e) { y[2 * e] = bflo(aw[e]) + bflo(bw[e]); y[2 * e + 1] = bfhi(aw[e]) + bfhi(bw[e]); sum += y[2 * e] + y[2 * e + 1]; } \
            sum += __shfl_xor(sum, 1); sum += __shfl_xor(sum, 2); sum += __shfl_xor(sum, 4); \
            const float mean = sum * (1.f / 64.f); float vs = 0.f; \
            _Pragma("unroll") for (int i = 0; i < 8; ++i) { const float dl = y[i] - mean; vs += dl * dl; } \
            vs += __shfl_xor(vs, 1); vs += __shfl_xor(vs, 2); vs += __shfl_xor(vs, 4); \
            const float rstd = 1.0f / sqrtf(vs * (1.f / 64.f) + GN_EPS); \
            const float sb = 0.5f * (s0[c] + s1[c]);        \
            const f32x4 l0 = *(const LAS f32x4*)(TC + d), l1 = *(const LAS f32x4*)(TC + d + 4), b0 = *(const LAS f32x4*)(TC + D + d), b1 = *(const LAS f32x4*)(TC + D + d + 4); \
            const float lw_[8] = {l0.x, l0.y, l0.z, l0.w, l1.x, l1.y, l1.z, l1.w}, lb_[8] = {b0.x, b0.y, b0.z, b0.w, b1.x, b1.y, b1.z, b1.w}; \
            float o[8]; \
            _Pragma("unroll") for (int e = 0; e < 4; ++e) { o[2 * e] = (y[2 * e] - mean) * rstd * lw_[2 * e] + lb_[2 * e] + sb * bflo(vw[e]); o[2 * e + 1] = (y[2 * e + 1] - mean) * rstd * lw_[2 * e + 1] + lb_[2 * e + 1] + sb * bfhi(vw[e]); } \
            v4u w_; w_.x = pk2(o[0], o[1]); w_.y = pk2(o[2], o[3]); w_.z = pk2(o[4], o[5]); w_.w = pk2(o[6], o[7]); \
            *(v4u*)((char*)PO + (unsigned)((r_) * D + d) * 2u) = w_; } } while (0)
    int r = gw;
    if (r < ML) CB_LOAD(yaA, ybA, vqA, s0A, s1A, r);
#pragma unroll 1
    for (; r < ML; r += 2 * NGW) {
        const int r1 = r + NGW, r2 = r + 2 * NGW;
        if (r1 < ML) CB_LOAD(yaB, ybB, vqB, s0B, s1B, r1);
        CB_COMP(yaA, ybA, vqA, s0A, s1A, r);
        if (r2 < ML) CB_LOAD(yaA, ybA, vqA, s0A, s1A, r2);
        if (r1 < ML) CB_COMP(yaB, ybB, vqB, s0B, s1B, r1);
    }
#undef CB_LOAD
#undef CB_COMP
}

template <class RowMap, bool BLK = false>
__device__ __forceinline__ void transpose_item(const float* W, int K, int N, bf16* WT, const RowMap& rm, LAS float* scr, int item, int lane) {
    const int nblk = N / 32, kb = item / nblk, nb = item % nblk, k0 = 64 * kb, n0 = 32 * nb;
#pragma unroll 8
    for (int i = 0; i < 32; ++i) { const int kk = 2 * i + (lane >> 5); scr[kk * 33 + (lane & 31)] = W[(size_t)(k0 + kk) * N + n0 + (lane & 31)]; }
    LDS_WAIT(); asm volatile("" ::: "memory");
    const int c = lane & 7;
#pragma unroll
    for (int j = 0; j < 4; ++j) { const int n = (lane >> 3) + 8 * j; const LAS float* s = scr + (8 * c) * 33 + n;
        v4u o; o.x = pk2(s[0 * 33], s[1 * 33]); o.y = pk2(s[2 * 33], s[3 * 33]); o.z = pk2(s[4 * 33], s[5 * 33]); o.w = pk2(s[6 * 33], s[7 * 33]);
        const int nr = rm(n0 + n);
        if (BLK) *(v4u*)(WT + ((size_t)(nr >> 8) * (K / 64) + (k0 >> 6)) * 16384 + (size_t)(nr & 255) * 64 + 8 * c) = o;
        else *(v4u*)(WT + (size_t)nr * K + k0 + 8 * c) = o; }
    LDS_WAIT(); asm volatile("" ::: "memory");
}
struct RmId { __device__ __forceinline__ int operator()(int n) const { return n; } };
struct RmW13 { __device__ __forceinline__ int operator()(int n) const { const int bj = n >= DFF ? 1 : 0, j = n - bj * DFF; return 256 * (j >> 7) + 128 * bj + (j & 127); } };

__device__ __forceinline__ void p0_prologue(Frame& F, const Args& AR) {
    int tid_ = threadIdx.x; asm volatile("" : "+v"(tid_)); const int TID = tid_, LANE = tid_ & 63, WAVE = __builtin_amdgcn_readfirstlane(tid_ >> 6);
    const float* x_c = AR.in[1]; const float* c_ctx = AR.in[3]; const float* mod_w = AR.in[4];
    for (int i = blockIdx.x * (NWAVES * 64) + TID; i < 6 * 262144 / 4; i += F.G * NWAVES * 64) ((f32x4*)(F.ws + WS_PS))[i] = (f32x4){0.f, 0.f, 0.f, 0.f};
    {
        LAS float* sil = (LAS float*)(F.lds);
        LAS f32x4* red = (LAS f32x4*)(F.lds + 24576);
        for (int i = TID; i < 3 * D; i += NWAVES * 64) { const int who = i / D, k = i % D; const float v = who < 2 ? x_c[who * D + k] : c_ctx[k]; sil[i] = v * sigmoidf_(v); }
        __syncthreads();
        for (int t = blockIdx.x; t < 576; t += F.G) {
            const int q = t & 3, cb = (t >> 2) % 72, layer = t / 288;
            const int r0 = q * 512 + WAVE * 64;
            const float* wp = mod_w + ((size_t)layer * D + r0) * NMODV + cb * 256 + LANE * 4;
            f32x4 a0 = {0.f, 0.f, 0.f, 0.f}, a1 = a0, a2 = a0;
#pragma unroll 8
            for (int r = 0; r < 64; ++r) { const f32x4 w = *(const f32x4*)(wp + (size_t)r * NMODV); a0 += w * sil[r0 + r]; a1 += w * sil[D + r0 + r]; a2 += w * sil[2 * D + r0 + r]; }
            red[(WAVE * 3 + 0) * 64 + LANE] = a0; red[(WAVE * 3 + 1) * 64 + LANE] = a1; red[(WAVE * 3 + 2) * 64 + LANE] = a2;
            __syncthreads();
            if (WAVE < 3) { f32x4 s = {0.f, 0.f, 0.f, 0.f};
#pragma unroll
                for (int w = 0; w < 8; ++w) s += red[(w * 3 + WAVE) * 64 + LANE];
                *(f32x4*)((float*)(F.ws + WS_MODP) + ((size_t)(q * 2 + layer) * 3 + WAVE) * NMODV + cb * 256 + LANE * 4) = s; }
            __syncthreads();
        }
    }
    LAS float* scr = (LAS float*)(F.lds + WAVE * 16384);
    const int gw = F.vcu * NWAVES + WAVE, NGW = F.G * NWAVES;
    {
        constexpr int I13 = (D / 64) * (2 * DFF / 32), I2 = (DFF / 64) * (D / 32), IDD = (D / 64) * (D / 32);
        constexpr int NIT = 4 * I13 + 4 * I2 + 5 * IDD + 2 * (D / 64) * (256 / 32) / 1;
        for (int it = gw; it < NIT; it += NGW) {
            int r = it;
            if (r < 4 * I13) { const int lf = r / I13; r -= lf * I13; const int l = lf >> 1, f = lf & 1;
                transpose_item<RmW13, true>(AR.in[7] + (size_t)lf * D * 2 * DFF, D, 2 * DFF, (bf16*)(F.ws + (l ? WS_WL1 : WS_WL0) + (size_t)f * 44 * MiB), RmW13(), scr, r, LANE); continue; }
            r -= 4 * I13;
            if (r < 4 * I2) { const int lf = r / I2; r -= lf * I2; const int l = lf >> 1, f = lf & 1;
                transpose_item<RmId, true>(AR.in[8] + (size_t)lf * DFF * D, DFF, D, (bf16*)(F.ws + (l ? WS_WL1 : WS_WL0) + 88 * MiB + (size_t)f * 22 * MiB), RmId(), scr, r, LANE); continue; }
            r -= 4 * I2;
            if (r < IDD) { transpose_item(AR.in[9], D, D, (bf16*)(F.ws + WS_WFO), RmId(), scr, r, LANE); continue; }
            r -= IDD;
            if (r < 3 * IDD) { const int p = r / IDD; r -= p * IDD; transpose_item(AR.in[12] + (size_t)p * D * D, D, D, (bf16*)(F.ws + WS_WRKV + (size_t)p * 8 * MiB), RmId(), scr, r, LANE); continue; }
            r -= 3 * IDD;
            if (r < IDD) { transpose_item(AR.in[26], D, D, (bf16*)(F.ws + WS_WRO), RmId(), scr, r, LANE); continue; }
            r -= IDD;
            if (r < 256) { transpose_item(AR.in[19], D, 256, (bf16*)(F.ws + WS_WSMALL + WSM_G1T), RmId(), scr, r, LANE); continue; }
            r -= 256;
            transpose_item(AR.in[20], 256, D, (bf16*)(F.ws + WS_WSMALL + WSM_G2T), RmId(), scr, r, LANE);
        }
    }
    {
        const int gt = (F.vcu * NWAVES + WAVE) * 64 + LANE, NGT = F.G * NWAVES * 64;
        for (int i = gt; i < 2 * 256 * D; i += NGT) { const int which = i / (256 * D), rr = (i / D) % 256, k = i % D;
            float v = 0.f; if (rr < 192) { const int z = rr / 96, r = rr % 96; v = AR.in[which ? 17 : 14][((size_t)z * D + k) * LORA + r]; }
            ((bf16*)(F.ws + WS_WSMALL + (which ? WSM_A1CAT : WSM_W1CAT)))[(size_t)rr * D + k] = (bf16)(pk2(v, 0.f) & 0xffffu); }
        for (int i = gt; i < 2 * 2 * D * LORA; i += NGT) { const int which = i / (2 * D * LORA), j = i % (2 * D * LORA), z = j / (D * LORA), n = (j / LORA) % D, r = j % LORA;
            const float v = AR.in[which ? 18 : 15][((size_t)z * LORA + r) * D + n];
            ((bf16*)(F.ws + WS_WSMALL + (which ? WSM_A2UP : WSM_W2UP)))[j] = (bf16)(pk2(v, 0.f) & 0xffffu); }
        for (int i = gt; i < MC * D / 4; i += NGT) ((f32x4*)(F.ws + WS_XC))[i] = ((const f32x4*)AR.in[2])[i];
        const float RS128 = 0.08838834764831845f;
        bf16* dm = (bf16*)(F.ws + WS_TAB + TAB_DMAT); bf16* m1 = (bf16*)(F.ws + WS_TAB + TAB_M1); bf16* m2 = (bf16*)(F.ws + WS_TAB + TAB_M2); bf16* m3 = (bf16*)(F.ws + WS_TAB + TAB_M3);
        f32x2* tw = (f32x2*)(F.ws + WS_TAB + TAB_TW);
        for (int i = gt; i < 512 * 256; i += NGT) { const int r = i >> 8, ch = i & 255, cs = r >> 8, kc = r & 255; float s, c; sincospif((float)((kc * ch) & 255) * (1.f / 128.f), &s, &c);
            dm[i] = (bf16)(pk2((cs ? s : c) * 0.0625f, 0.f) & 0xffffu); }
        for (int i = gt; i < 256 * 256; i += NGT) { const int r = i >> 8, ci = i & 255, ri = r >> 7, k1 = r & 127, cs = ci >> 7, n1 = ci & 127; float s, c; sincospif((float)((k1 * n1) & 127) * (1.f / 64.f), &s, &c);
            const float v1 = ri == 0 ? (cs == 0 ? c : -s) : (cs == 0 ? s : c);
            m1[i] = (bf16)(pk2(v1 * RS128, 0.f) & 0xffffu);
            const float v2 = r < 128 ? (cs == 0 ? c : -s) : 0.f;
            m2[i] = (bf16)(pk2(v2 * RS128, 0.f) & 0xffffu); }
        for (int i = gt; i < 256 * 512; i += NGT) { const int k = i >> 9, ci = i & 511, cs = ci >> 8, n = ci & 255; float s, c; sincospif((float)((k * n) & 255) * (1.f / 128.f), &s, &c);
            m3[i] = (bf16)(pk2((cs ? -s : c) * 0.0625f, 0.f) & 0xffffu); }
        for (int i = gt; i < 128 * 128; i += NGT) { const int k1 = i >> 7, n2 = i & 127; float s, c; sincospif((float)(k1 * n2) * (1.f / 8192.f), &s, &c); tw[i] = (f32x2){c, s}; }
    }
}

template <bool BLK = false, bool FIRST = false> __device__ __forceinline__ void phase_norm(Frame& F, const float* xl, const float* xc, int r0, int Mrows, const float* nw, int layer, int sidx, bf16* HN) {
    int tid_ = threadIdx.x; asm volatile("" : "+v"(tid_)); const int TID = tid_, LANE = tid_ & 63, WAVE = __builtin_amdgcn_readfirstlane(tid_ >> 6);
    LAS float* TA = (LAS float*)(F.lds);
    LAS float* TB = (LAS float*)(F.lds + 24576);
    for (int i = TID; i < 3 * D / 4; i += NWAVES * 64) { const int who = i / (D / 4), d = (i % (D / 4)) * 4;
        const ModRef MR{(const float*)(F.ws + WS_MODP), F.modb, (const float*)(F.ws + WS_MODV)};
        const f32x4 sh = FIRST ? modv4(MR, layer, who, sidx * D + d) : modvF(MR, layer, who, sidx * D + d), sc = FIRST ? modv4(MR, layer, who, (sidx + 1) * D + d) : modvF(MR, layer, who, (sidx + 1) * D + d), g = *(const f32x4*)(nw + d);
        *(LAS f32x4*)(TA + who * D + d) = g * (sc + 1.f); *(LAS f32x4*)(TB + who * D + d) = sh; }
    if (FIRST) {
        const ModRef MR{(const float*)(F.ws + WS_MODP), F.modb, nullptr}; float* MV = (float*)(F.ws + WS_MODV);
        for (int i = F.vcu * (NWAVES * 64) + TID; i < 6 * NMODV / 4; i += F.G * NWAVES * 64) { const int lw = i / (NMODV / 4), c = (i % (NMODV / 4)) * 4; *(f32x4*)(MV + (size_t)lw * NMODV + c) = modv4(MR, lw / 3, lw % 3, c); }
    }
    __syncthreads();
    const int gw = F.vcu * NWAVES + WAVE, NGW = F.G * NWAVES;
    for (int r = r0 + gw; r < Mrows; r += NGW) {
        const int who = who_of_row(r);
        const float* xr = r < ML ? xl + (size_t)r * D : xc + (size_t)(r - ML) * D;
        f32x4 v[4][2]; float ss = 0.f;
#pragma unroll
        for (int j = 0; j < 4; ++j)
#pragma unroll
            for (int h = 0; h < 2; ++h) { v[j][h] = *(const f32x4*)(xr + 512 * j + 8 * LANE + 4 * h); ss += (v[j][h].x * v[j][h].x + v[j][h].y * v[j][h].y) + (v[j][h].z * v[j][h].z + v[j][h].w * v[j][h].w); }
        const float rstd = 1.0f / sqrtf(wave_sum(ss) * (1.f / D) + NORM_EPS);
#pragma unroll
        for (int j = 0; j < 4; ++j) { const int d = 512 * j + 8 * LANE;
            const f32x4 a0 = *(const LAS f32x4*)(TA + who * D + d), a1 = *(const LAS f32x4*)(TA + who * D + d + 4), b0 = *(const LAS f32x4*)(TB + who * D + d), b1 = *(const LAS f32x4*)(TB + who * D + d + 4);
            const f32x4 o0 = v[j][0] * rstd * a0 + b0, o1 = v[j][1] * rstd * a1 + b1;
            v4u w; w.x = pk2(o0.x, o0.y); w.y = pk2(o0.z, o0.w); w.z = pk2(o1.x, o1.y); w.w = pk2(o1.z, o1.w);
            if (BLK) *(v4u*)(HN + ((size_t)(r >> 8) * (D / 64) + (d >> 6)) * 16384 + (size_t)(r & 255) * 64 + (d & 63)) = w;
            else *(v4u*)(HN + (size_t)r * D + d) = w; }
    }
}
__device__ __forceinline__ void phase_final(Frame& F, float* x, const float* w) {
    int tid_ = threadIdx.x; asm volatile("" : "+v"(tid_)); const int TID = tid_, LANE = tid_ & 63, WAVE = __builtin_amdgcn_readfirstlane(tid_ >> 6);
    const int gw = F.vcu * NWAVES + WAVE, NGW = F.G * NWAVES;
    for (int r = gw; r < ML; r += NGW) {
        float* xr = x + (size_t)r * D;
        f32x4 v[8]; float ss = 0.f;
#pragma unroll
        for (int j = 0; j < 8; ++j) { v[j] = *(const f32x4*)(xr + 256 * j + 4 * LANE); ss += (v[j].x * v[j].x + v[j].y * v[j].y) + (v[j].z * v[j].z + v[j].w * v[j].w); }
        const float rstd = 1.0f / sqrtf(wave_sum(ss) * (1.f / D) + NORM_EPS);
#pragma unroll
        for (int j = 0; j < 8; ++j) { const f32x4 g = *(const f32x4*)(w + 256 * j + 4 * LANE); *(f32x4*)(xr + 256 * j + 4 * LANE) = v[j] * rstd * g; }
    }
}

#if MK_DEBUG
__device__ __forceinline__ void dbg_flag(unsigned* ctl, unsigned code) { atomicMax(ctl + CW_DBG, code); }
__device__ __forceinline__ bool dbg_bad(float got, float ref, float atol, float rtol) { const float e = fabsf(got - ref); return !(e <= atol + rtol * fabsf(ref)); }
__device__ __forceinline__ unsigned dbg_hash(unsigned x) { x ^= x >> 16; x *= 0x7feb352du; x ^= x >> 15; x *= 0x846ca68bu; x ^= x >> 16; return x; }
__device__ __noinline__ void dbg_check_mod(unsigned char* ws, const float* c, const float* c_ctx, const float* mod_w, const float* modb) {
    const int lane = threadIdx.x & 63, gw = blockIdx.x * 8 + (threadIdx.x >> 6);
    if (gw >= 96) return;
    const unsigned h = dbg_hash(gw * 2654435761u + 17u); const int layer = h & 1, who = (h >> 1) % 3, col = ((h >> 4) % NMODV) & ~3;
    float s = 0.f;
    for (int k = lane; k < D; k += 64) { const float v = who < 2 ? c[who * D + k] : c_ctx[k]; s += v / (1.f + expf(-v)) * mod_w[((size_t)layer * D + k) * NMODV + col]; }
    s = wave_sum(s) + modb[(size_t)layer * NMODV + col];
    const ModRef MR{(const float*)(ws + WS_MODP), modb};
    const f32x4 g = modv4(MR, layer, who, col);
    if (lane == 0 && dbg_bad(g.x, s, 2e-3f, 2e-3f)) dbg_flag((unsigned*)(ws + WS_CTL), 1u);
}
__device__ __noinline__ void dbg_check_hn(unsigned char* ws, const float* x, const float* ctx, const float* nw, const float* modb, int layer, int sidx, unsigned code) {
    const int lane = threadIdx.x & 63, gw = blockIdx.x * 8 + (threadIdx.x >> 6);
    if (gw >= 64) return;
    const int r = (gw < 48) ? (int)(dbg_hash(gw + 99u) % ML) : ML + (int)(dbg_hash(gw + 7u) % MC);
    const float* xr = r < ML ? x + (size_t)r * D : ctx + (size_t)(r - ML) * D; const int who = who_of_row(r);
    float ss = 0.f; for (int d = lane; d < D; d += 64) ss += xr[d] * xr[d];
    const float rstd = 1.0f / sqrtf(wave_sum(ss) / D + NORM_EPS);
    const ModRef MR{(const float*)(ws + WS_MODP), modb}; const bf16* HN = (const bf16*)(ws + WS_ACT + ACT_HN);
    bool bad = false;
    for (int d4 = lane * 4; d4 < D; d4 += 256) { const f32x4 sh = modv4(MR, layer, who, sidx * D + d4), sc = modv4(MR, layer, who, (sidx + 1) * D + d4);
        for (int e = 0; e < 4; ++e) { const float ref = xr[d4 + e] * rstd * nw[d4 + e] * (1.f + sc[e]) + sh[e]; bad |= dbg_bad(bf2f(HN[(size_t)r * D + d4 + e]), ref, 0.03f, 0.01f); } }
    if (bad) dbg_flag((unsigned*)(ws + WS_CTL), code);
}
__device__ __noinline__ void dbg_check_h(unsigned char* ws, const float* w13) {
    const int lane = threadIdx.x & 63, gw = blockIdx.x * 8 + (threadIdx.x >> 6);
    if (gw >= 512) return;
    const unsigned h = dbg_hash(gw + 1234u); const int r = (gw & 7) == 7 ? ML + (int)(h % MC) : (int)(h % ML), j = (int)((h >> 7) % DFF);
    const bf16* HN = (const bf16*)(ws + WS_ACT + ACT_HN); const bf16* HB = (const bf16*)(ws + WS_ACT + ACT_H);
    float g = 0.f, u = 0.f;
    for (int k = lane; k < D; k += 64) { const float a = bf2f(HN[(size_t)r * D + k]); g += a * w13[(size_t)k * 2 * DFF + j]; u += a * w13[(size_t)k * 2 * DFF + DFF + j]; }
    g = wave_sum(g); u = wave_sum(u);
    const float ref = g / (1.f + expf(-g)) * u;
    if (lane == 0 && dbg_bad(bf2f(HB[(size_t)r * DFF + j]), ref, 0.03f, 0.03f)) dbg_flag((unsigned*)(ws + WS_CTL), 3u);
}
__device__ __noinline__ void dbg_check_w2(unsigned char* ws, const float* x, const float* ctx, const float* out, const float* w2, const float* modb) {
    const int lane = threadIdx.x & 63, gw = blockIdx.x * 8 + (threadIdx.x >> 6);
    if (gw >= 512) return;
    const unsigned h = dbg_hash(gw + 4321u); const int r = (gw & 7) == 7 ? ML + (int)(h % MC) : (int)(h % ML), col = (int)((h >> 7) % D) & ~3;
    const bf16* HB = (const bf16*)(ws + WS_ACT + ACT_H);
    float a = 0.f; for (int j = lane; j < DFF; j += 64) a += bf2f(HB[(size_t)r * DFF + j]) * w2[(size_t)j * D + col];
    a = wave_sum(a);
    const ModRef MR{(const float*)(ws + WS_MODP), modb}; const f32x4 gt = modv4(MR, 0, who_of_row(r), 2 * D + col);
    const float base = r < ML ? x[(size_t)r * D + col] : ctx[(size_t)(r - ML) * D + col];
    const float got = r < ML ? out[(size_t)r * D + col] : ((const float*)(ws + WS_XC))[(size_t)(r - ML) * D + col];
    if (lane == 0 && dbg_bad(got, base + 0.5f * gt.x * a, 0.02f, 0.01f)) dbg_flag((unsigned*)(ws + WS_CTL), 4u);
}
__device__ __noinline__ void dbg_check_fourier(unsigned char* ws, const float* xl, const float* nw, const float* modb, LAS float* red) {
    const int lane = threadIdx.x & 63, wave = threadIdx.x >> 6;
    if (blockIdx.x >= 40) return;
    const unsigned h = dbg_hash(blockIdx.x + 555u); const bool isc = blockIdx.x >= 32;
    const int L = isc ? CTXL : SEQ, b = h & 1, k = (int)((h >> 1) % (unsigned)L), g = (h >> 17) & 7, ch = (h >> 20) & 255;
    const float* xb = isc ? (const float*)(ws + WS_XC) + (size_t)b * CTXL * D : xl + (size_t)b * SEQ * D; const int who = isc ? 2 : b;
    const ModRef MR{(const float*)(ws + WS_MODP), modb};
    const int c0 = g * 256 + lane * 4; const f32x4 sh = modv4(MR, 0, who, 3 * D + c0), sc = modv4(MR, 0, who, 4 * D + c0);
    float acc = 0.f;
    for (int n = wave; n < L; n += 8) { const float* xr = xb + (size_t)n * D;
        float ss = 0.f; for (int d = lane; d < D; d += 64) ss += xr[d] * xr[d];
        const float rstd = 1.0f / sqrtf(wave_sum(ss) / D + NORM_EPS);
        const float fl = (float)((k * n) % L) / (float)L;
        for (int e = 0; e < 4; ++e) { const int c = lane * 4 + e; float hv = xr[c0 + e] * rstd * nw[c0 + e] * (1.f + sc[e]) + sh[e]; hv = bflo(pk2(hv, 0.f));
            acc += hv * cospif(2.f * (fl + (float)((ch * c) & 255) * (1.f / 256.f))); } }
    acc = wave_sum(acc); if (lane == 0) red[wave] = acc; __syncthreads();
    if (threadIdx.x == 0) { float t = 0.f; for (int w = 0; w < 8; ++w) t += red[w]; t *= isc ? (1.f / 256.f) : (1.f / 2048.f);
        const size_t row = isc ? (size_t)ML + b * CTXL + k : (size_t)b * SEQ + k; const float got = bf2f(((const bf16*)(ws + WS_ACT + ACT_HN))[row * D + g * 256 + ch]);
        if (dbg_bad(got, t, 0.04f, 0.02f)) dbg_flag((unsigned*)(ws + WS_CTL), isc ? 6u : 5u); }
}
__device__ __noinline__ void dbg_check_rkv(unsigned char* ws, const float* wrkv) {
    const int lane = threadIdx.x & 63, gw = blockIdx.x * 8 + (threadIdx.x >> 6);
    if (gw >= 768) return;
    const unsigned h = dbg_hash(gw + 777u); const int wsel = gw % 3, r = (gw & 7) == 7 ? ML + (int)(h % MC) : (int)(h % ML), col = (int)((h >> 9) % D);
    const bf16* A = (const bf16*)(ws + WS_ACT + ACT_XM + (size_t)wsel * XM_STRIDE); const bf16* O = (const bf16*)(ws + WS_ACT + ACT_XM + (size_t)(3 + wsel) * XM_STRIDE);
    float a = 0.f; for (int k = lane; k < D; k += 64) a += bf2f(A[(size_t)r * D + k]) * wrkv[((size_t)wsel * D + k) * D + col];
    a = wave_sum(a);
    if (lane == 0 && dbg_bad(bf2f(O[(size_t)r * D + col]), a, 0.03f, 0.02f)) dbg_flag((unsigned*)(ws + WS_CTL), 8u);
}
__device__ __noinline__ void dbg_check_lora(unsigned char* ws, const float* w1, const float* a1, const float* g1) {
    const int lane = threadIdx.x & 63, gw = blockIdx.x * 8 + (threadIdx.x >> 6);
    if (gw >= 768) return;
    const unsigned h = dbg_hash(gw + 888u); const int which = gw % 3, r = (gw & 7) == 7 ? ML + (int)(h % MC) : (int)(h % ML);
    const int col = which == 2 ? (int)((h >> 9) % 256) : (int)((h >> 9) % 192);
    const bf16* A = (const bf16*)(ws + WS_ACT + ACT_XM + (size_t)(3 + which) * XM_STRIDE); const bf16* O = (const bf16*)(ws + WS_ACT + ACT_LR + (size_t)which * LR_STRIDE);
    float a = 0.f;
    for (int k = lane; k < D; k += 64) { const float wv = which == 2 ? g1[(size_t)k * 256 + col] : (which ? a1 : w1)[((size_t)(col / 96) * D + k) * LORA + (col % 96)]; a += bf2f(A[(size_t)r * D + k]) * wv; }
    a = wave_sum(a); const float ref = which == 0 ? tanhf(a) : (which == 2 ? 1.f / (1.f + expf(-a)) : a);
    if (lane == 0 && dbg_bad(bf2f(O[(size_t)r * 256 + col]), ref, 0.02f, 0.02f)) dbg_flag((unsigned*)(ws + WS_CTL), 9u);
}
__device__ __noinline__ void dbg_check_scan(unsigned char* ws, const float* p_w0, const float* p_a0, const float* p_kk, const float* p_ka, const float* p_w2, const float* p_a2) {
    const int lane = threadIdx.x & 63, gw = blockIdx.x * 8 + (threadIdx.x >> 6);
    if (gw >= 64) return;
    const unsigned hsh = dbg_hash(gw + 31337u); const int chain = hsh & 127, i = (hsh >> 8) & 63, b = chain >> 6, hd = (chain >> 1) & 31, z = chain & 1;
    const bf16* RKV = (const bf16*)(ws + WS_ACT + ACT_XM + 3 * XM_STRIDE);
    const bf16* TWb = (const bf16*)(ws + WS_ACT + ACT_LR); const bf16* TAb = (const bf16*)(ws + WS_ACT + ACT_LR + LR_STRIDE);
    const bf16* YB = (const bf16*)(ws + WS_ACT + (z ? ACT_YB1 : ACT_YB0));
    const int ch = hd * 64 + lane;
    const float w0 = p_w0[z * D + ch], a0 = p_a0[z * D + ch], kkc = p_kk[ch], kac = p_ka[ch];
    float st = 0.f; float worst = 0.f;
    for (int s_ = 0; s_ < CTXL + SEQ; ++s_) {
        const int row = scan_row(b, z, s_);
        float lwv = 0.f, lav = 0.f;
        for (int r = 0; r < LORA; ++r) { lwv += bf2f(TWb[(size_t)row * 256 + z * 96 + r]) * p_w2[((size_t)z * LORA + r) * D + ch]; lav += bf2f(TAb[(size_t)row * 256 + z * 96 + r]) * p_a2[((size_t)z * LORA + r) * D + ch]; }
        const float xw = w0 + lwv, logw = -log1pf(expf(-xw)) - 0.5f, dec = expf(-expf(logw));
        const float asig = 1.f / (1.f + expf(-(a0 + lav)));
        const float rj = bf2f(RKV[(size_t)row * D + ch]), kj = bf2f(RKV[(size_t)MT * D + (size_t)row * D + ch]), vi = bf2f(RKV[2 * (size_t)MT * D + (size_t)row * D + hd * 64 + i]);
        const float kr = kj * kkc; const float nrm = wave_sum(kr * kr); const float kkj = kr / sqrtf(fmaxf(nrm, 1e-24f));
        const float aj = -kkj, bj = kkj * asig, kdj = kj * (1.f + (asig - 1.f) * kac);
        const float sa = wave_sum(st * aj);
        st = st * dec + sa * bj + vi * kdj;
        const float y = wave_sum(st * rj);
        if (s_ >= CTXL) { const float got = bf2f(YB[(size_t)row * D + hd * 64 + i]); const float e = fabsf(got - y) / (0.05f + 0.03f * fabsf(y)); worst = fmaxf(worst, e); }
    }
    if (lane == 0 && !(worst <= 1.f)) dbg_flag((unsigned*)(ws + WS_CTL), 10u);
}
__device__ __noinline__ void dbg_check_combine(unsigned char* ws, const float* p_ka, const float* p_rk, const float* p_lnw, const float* p_lnb) {
    const int lane = threadIdx.x & 63, gw = blockIdx.x * 8 + (threadIdx.x >> 6);
    if (gw >= 256) return;
    const unsigned hsh = dbg_hash(gw + 4242u); const int r = (int)(hsh % ML), hd = (hsh >> 20) & 31, ch = hd * 64 + lane;
    const bf16* RKV = (const bf16*)(ws + WS_ACT + ACT_XM + 3 * XM_STRIDE);
    const float y = bf2f(((const bf16*)(ws + WS_ACT + ACT_YB0))[(size_t)r * D + ch]) + bf2f(((const bf16*)(ws + WS_ACT + ACT_YB1))[(size_t)r * D + ch]);
    const float mean = wave_sum(y) / 64.f, var = wave_sum((y - mean) * (y - mean)) / 64.f;
    const float rj = bf2f(RKV[(size_t)r * D + ch]), kj = bf2f(RKV[(size_t)MT * D + (size_t)r * D + ch]), vj = bf2f(RKV[2 * (size_t)MT * D + (size_t)r * D + ch]);
    const float* SA = (const float*)(ws + WS_SA);
    const float sb = wave_sum(rj * p_rk[ch] * kj * (1.f - p_ka[ch])) + 0.5f * (SA[(size_t)r * 32 + hd] + SA[((size_t)MT + r) * 32 + hd]);
    const float ref = (y - mean) / sqrtf(var + GN_EPS) * p_lnw[ch] + p_lnb[ch] + sb * vj;
    const float got = bf2f(((const bf16*)(ws + WS_ACT + ACT_PO))[(size_t)r * D + ch]);
    if (dbg_bad(got, ref, 0.03f, 0.02f)) dbg_flag((unsigned*)(ws + WS_CTL), 12u);
}
__device__ __noinline__ void dbg_final(unsigned char* ws, float* out) {
    const unsigned code = __hip_atomic_load((unsigned*)(ws + WS_CTL) + CW_DBG, __ATOMIC_RELAXED, __HIP_MEMORY_SCOPE_AGENT);
    if (code) for (size_t i = (size_t)blockIdx.x * 512 + threadIdx.x; i < (size_t)ML * D; i += (size_t)gridDim.x * 512) out[i] = 1000.f * code;
}
#define DBG_PHASE(stmt) PH_BEGIN stmt; PH_END
#else
#define DBG_PHASE(stmt)
#endif

constexpr int NPH = 42;
__global__ void __launch_bounds__(NWAVES * 64, 2) mk_fwd(const Args args) {
    const Args& AR = args;
    extern __shared__ __attribute__((aligned(16))) unsigned char lds[];
    Frame F;
    F.lds = (LAS unsigned char*)lds;
    F.MISC = (volatile LAS unsigned*)(F.lds + LDSCTL_OFF);
    F.G = gridDim.x; { const int bx = blockIdx.x; F.vcu = (F.G % 8 == 0) ? (bx % 8) * (F.G / 8) + bx / 8 : bx; }
    F.ws = args.ws; F.ctl = (unsigned*)(args.ws + WS_CTL); F.out = args.out;
    F.modb = args.in[5];
    if (threadIdx.x < 16) ((LAS unsigned*)(F.lds + LDSCTL_OFF))[threadIdx.x] = 0u;
    __syncthreads();
    XcdBarrier bar; bar.bar = F.ctl + CW_BAR; bar.x = 0; bar.st = nullptr;
    if (!MK_PER_PHASE) bar = xcd_barrier_post(F.ctl + CW_BAR, F.MISC + 8);
    const int lo = args.ph_lo, hi = args.ph_hi;
    int ph = 0;
#define PH_BEGIN if (ph >= lo && ph < hi) {
#define PH_END   if (ph + 1 < hi) { if (MK_PER_PHASE) { if (threadIdx.x == 0) __hip_atomic_store(F.ctl + 0, 0xBADu, __ATOMIC_RELAXED, __HIP_MEMORY_SCOPE_AGENT); } else { xcd_barrier(bar); if (MK_PROBE & 16384) xcd_barrier(bar); } } } ++ph;

    float* XC = (float*)(F.ws + WS_XC);
    const ModRef MR{(const float*)(F.ws + WS_MODP), args.in[5], (const float*)(F.ws + WS_MODV)};
    bf16* HN = (bf16*)(F.ws + WS_ACT + ACT_HN);
    bf16* HB = (bf16*)(F.ws + WS_ACT + ACT_H);
    bf16* HNA = (bf16*)(F.ws + WS_ACT + 500 * MiB);
    float* PSB = (float*)(F.ws + WS_PS); float* RSTD = (float*)(F.ws + WS_RSTD);

    REP(16) PH_BEGIN p0_prologue(F, args); PH_END
    DBG_PHASE(dbg_check_mod(F.ws, AR.in[1], AR.in[3], AR.in[4], AR.in[5]))

#define FFN_STAGE(s_) do { constexpr int s = (s_); constexpr int layer = s >> 1, f = s & 1; constexpr int Mrows = (s == 3) ? ML : MT; \
        const float* srcL = (s == 0) ? AR.in[0] : F.out; const float* srcC = XC; \
        bf16* HNs = (s & 1) ? HNA : HN;        \
        if (s == 0) { REP(4) PH_BEGIN phase_norm<true, true>(F, srcL, srcC, 0, Mrows, AR.in[6] + (size_t)(layer * 3 + (f ? 2 : 0)) * D, layer, f ? 6 : 0, HNs); PH_END } \
        else if (s != 3) { PH_BEGIN phase_norm<true>(F, srcL, srcC, ML, Mrows, AR.in[6] + (size_t)(layer * 3 + (f ? 2 : 0)) * D, layer, f ? 6 : 0, HNs); PH_END }        \
        if (s == 0) { DBG_PHASE(dbg_check_hn(F.ws, AR.in[0], AR.in[2], AR.in[6], AR.in[5], 0, 0, 2u)) } \
        REP(s == 0 ? 2 : 0) PH_BEGIN { \
            OpBlk A{HNs, D / 64, true}, B{(const bf16*)(F.ws + (layer ? WS_WL1 : WS_WL0) + (size_t)f * 44 * MiB), D / 64, false}; \
            pg8::StaticOrder S; S.init(Mrows / 256, DFF / 128, F.G, (int)blockIdx.x); \
            EpiSwiGLU E{HB}; \
            pg8::gemm_phase(F.lds + RING_OFF, D, A, B, S, E); \
        } PH_END \
        if (s == 0) { DBG_PHASE(dbg_check_h(F.ws, AR.in[7])) } \
        PH_BEGIN { \
            OpHBlk A{HB, -1, 0}; OpBlk B{(const bf16*)(F.ws + (layer ? WS_WL1 : WS_WL0) + 88 * MiB + (size_t)f * 22 * MiB), HKT, false}; \
            pg8::StaticOrder S; S.init(ML / 256, D / 256, F.G, (int)blockIdx.x, 4, 0, 1); \
              \
            constexpr int NX = (s == 0) ? 2 : (s == 1) ? 1 : (s == 2) ? 3 : 4; constexpr int site = (s == 0) ? 0 : (s == 1) ? 2 : (s == 2) ? 3 : 5; \
            const float* nwn = (s == 0) ? AR.in[6] + (size_t)(0 * 3 + 1) * D : (s == 1) ? AR.in[6] + (size_t)(1 * 3 + 0) * D : AR.in[27]; \
            EpiResidNorm<false, true, NX> E{MR, srcL, F.out, nullptr, layer, f ? 8 : 2, nwn, (s == 0) ? 0 : 1, (s == 0) ? 3 : 0, HN, RSTD, PSB + (size_t)site * 262144, F.ctl + CW_PCNT + site * 1024, F.lds + RING_BYTES}; \
            pg8::gemm_phase(F.lds + RING_OFF, DFF, A, B, S, E); \
            if (Mrows > ML) { OpHBlk Ac{HB, 128, HKT / 4}; OpBlkK Bc{(const bf16*)(F.ws + (layer ? WS_WL1 : WS_WL0) + 88 * MiB + (size_t)f * 22 * MiB), HKT}; \
                OrderCtxK Sc{F.G, (int)blockIdx.x}; EpiCtxAtomic<false, true> Ec{MR, XC, nullptr, layer, f ? 8 : 2}; \
                pg8::gemm_phase(F.lds + RING_OFF, DFF / 4, Ac, Bc, Sc, Ec); } \
        } PH_END \
        if (s == 0) { DBG_PHASE(dbg_check_w2(F.ws, AR.in[0], AR.in[2], F.out, AR.in[8], AR.in[5])) } \
    } while (0)

    FFN_STAGE(0);
        {
            bf16* YT = (bf16*)(F.ws + WS_ACT + ACT_YT); bf16* T2 = (bf16*)(F.ws + WS_ACT + ACT_T2); bf16* YC = (bf16*)(F.ws + WS_ACT + ACT_YC);
            PH_BEGIN phase_norm<false>(F, F.out, XC, ML, MT, AR.in[6] + (size_t)(0 * 3 + 1) * D, 0, 3, HN); PH_END
            REP(64) PH_BEGIN {
                { OpFixed A{(const bf16*)(F.ws + WS_TAB + TAB_DMAT), 256, 1}; OpChanL B{HN}; pg8::StaticOrder S; S.init(16, 128, F.G, (int)blockIdx.x); EpiChanL E{YT};
                  pg8::gemm_phase(F.lds + RING_OFF, 256, A, B, S, E); }
                { OpFixed A{(const bf16*)(F.ws + WS_TAB + TAB_DMAT), 256, 1}; OpChanC B{HN}; pg8::StaticOrder S; S.init(16, 2, F.G, (int)blockIdx.x); EpiChanC E{YC};
                  pg8::gemm_phase(F.lds + RING_OFF, 256, A, B, S, E); }
            } PH_END
            REP(64) PH_BEGIN {
                { OpFixed A{(const bf16*)(F.ws + WS_TAB + TAB_M1), 256, 0}; pg8::OpPlain B{YT, 256, false}; pg8::StaticOrder S; S.init(1, 2048, F.G, (int)blockIdx.x); EpiStage1 E{T2, (const float*)(F.ws + WS_TAB + TAB_TW)};
                  pg8::gemm_phase(F.lds + RING_OFF, 256, A, B, S, E); }
                { OpFixed A{(const bf16*)(F.ws + WS_TAB + TAB_M3), 512, 0}; pg8::OpPlain B{YC, 512, false}; pg8::StaticOrder S; S.init(1, 16, F.G, (int)blockIdx.x); EpiCtxDft E{HN};
                  pg8::gemm_phase(F.lds + RING_OFF, 512, A, B, S, E); }
            } PH_END
            REP(64) PH_BEGIN {
                OpFixed A{(const bf16*)(F.ws + WS_TAB + TAB_M2), 256, 0}; OpStage2B B{T2}; pg8::StaticOrder S; S.init(1, 2048, F.G, (int)blockIdx.x); EpiStage2 E{HN};
                pg8::gemm_phase(F.lds + RING_OFF, 256, A, B, S, E);
            } PH_END
            DBG_PHASE(dbg_check_fourier(F.ws, F.out, AR.in[6] + D, AR.in[5], (LAS float*)F.lds))
            PH_BEGIN {
                pg8::OpPlain A{HN, D, true}, B{(const bf16*)(F.ws + WS_WFO), D, false};
                pg8::StaticOrder S; S.init(ML / 256, D / 256, F.G, (int)blockIdx.x, 4);
                EpiResidNorm<true, false, 1> E{MR, F.out, F.out, AR.in[10], 0, 5, AR.in[6] + (size_t)(0 * 3 + 2) * D, 0, 6, HNA, RSTD, PSB + (size_t)1 * 262144, F.ctl + CW_PCNT + 1 * 1024, F.lds + RING_BYTES};
                pg8::gemm_phase(F.lds + RING_OFF, D, A, B, S, E);
                OpKSplit Ac{HN + (size_t)ML * D, D, D / 4, true}, Bc{(const bf16*)(F.ws + WS_WFO), D, D / 4, false};
                OrderCtxK Sc{F.G, (int)blockIdx.x}; EpiCtxAtomic<true, false> Ec{MR, XC, AR.in[10], 0, 5};
                pg8::gemm_phase(F.lds + RING_OFF, D / 4, Ac, Bc, Sc, Ec);
            } PH_END
        }
    FFN_STAGE(1);
    FFN_STAGE(2);
    {
        bf16* XM = (bf16*)(F.ws + WS_ACT + ACT_XM); bf16* LR = (bf16*)(F.ws + WS_ACT + ACT_LR); bf16* PO = (bf16*)(F.ws + WS_ACT + ACT_PO);
        REP(8) PH_BEGIN phase_rowstats(F, F.out, XC, RSTD, ML); PH_END
        REP(4096) PH_BEGIN phase_mix(F, MR, F.out, XC, RSTD, AR.in[6] + (size_t)(1 * 3 + 1) * D, AR.in[11], XM); PH_END
        REP(128) PH_BEGIN {
            OpXM A{XM, 1, 3}; OpWSel B{(const bf16*)(F.ws + WS_WSMALL), 1, 1 * MiB}; pg8::StaticOrder S; S.init(MT / 256, 3, F.G, (int)blockIdx.x); EpiLora E{LR};
            pg8::gemm_phase(F.lds + RING_OFF, D, A, B, S, E);
            { OpXM Ac{XM, 8, 0}; OpWSel Bc{(const bf16*)(F.ws + WS_WRKV), 8, 8 * MiB}; pg8::StaticOrder Sc; Sc.init(2, 24, F.G, (int)((blockIdx.x + F.G - 140) % F.G), pg8::WGM, 128); EpiRkvC Ec{(bf16*)(F.ws + WS_RKVC)};
              pg8::gemm_phase(F.lds + RING_OFF, D, Ac, Bc, Sc, Ec); }
        } PH_END
        DBG_PHASE(dbg_check_lora(F.ws, AR.in[14], AR.in[17], AR.in[19]))
        REP(512) PH_BEGIN {
            OpXM A{XM, 8, 0}; OpWSel B{(const bf16*)(F.ws + WS_WRKV), 8, 8 * MiB}; pg8::StaticOrder S; S.init(ML / 256, 24, F.G, (int)blockIdx.x); EpiRkv E{XM};
            pg8::gemm_phase(F.lds + RING_OFF, D, A, B, S, E);
        } PH_END
        DBG_PHASE(dbg_check_rkv(F.ws, AR.in[12]))
        REP(1)
#pragma unroll 1
        for (int w = 0; w <= SCAN_NW; ++w) { PH_BEGIN phase_scan_step(F, args, w); PH_END }
        DBG_PHASE(dbg_check_scan(F.ws, AR.in[13], AR.in[16], AR.in[21], AR.in[22], AR.in[15], AR.in[18]))
        REP(256) PH_BEGIN phase_combine(F, args, PO); PH_END
        DBG_PHASE(dbg_check_combine(F.ws, AR.in[22], AR.in[23], AR.in[24], AR.in[25]))
        PH_BEGIN {
            pg8::OpPlain A{(const bf16*)((const char*)LR + 2 * LR_STRIDE), 256, true}, B{(const bf16*)(F.ws + WS_WSMALL + WSM_G2T), 256, false};
            pg8::StaticOrder S; S.init(ML / 256, D / 256, F.G, (int)blockIdx.x); EpiMulG<> E{PO};
            if (MK_PROBE & 32768) { EpiMulG<true> Ed{PO}; pg8::gemm_phase(F.lds + RING_OFF, 256, A, B, S, Ed); }
            pg8::gemm_phase(F.lds + RING_OFF, 256, A, B, S, E);
        } PH_END
        PH_BEGIN {
            pg8::OpPlain A{PO, D, true}, B{(const bf16*)(F.ws + WS_WRO), D, false};
            pg8::StaticOrder S; S.init(ML / 256, D / 256, F.G, (int)blockIdx.x, 4);
            EpiResidNorm<false, false, 1> E{MR, F.out, F.out, nullptr, 1, 5, AR.in[6] + (size_t)(1 * 3 + 2) * D, 1, 6, HNA, RSTD, PSB + (size_t)4 * 262144, F.ctl + CW_PCNT + 4 * 1024, F.lds + RING_BYTES};
            pg8::gemm_phase(F.lds + RING_OFF, D, A, B, S, E);
        } PH_END
    }
    FFN_STAGE(3);
    DBG_PHASE(dbg_final(F.ws, F.out))
#undef PH_BEGIN
#undef PH_END
}

extern "C" void kernel_launch(void* const* d_in, const int* in_sizes, int n_in, void* d_out, int out_size, void* d_ws, size_t ws_size, hipStream_t stream) {
    static int grid = 0;
    if (grid == 0) {
        if (n_in != 28 || out_size != ML * D || ws_size < WS_END) { fprintf(stderr, "kernel_launch: unexpected shapes (n_in %d, out %d, ws %zu < %zu)\n", n_in, out_size, ws_size, (size_t)WS_END); grid = -1; return; }
        int dev = 0, cus = 0, per_cu = 0;
        if (hipGetDevice(&dev) != hipSuccess || hipDeviceGetAttribute(&cus, hipDeviceAttributeMultiprocessorCount, dev) != hipSuccess) { grid = -1; return; }
        if (hipFuncSetAttribute((const void*)mk_fwd, hipFuncAttributeMaxDynamicSharedMemorySize, LDS_BYTES) != hipSuccess) { fprintf(stderr, "kernel_launch: hipFuncSetAttribute failed\n"); grid = -1; return; }
        if (hipOccupancyMaxActiveBlocksPerMultiprocessor(&per_cu, (const void*)mk_fwd, NWAVES * 64, LDS_BYTES) != hipSuccess || per_cu < 1)
            fprintf(stderr, "kernel_launch: occupancy query reports %d per CU\n", per_cu);
        (void)hipGetLastError();
        grid = cus;
        if (cus != 256) { fprintf(stderr, "kernel_launch: built for a 256-CU device (the scan phase maps its 256 chains-halves onto 256 workgroups); found %d CUs, nothing launched\n", cus); grid = -1; return; }
    }
    if (grid < 0) return;
    if (hipMemsetAsync((char*)d_ws + WS_CTL, 0, CTL_ZERO_BYTES, stream) != hipSuccess) return;
    Args a{};
    for (int i = 0; i < 28; ++i) a.in[i] = (const float*)d_in[i];
    a.out = (float*)d_out; a.ws = (unsigned char*)d_ws;
#if MK_PER_PHASE
    for (int p = 0; p < NPH; ++p) { a.ph_lo = p; a.ph_hi = p + 1; hipLaunchKernelGGL(mk_fwd, dim3(grid), dim3(NWAVES * 64), LDS_BYTES, stream, a); }
#else
    a.ph_lo = 0; a.ph_hi = 100000;
    hipLaunchKernelGGL(mk_fwd, dim3(grid), dim3(NWAVES * 64), LDS_BYTES, stream, a);
#endif
}
```

```cpp
#include <hip/hip_runtime.h>
#include <cstdio>
#include <cstdint>

#ifndef MK_PER_PHASE
#define MK_PER_PHASE 0
#endif
#ifndef MK_PROBE
#define MK_PROBE 0
#endif
#define REP(mask) _Pragma("unroll 1") for (int rep_ = 0; rep_ < ((MK_PROBE & (mask)) ? 2 : 1); ++rep_)
#ifndef MK_DEBUG
#define MK_DEBUG 0
#endif

#define GAS __attribute__((address_space(1)))
#define LAS __attribute__((address_space(3)))
typedef unsigned short bf16;
typedef unsigned v4u __attribute__((ext_vector_type(4)));
typedef unsigned v2u __attribute__((ext_vector_type(2)));
typedef float f32x4 __attribute__((ext_vector_type(4)));
typedef float f32x2 __attribute__((ext_vector_type(2)));
typedef float f32x16 __attribute__((ext_vector_type(16)));
typedef short bf16x8 __attribute__((ext_vector_type(8)));
typedef __bf16 bf2_t __attribute__((ext_vector_type(2)));

constexpr int D = 2048, NBATCH = 2, SEQ = 16384, CTXL = 256, DFF = 5632, NMODV = 9 * 2048, NH = 32, HD = 64;
constexpr int ML = NBATCH * SEQ, MC = NBATCH * CTXL, MT = ML + MC;
constexpr int LORA = 96;
constexpr int HKT = DFF / 64;
constexpr int NWAVES = 8;
constexpr float NORM_EPS = 1e-6f, GN_EPS = 64e-5f;

constexpr size_t MiB = 1u << 20;
constexpr size_t WS_CTL = 0, CTL_ZERO_BYTES = 64 * 1024;
constexpr size_t WS_MODP = 1 * MiB;
constexpr size_t WS_TAB = 3 * MiB;
constexpr size_t TAB_DMAT = 0, TAB_M1 = 262144, TAB_M2 = 393216, TAB_M3 = 524288, TAB_TW = 786432;
constexpr size_t WS_RSTD = 4 * MiB;
constexpr size_t WS_SA = 5 * MiB;
constexpr size_t WS_XC = 14 * MiB;
constexpr size_t WS_WSMALL = 18 * MiB;
constexpr size_t WSM_W1CAT = 0, WSM_A1CAT = 1 * MiB, WSM_G1T = 2 * MiB, WSM_W2UP = 3 * MiB, WSM_A2UP = 4 * MiB, WSM_G2T = 5 * MiB;
constexpr size_t WS_WFO = 24 * MiB, WS_WRO = 32 * MiB, WS_WRKV = 40 * MiB;
constexpr size_t WS_WL0 = 64 * MiB, WS_WL1 = 196 * MiB;
constexpr size_t WS_ACT = 328 * MiB;
constexpr size_t ACT_HN = 0, ACT_H = 130 * MiB;
constexpr size_t ACT_YT = 130 * MiB, ACT_T2 = 386 * MiB, ACT_YC = 642 * MiB;
constexpr size_t ACT_XM = 0, XM_STRIDE = 130 * MiB, ACT_LR = 780 * MiB, LR_STRIDE = 17039360;
constexpr size_t ACT_WBUF = 0, WBUF_STRIDE = 123 * MiB, ACT_YB0 = 248 * MiB, ACT_YB1 = 829 * MiB, ACT_PO = 0;
constexpr size_t WS_SST = WS_ACT + 957 * MiB;
constexpr size_t WS_RKVC = WS_SST + 2 * MiB;
constexpr size_t WS_PS = WS_RKVC + 6 * MiB;
constexpr size_t WS_MODV = WS_PS + 6 * MiB;
constexpr size_t WS_DUMP = WS_MODV + 1 * MiB;
constexpr size_t WS_END = WS_DUMP + 16 * MiB;
static_assert(WS_END <= 1476395008ull, "workspace map exceeds the guaranteed minimum");
static_assert((size_t)MT * D * 2 == 130 * MiB, "XM size");

constexpr int CW_DBG = 8;
constexpr int CW_BAR = 4096;
constexpr int CW_PCNT = 8192;

#define LDS_WAIT() asm volatile("s_waitcnt lgkmcnt(0)" ::: "memory")
#define VM_WAIT() asm volatile("s_waitcnt vmcnt(0)" ::: "memory")
__device__ __forceinline__ unsigned pk2(float lo, float hi) { f32x2 v = {lo, hi}; bf2_t b = __builtin_convertvector(v, bf2_t); return __builtin_bit_cast(unsigned, b); }
__device__ __forceinline__ float bf2f(bf16 b) { return __uint_as_float(((unsigned)b) << 16); }
__device__ __forceinline__ float bflo(unsigned w) { return __uint_as_float(w << 16); }
__device__ __forceinline__ float bfhi(unsigned w) { return __uint_as_float(w & 0xffff0000u); }
__device__ __forceinline__ float wave_sum(float v) {
#pragma unroll
    for (int o = 1; o < 64; o <<= 1) v += __shfl_xor(v, o);
    return v;
}
__device__ __forceinline__ float sigmoidf_(float x) { return __builtin_amdgcn_rcpf(1.f + __expf(-x)); }

#define XB_TMO      128
#define XB_XCNT(j)  (256  + 64 * (j))
#define XB_XSUB(j)  (1280 + 64 * (j))
#define XB_XGEN(j)  (2304 + 64 * (j))
#define XB_TOP      3328
#define XB_TOPGEN   3392
#define XCD_BAR_WORDS 3456
#define XB_SPIN_CAP (1u << 22)

__device__ __forceinline__ unsigned xb_ld(unsigned* p)              { return __hip_atomic_load(p, __ATOMIC_RELAXED, __HIP_MEMORY_SCOPE_AGENT); }
__device__ __forceinline__ unsigned xb_add(unsigned* p, unsigned v) { return __hip_atomic_fetch_add(p, v, __ATOMIC_RELAXED, __HIP_MEMORY_SCOPE_AGENT); }
__device__ __forceinline__ unsigned xb_xcc_id() { return (unsigned)__builtin_amdgcn_s_getreg((3 << 11) | 20) & 0xFu; }
#define XB_SPIN(cond, bar) do { unsigned _sp = 0; while (cond) { __builtin_amdgcn_s_sleep(1); \
    if ((++_sp & 255u) == 0u) { if (xb_ld(&(bar)[XB_TMO])) break; if (_sp > XB_SPIN_CAP) { atomicAdd(&(bar)[XB_TMO], 1u); break; } } } } while (0)

struct XcdBarrier { unsigned* bar; unsigned x; volatile LAS unsigned* st; };

__device__ __forceinline__ XcdBarrier xcd_barrier_post(unsigned* bar, volatile LAS unsigned* st) {
    XcdBarrier b; b.bar = bar; b.x = xb_xcc_id(); b.st = st;
    if (threadIdx.x == 0) (void)xb_add(&bar[XB_XCNT(b.x)], 1u);
    return b;
}
__device__ __forceinline__ void xcd_barrier_complete(unsigned* bar, unsigned x, unsigned& nloc, unsigned& nx) {
    const unsigned G = gridDim.x * gridDim.y * gridDim.z;
    unsigned sum, cnt, mine, sp = 0u;
    for (;;) {
        sum = 0u; cnt = 0u; mine = 0u;
#pragma unroll
        for (unsigned j = 0; j < 16; ++j) { const unsigned c = xb_ld(&bar[XB_XCNT(j)]); sum += c; cnt += (c > 0u) ? 1u : 0u; mine = (j == x) ? c : mine; }
        if (sum == G) break;
        __builtin_amdgcn_s_sleep(1);
        if ((++sp & 255u) == 0u) { if (xb_ld(&bar[XB_TMO])) break; if (sp > XB_SPIN_CAP) { atomicAdd(&bar[XB_TMO], 1u); break; } }
    }
    nloc = mine > 0u ? mine : 1u; nx = cnt > 0u ? cnt : 1u;
}
__device__ __forceinline__ void xcd_barrier(const XcdBarrier& b) {
    asm volatile("s_waitcnt vmcnt(0)" ::: "memory");
    __syncthreads();
    if (threadIdx.x == 0) {
        unsigned* bar = b.bar;
        __builtin_amdgcn_s_waitcnt(0);
        unsigned nloc = b.st[0], nx = b.st[1];
        if (nloc == 0u) { xcd_barrier_complete(bar, b.x, nloc, nx); b.st[0] = nloc; b.st[1] = nx; }
        const unsigned old = xb_add(&bar[XB_XSUB(b.x)], 1u);
        const unsigned gen = old / nloc;
        if (old + 1u == (gen + 1u) * nloc) {
            __builtin_amdgcn_fence(__ATOMIC_RELEASE, "agent");
            asm volatile("s_waitcnt vmcnt(0)" ::: "memory");
            const unsigned og = xb_add(&bar[XB_TOP], 1u);
            const unsigned tg = og / nx;
            if (og + 1u == (tg + 1u) * nx) xb_add(&bar[XB_TOPGEN], 1u);
            else XB_SPIN(xb_ld(&bar[XB_TOPGEN]) == tg, bar);
            __builtin_amdgcn_fence(__ATOMIC_ACQUIRE, "agent");
            xb_add(&bar[XB_XGEN(b.x)], 1u);
            asm volatile("s_waitcnt vmcnt(0)" ::: "memory");
        } else {
            XB_SPIN(xb_ld(&bar[XB_XGEN(b.x)]) == gen, bar);
            __builtin_amdgcn_fence(__ATOMIC_ACQUIRE, "agent");
            asm volatile("s_waitcnt vmcnt(0)" ::: "memory");
        }
    }
    __syncthreads();
}

namespace pg8 {
constexpr int BM = 256, BK = 64, HALF = 128, HTB = HALF * BK * 2, STAGE_BYTES = 8 * HTB, NXCD = 8, WGM = 8;
__host__ __device__ __forceinline__ int lds_byte(int r, int c) { const int st = (r >> 4) * 2 + (c >> 5), rr = r & 15, cc = c & 31, ob = rr * 64 + cc * 2; return st * 1024 + (ob ^ (((ob >> 9) & 1) << 5)); }
__host__ __device__ __forceinline__ void stage_rc(int b, int& R, int& C) { const int st = b / 1024, sb = b % 1024, swz = sb ^ (((sb >> 9) & 1) << 5); R = (st >> 1) * 16 + swz / 64; C = (st & 1) * 32 + (swz % 64) / 2; }
__host__ __device__ __forceinline__ int perm32(int rho) { const int n = rho >> 4, i = rho & 15; return 8 * (i >> 2) + 4 * n + (i & 3); }

struct Unit { int pm, pn; };
struct StaticOrder {
    int nM, nN, nwg, G, c, wgm, pm0, rev;
    __host__ __device__ void init(int nM_, int nN_, int G_, int c_, int wgm_ = WGM, int pm0_ = 0, int rev_ = 0) { nM = nM_; nN = nN_; nwg = nM * nN; G = G_; c = c_; wgm = wgm_; pm0 = pm0_; rev = rev_; }
    __host__ __device__ bool next(int i, Unit& u) const {
        const long L = (long)i * G + c; if (L >= nwg) return false;
        int wgid = (int)L; { const int q = nwg / NXCD, r = nwg % NXCD, xcd = wgid % NXCD, off = wgid / NXCD; wgid = (xcd < r ? xcd * (q + 1) : r * (q + 1) + (xcd - r) * q) + off; }
        const int nig = wgm * nN, gid = wgid / nig, fm = gid * wgm, gsz = (nM - fm) < wgm ? (nM - fm) : wgm;
        const int pmi = fm + ((wgid % nig) % gsz); u.pm = pm0 + (rev ? nM - 1 - pmi : pmi); u.pn = (wgid % nig) / gsz; return true;
    }
};
struct OpPlain {
    const bf16* base; int ld; bool isA;
    __device__ __forceinline__ const char* tile(const Unit& u) const { return (const char*)base + (size_t)(isA ? u.pm : u.pn) * 256 * ld * 2; }
    __device__ __forceinline__ unsigned voff(int R, int C) const { return (unsigned)(R * ld + C) * 2u; }
    __device__ __forceinline__ size_t hstep() const { return (size_t)HALF * ld * 2; }
    __device__ __forceinline__ size_t kstep() const { return 128; }
};

template <class AOp, class BOp, class Epi, class Sched>
__device__ __forceinline__ void gemm_phase(LAS unsigned char* lds, const int K, const AOp& Aop, const BOp& Bop, const Sched& S, const Epi& E) {
    int tid = threadIdx.x; asm volatile("" : "+v"(tid));
    const int wid = __builtin_amdgcn_readfirstlane(tid >> 6), lane = tid & 63, wr = wid >> 2, wc = wid & 3, fr = lane & 15, fq = lane >> 4;
    int nt = K / BK; asm volatile("" : "+s"(nt));
    unsigned voffA[2], voffB[2];
#pragma unroll
    for (int i = 0; i < 2; ++i) { int R, C; stage_rc(tid * 16 + i * 8192, R, C); const int Rb = Epi::PERM ? ((R & ~31) + perm32(R & 31)) : R;
        voffA[i] = Aop.voff(R, C); voffB[i] = Bop.voff(Rb, C); }
    const size_t kstepA = Aop.kstep(), kstepB = Bop.kstep();
    const size_t hstepA = Aop.hstep(), hstepB = Bop.hstep();
    const unsigned ldsw = (unsigned)wid * 1024u;
    const int aoff = lds_byte(wr * 64 + fr, fq * 8), boff = lds_byte(wc * 32 + fr, fq * 8);
#define PG8_SA(b, h) (((b) * 2 + (h)) * HTB)
#define PG8_SB(b, h) ((4 + (b) * 2 + (h)) * HTB)
#define PG8_STAGE(bufoff, gbase, voff) do { _Pragma("unroll") for (int _i = 0; _i < 2; ++_i) \
        __builtin_amdgcn_global_load_lds((const unsigned*)((const char*)(gbase) + (voff)[_i]), (LAS unsigned*)(lds + (bufoff) + ldsw + _i * 8192), 16, 0, 0); } while (0)
#define PG8_LDA(dst, b, h) do { _Pragma("unroll") for (int m = 0; m < 4; ++m) _Pragma("unroll") for (int k = 0; k < 2; ++k) dst[m][k] = *(const LAS bf16x8*)(lds + PG8_SA(b, h) + aoff + m * 2048 + k * 1024); } while (0)
#define PG8_LDB(dst, b, h) do { _Pragma("unroll") for (int n = 0; n < 2; ++n) _Pragma("unroll") for (int k = 0; k < 2; ++k) dst[n][k] = *(const LAS bf16x8*)(lds + PG8_SB(b, h) + boff + n * 2048 + k * 1024); } while (0)
#define PG8_MMA(ai, bj, At, Bt) do { __builtin_amdgcn_s_setprio(1); _Pragma("unroll") for (int m = 0; m < 4; ++m) _Pragma("unroll") for (int n = 0; n < 2; ++n) _Pragma("unroll") for (int k = 0; k < 2; ++k) \
        acc[ai][bj][m][n] = __builtin_amdgcn_mfma_f32_16x16x32_bf16(Bt[n][k], At[m][k], acc[ai][bj][m][n], 0, 0, 0); __builtin_amdgcn_s_setprio(0); } while (0)
#define PG8_WAIT_V(n) asm volatile("s_waitcnt vmcnt(" #n ")" ::: "memory")
#define PG8_WAIT_L(n) asm volatile("s_waitcnt lgkmcnt(" #n ")" ::: "memory")
#define PG8_BAR __builtin_amdgcn_s_barrier()
#define PG8_SCHED __builtin_amdgcn_sched_barrier(0)
    Unit cur, nxt; int ui = 0;
    if (!S.next(0, cur)) return;
    f32x4 acc[2][2][4][2];
#pragma unroll
    for (int a = 0; a < 2; ++a)
#pragma unroll
        for (int b = 0; b < 2; ++b)
#pragma unroll
            for (int m = 0; m < 4; ++m)
#pragma unroll
                for (int n = 0; n < 2; ++n) acc[a][b][m][n] = (f32x4){0.f, 0.f, 0.f, 0.f};
    bf16x8 At[4][2], B0[2][2], B1[2][2];
    const char* cA = Aop.tile(cur); const char* cB = Bop.tile(cur);
    PG8_STAGE(PG8_SB(0, 0), cB, voffB); PG8_STAGE(PG8_SB(0, 1), cB + hstepB, voffB); PG8_STAGE(PG8_SA(0, 0), cA, voffA); PG8_STAGE(PG8_SA(0, 1), cA + hstepA, voffA);
    if (wr == 1) PG8_BAR;
    PG8_WAIT_V(2); PG8_BAR;
    PG8_STAGE(PG8_SB(1, 0), cB + kstepB, voffB); PG8_STAGE(PG8_SA(1, 0), cA + kstepA, voffA); PG8_STAGE(PG8_SB(1, 1), cB + hstepB + kstepB, voffB);
    PG8_WAIT_V(6); PG8_BAR;
    for (;;) {
        const bool has_next = S.next(ui + 1, nxt);
        const char* nA = has_next ? Aop.tile(nxt) : cA; const char* nB = has_next ? Bop.tile(nxt) : cB;
#pragma unroll 1
        for (int t = 0; t < nt; t += 2) {
            const bool last = (t == nt - 2);
            const char* a1 = cA + (size_t)(t + 1) * kstepA;
            const char* a2 = last ? nA : cA + (size_t)(t + 2) * kstepA; const char* b2 = last ? nB : cB + (size_t)(t + 2) * kstepB;
            const char* a3 = a2 + kstepA; const char* b3 = b2 + kstepB;
            PG8_LDB(B0, 0, 0); PG8_LDB(B1, 0, 1); PG8_SCHED; PG8_LDA(At, 0, 0); PG8_STAGE(PG8_SA(1, 1), a1 + hstepA, voffA);
            PG8_WAIT_V(8); PG8_WAIT_L(0); PG8_BAR; PG8_MMA(0, 0, At, B0); PG8_MMA(0, 1, At, B1); PG8_BAR; PG8_SCHED;
            PG8_LDA(At, 0, 1); PG8_STAGE(PG8_SB(0, 0), b2, voffB); PG8_STAGE(PG8_SB(0, 1), b2 + hstepB, voffB); PG8_STAGE(PG8_SA(0, 0), a2, voffA);
            PG8_WAIT_V(8); PG8_WAIT_L(0); PG8_BAR; PG8_MMA(1, 0, At, B0); PG8_MMA(1, 1, At, B1); PG8_BAR; PG8_SCHED;
            PG8_LDB(B0, 1, 0); PG8_LDB(B1, 1, 1); PG8_SCHED; PG8_LDA(At, 1, 0); PG8_STAGE(PG8_SA(0, 1), a2 + hstepA, voffA);
            PG8_WAIT_V(8); PG8_WAIT_L(0); PG8_BAR; PG8_MMA(0, 0, At, B0); PG8_MMA(0, 1, At, B1); PG8_BAR; PG8_SCHED;
            PG8_LDA(At, 1, 1); PG8_STAGE(PG8_SB(1, 0), b3, voffB); PG8_STAGE(PG8_SB(1, 1), b3 + hstepB, voffB); PG8_STAGE(PG8_SA(1, 0), a3, voffA);
            PG8_WAIT_V(8); PG8_WAIT_L(0); PG8_BAR; PG8_MMA(1, 0, At, B0); PG8_MMA(1, 1, At, B1); PG8_BAR; PG8_SCHED;
        }
        if (wr == 0) PG8_BAR;
        E(acc, cur, wr, wc, fr, fq);
        if (!has_next) break;
#pragma unroll
        for (int a = 0; a < 2; ++a)
#pragma unroll
            for (int b = 0; b < 2; ++b)
#pragma unroll
                for (int m = 0; m < 4; ++m)
#pragma unroll
                    for (int n = 0; n < 2; ++n) acc[a][b][m][n] = (f32x4){0.f, 0.f, 0.f, 0.f};
        cur = nxt; cA = nA; cB = nB; ++ui;
        if (wr == 1) PG8_BAR;
    }
    PG8_WAIT_V(0);
    PG8_BAR;
#undef PG8_SA
#undef PG8_SB
#undef PG8_STAGE
#undef PG8_LDA
#undef PG8_LDB
#undef PG8_MMA
#undef PG8_WAIT_V
#undef PG8_WAIT_L
#undef PG8_BAR
#undef PG8_SCHED
}
}

constexpr int RING_OFF = 0, RING_BYTES = 131072;
constexpr int LDSCTL_OFF = 160 * 1024 - 64;
constexpr int LDS_BYTES = 160 * 1024;

struct Args { const float* in[28]; float* out; unsigned char* ws; int ph_lo, ph_hi; };
struct Frame {
    LAS unsigned char* lds;
    volatile LAS unsigned* MISC;
    unsigned* ctl;
    int vcu, G;
    float* out; unsigned char* ws; const float* modb;
};
struct ModRef { const float* modp; const float* modb; const float* modv; };
__device__ __forceinline__ f32x4 modv4(const ModRef& M, int layer, int who, int col  ) {
    const float* p = M.modp + ((size_t)(layer * 3 + who)) * NMODV + col;
    f32x4 s = *(const f32x4*)(M.modb + (size_t)layer * NMODV + col);
#pragma unroll
    for (int q = 0; q < 4; ++q) s += *(const f32x4*)(p + (size_t)q * 6 * NMODV);
    return s;
}
__device__ __forceinline__ f32x4 modvF(const ModRef& M, int layer, int who, int col) { return *(const f32x4*)(M.modv + ((size_t)(layer * 3 + who)) * NMODV + col); }
__device__ __forceinline__ int who_of_row(int r) { return r < SEQ ? 0 : (r < ML ? 1 : 2); }

struct EpiSwiGLU {
    static constexpr bool PERM = true;
    bf16* H;
    __device__ __forceinline__ void operator()(const f32x4 (&acc)[2][2][4][2], const pg8::Unit& u, int wr, int wc, int fr, int fq) const {
        const int rl0 = wr * 64 + fr; const size_t tb = ((size_t)u.pm * HKT + 2 * u.pn + (wc >> 1)) * 16384 + 32 * (wc & 1) + 8 * fq;
#pragma unroll
        for (int ai = 0; ai < 2; ++ai)
#pragma unroll
            for (int m = 0; m < 4; ++m) {
                bf16* rowp = H + tb + (size_t)(rl0 + ai * 128 + m * 16) * 64;
                float h[8];
#pragma unroll
                for (int n = 0; n < 2; ++n)
#pragma unroll
                    for (int e = 0; e < 4; ++e) { const float g = acc[ai][0][m][n][e], up = acc[ai][1][m][n][e]; h[4 * n + e] = g * sigmoidf_(g) * up; }
                v4u w; w.x = pk2(h[0], h[1]); w.y = pk2(h[2], h[3]); w.z = pk2(h[4], h[5]); w.w = pk2(h[6], h[7]);
                *(v4u*)rowp = w;
            }
    }
};
template <bool HAS_BIAS, bool HALF, bool DRY = false> struct EpiResid {
    static constexpr bool PERM = false;
    ModRef MR; const float* baseL; const float* baseC; float* outL; float* outC; const float* bias; int layer, gidx;
    __device__ __forceinline__ void operator()(const f32x4 (&acc)[2][2][4][2], const pg8::Unit& u, int wr, int wc, int fr, int fq) const {
        const int who = u.pm < 64 ? 0 : (u.pm < 128 ? 1 : 2);
        const bool isl = u.pm < 128;
        const int rbase = (isl ? u.pm : u.pm - 128) * 256 + wr * 64 + fr;
        const float* bp = isl ? baseL : baseC; float* op = isl ? outL : outC;
        const int col0 = u.pn * 256 + wc * 32 + 4 * fq;
        f32x4 gv[2][2], bv[2][2];
#pragma unroll
        for (int bj = 0; bj < 2; ++bj)
#pragma unroll
            for (int n = 0; n < 2; ++n) { gv[bj][n] = modvF(MR, layer, who, gidx * D + col0 + bj * 128 + n * 16) * (HALF ? 0.5f : 1.0f);
                bv[bj][n] = (f32x4){0.f, 0.f, 0.f, 0.f}; if (HAS_BIAS) bv[bj][n] = *(const f32x4*)(bias + col0 + bj * 128 + n * 16); }
#pragma unroll
        for (int ai = 0; ai < 2; ++ai) {
            f32x4 bs[4][2][2];
#pragma unroll
            for (int m = 0; m < 4; ++m)
#pragma unroll
                for (int bj = 0; bj < 2; ++bj)
#pragma unroll
                    for (int n = 0; n < 2; ++n) bs[m][bj][n] = *(const f32x4*)(bp + (size_t)(rbase + ai * 128 + m * 16) * D + col0 + bj * 128 + n * 16);
#pragma unroll
            for (int m = 0; m < 4; ++m) asm volatile("" : "+v"(bs[m][0][0]), "+v"(bs[m][0][1]), "+v"(bs[m][1][0]), "+v"(bs[m][1][1]));
#pragma unroll
            for (int m = 0; m < 4; ++m)
#pragma unroll
                for (int bj = 0; bj < 2; ++bj)
#pragma unroll
                    for (int n = 0; n < 2; ++n) { const f32x4 o_ = bs[m][bj][n] + gv[bj][n] * (acc[ai][bj][m][n] + bv[bj][n]);
                        if (!DRY || o_.x == 123456.789f) *(f32x4*)(op + (size_t)(rbase + ai * 128 + m * 16) * D + col0 + bj * 128 + n * 16) = o_; }
            asm volatile("" ::: "memory");
        }
    }
};

template <bool HAS_BIAS, bool HALF, int NX> struct EpiResidNorm {
    static constexpr bool PERM = false;
    ModRef MR; const float* baseL; float* outL; const float* bias; int layer, gidx;
    const float* nw; int nlayer, sidx; bf16* HN; float* RSTD; float* PS; unsigned* cnt; LAS unsigned char* sl;
    __device__ __forceinline__ void operator()(const f32x4 (&acc)[2][2][4][2], const pg8::Unit& u, int wr, int wc, int fr_, int fq_) const {
        int fr = fr_, fq = fq_; asm volatile("" : "+v"(fr), "+v"(fq));
        const int who = u.pm < 64 ? 0 : 1;
        const int rbase = u.pm * 256 + wr * 64 + fr;
        const int col0 = u.pn * 256 + wc * 32 + 4 * fq;
        const unsigned eo0 = (unsigned)(rbase * D + col0) * 4u;
        char* dump = (char*)RSTD + (WS_DUMP - WS_RSTD) + (size_t)blockIdx.x * 65536 + ((wr * 4 + wc) * 64 + fq * 16 + fr) * 16;
        f32x4 xn[2][2][4][2]; float ssq[2][4];
        {
            f32x4 gv[2][2];
#pragma unroll
            for (int bj = 0; bj < 2; ++bj)
#pragma unroll
                for (int n = 0; n < 2; ++n) { gv[bj][n] = modvF(MR, layer, who, gidx * D + col0 + bj * 128 + n * 16) * (HALF ? 0.5f : 1.0f);
                    f32x4 bv = (f32x4){0.f, 0.f, 0.f, 0.f}; if (HAS_BIAS) bv = *(const f32x4*)(bias + col0 + bj * 128 + n * 16);
#pragma unroll
                    for (int ai = 0; ai < 2; ++ai)
#pragma unroll
                        for (int m = 0; m < 4; ++m) { xn[ai][bj][m][n] = acc[ai][bj][m][n]; if (HAS_BIAS) xn[ai][bj][m][n] += bv; } }
#pragma unroll
            for (int ai = 0; ai < 2; ++ai) {
                f32x4 bs[4][2][2];
#pragma unroll
                for (int m = 0; m < 4; ++m)
#pragma unroll
                    for (int bj = 0; bj < 2; ++bj)
#pragma unroll
                        for (int n = 0; n < 2; ++n) bs[m][bj][n] = *(const f32x4*)((const char*)baseL + (size_t)(eo0 + (unsigned)((ai * 128 + m * 16) * D) * 4u) + (bj * 128 + n * 16) * 4);
#pragma unroll
                for (int m = 0; m < 4; ++m) asm volatile("" : "+v"(bs[m][0][0]), "+v"(bs[m][0][1]), "+v"(bs[m][1][0]), "+v"(bs[m][1][1]));
#pragma unroll
                for (int m = 0; m < 4; ++m) { float sq = 0.f;
#pragma unroll
                    for (int bj = 0; bj < 2; ++bj)
#pragma unroll
                        for (int n = 0; n < 2; ++n) { const f32x4 o_ = bs[m][bj][n] + gv[bj][n] * xn[ai][bj][m][n];
                            if (NX != 4) *(f32x4*)((char*)outL + (size_t)(eo0 + (unsigned)((ai * 128 + m * 16) * D) * 4u) + (bj * 128 + n * 16) * 4) = o_;
                            else *(f32x4*)(dump + ((m * 4 + bj * 2 + n) & 7) * 512) = o_;
                            xn[ai][bj][m][n] = o_; sq += (o_.x * o_.x + o_.y * o_.y) + (o_.z * o_.z + o_.w * o_.w); }
                    ssq[ai][m] = sq; }
                asm volatile("" ::: "memory");
            }
        }
        f32x4 a4[2][2], b4[2][2];
        if (NX != 3) {
#pragma unroll
            for (int bj = 0; bj < 2; ++bj)
#pragma unroll
                for (int n = 0; n < 2; ++n) { const int col = col0 + bj * 128 + n * 16;
                    a4[bj][n] = *(const f32x4*)(nw + col); b4[bj][n] = (f32x4){0.f, 0.f, 0.f, 0.f};
                    if (NX != 4) { a4[bj][n] = a4[bj][n] * (modvF(MR, nlayer, who, (sidx + 1) * D + col) + 1.f); b4[bj][n] = modvF(MR, nlayer, who, sidx * D + col); } }
        }
        LAS float* P = (LAS float*)sl; LAS float* RS = P + 1024;
#pragma unroll
        for (int ai = 0; ai < 2; ++ai)
#pragma unroll
            for (int m = 0; m < 4; ++m) { float v = ssq[ai][m]; v += __shfl_xor(v, 16); v += __shfl_xor(v, 32); if (fq == 0) P[wc * 256 + ai * 128 + wr * 64 + m * 16 + fr] = v; }
        LDS_WAIT(); __builtin_amdgcn_s_barrier(); asm volatile("" ::: "memory");
        const int wid = wr * 4 + wc, t = wid * 64 + fq * 16 + fr;
        if (wid < 4) {
            const float v = (P[t] + P[256 + t]) + (P[512 + t] + P[768 + t]);
            unsigned* slot = (unsigned*)PS + (size_t)u.pm * 2048 + t;
            __hip_atomic_store(slot + u.pn * 256, __float_as_uint(v) | 1u, __ATOMIC_RELAXED, __HIP_MEMORY_SCOPE_AGENT);
            float tot = 0.f;
            for (int it = 0; it < (1 << 20); ++it) { unsigned w[8]; bool ok = true;
#pragma unroll
                for (int j = 0; j < 8; ++j) { w[j] = __hip_atomic_load(slot + j * 256, __ATOMIC_RELAXED, __HIP_MEMORY_SCOPE_AGENT); ok = ok && (w[j] != 0u); }
                if (__all(ok)) { tot = ((__uint_as_float(w[0]) + __uint_as_float(w[1])) + (__uint_as_float(w[2]) + __uint_as_float(w[3]))) + ((__uint_as_float(w[4]) + __uint_as_float(w[5])) + (__uint_as_float(w[6]) + __uint_as_float(w[7]))); break; }
                __builtin_amdgcn_s_sleep(1); }
            const float rstd = 1.0f / sqrtf(tot * (1.f / D) + NORM_EPS); RS[t] = rstd;
            if (NX == 3 && u.pn == 0) RSTD[u.pm * 256 + t] = rstd; }
        LDS_WAIT(); __builtin_amdgcn_s_barrier(); asm volatile("" ::: "memory");
        if (NX == 3) return;
        asm volatile("" : "+v"(fr), "+v"(fq));
        const int rl0 = wr * 64 + fr, cb = u.pn * 256 + wc * 32 + 4 * fq;
        float rs[2][4];
#pragma unroll
        for (int ai = 0; ai < 2; ++ai)
#pragma unroll
            for (int m = 0; m < 4; ++m) rs[ai][m] = RS[ai * 128 + m * 16 + rl0];
#pragma unroll
        for (int bj = 0; bj < 2; ++bj)
#pragma unroll
            for (int n = 0; n < 2; ++n) { const int col = cb + bj * 128 + n * 16;
#pragma unroll
                for (int ai = 0; ai < 2; ++ai)
#pragma unroll
                    for (int m = 0; m < 4; ++m) { const int rl = ai * 128 + m * 16 + rl0; const f32x4 o_ = xn[ai][bj][m][n] * rs[ai][m] * a4[bj][n] + b4[bj][n];
                        if (NX == 4) *(f32x4*)((char*)outL + (unsigned)((u.pm * 256 + rl) * D + col) * 4u) = o_;
                        else { f32x2 w; w.x = __uint_as_float(pk2(o_.x, o_.y)); w.y = __uint_as_float(pk2(o_.z, o_.w));
                            if (NX == 1) *(f32x2*)((char*)HN + (unsigned)((u.pm * (D / 64) + (col >> 6)) * 16384 + rl * 64 + (col & 63)) * 2u) = w;
                            else *(f32x2*)((char*)HN + (unsigned)((u.pm * 256 + rl) * D + col) * 2u) = w; } }
                asm volatile("" ::: "memory"); }
    }
};

struct OpHBlk {
    const bf16* base; int pm0, kt0;
    __device__ __forceinline__ const char* tile(const pg8::Unit& u) const { return (const char*)base + ((size_t)(pm0 < 0 ? u.pm : pm0 + (u.pm & 1)) * HKT + (pm0 < 0 ? 0 : (u.pm >> 1) * kt0)) * 32768; }
    __device__ __forceinline__ unsigned voff(int R, int C) const { return (unsigned)(R * 64 + C) * 2u; }
    __device__ __forceinline__ size_t hstep() const { return 16384; }
    __device__ __forceinline__ size_t kstep() const { return 32768; }
};
struct OpBlk {
    const bf16* base; int nkt; bool isA;
    __device__ __forceinline__ const char* tile(const pg8::Unit& u) const { return (const char*)base + (size_t)(isA ? u.pm : u.pn) * nkt * 32768; }
    __device__ __forceinline__ unsigned voff(int R, int C) const { return (unsigned)(R * 64 + C) * 2u; }
    __device__ __forceinline__ size_t hstep() const { return 16384; }
    __device__ __forceinline__ size_t kstep() const { return 32768; }
};
struct OpBlkK {
    const bf16* base; int nkt;
    __device__ __forceinline__ const char* tile(const pg8::Unit& u) const { return (const char*)base + ((size_t)(u.pn & 7) * nkt + (size_t)(u.pn >> 3) * (nkt / 4)) * 32768; }
    __device__ __forceinline__ unsigned voff(int R, int C) const { return (unsigned)(R * 64 + C) * 2u; }
    __device__ __forceinline__ size_t hstep() const { return 16384; }
    __device__ __forceinline__ size_t kstep() const { return 32768; }
};
struct OrderCtxK { int G, c; __device__ __forceinline__ bool next(int i, pg8::Unit& u) const { const int L = i * G + c; if (L >= 64) return false; const int kq = L >> 4; u.pm = (L & 1) + 2 * kq; u.pn = ((L >> 1) & 7) + 8 * kq; return true; } };
struct OpKSplit {
    const bf16* base; int ld, klen; bool isA;
    __device__ __forceinline__ const char* tile(const pg8::Unit& u) const { const int t = isA ? (u.pm & 1) : (u.pn & 7), kq = isA ? (u.pm >> 1) : (u.pn >> 3); return (const char*)base + ((size_t)t * 256 * ld + (size_t)kq * klen) * 2; }
    __device__ __forceinline__ unsigned voff(int R, int C) const { return (unsigned)(R * ld + C) * 2u; }
    __device__ __forceinline__ size_t hstep() const { return (size_t)128 * ld * 2; }
    __device__ __forceinline__ size_t kstep() const { return 128; }
};
template <bool HAS_BIAS, bool HALF> struct EpiCtxAtomic {
    static constexpr bool PERM = false;
    ModRef MR; float* XC; const float* bias; int layer, gidx;
    __device__ __forceinline__ void operator()(const f32x4 (&acc)[2][2][4][2], const pg8::Unit& u, int wr, int wc, int fr, int fq) const {
        const int panel = u.pm & 1, ct = u.pn & 7, kq = u.pn >> 3;
        const int rbase = panel * 256 + wr * 64 + fr, col0 = ct * 256 + wc * 32 + 4 * fq;
#pragma unroll
        for (int bj = 0; bj < 2; ++bj)
#pragma unroll
            for (int n = 0; n < 2; ++n) {
                const f32x4 gv = modvF(MR, layer, 2, gidx * D + col0 + bj * 128 + n * 16) * (HALF ? 0.5f : 1.0f);
                f32x4 bv = {0.f, 0.f, 0.f, 0.f}; if (HAS_BIAS) { if (kq == 0) bv = *(const f32x4*)(bias + col0 + bj * 128 + n * 16); }
#pragma unroll
                for (int ai = 0; ai < 2; ++ai)
#pragma unroll
                    for (int m = 0; m < 4; ++m) { float* op = XC + (size_t)(rbase + ai * 128 + m * 16) * D + col0 + bj * 128 + n * 16; const f32x4 v = gv * (acc[ai][bj][m][n] + bv);
#pragma unroll
                        for (int e = 0; e < 4; ++e) (void)__hip_atomic_fetch_add(op + e, v[e], __ATOMIC_RELAXED, __HIP_MEMORY_SCOPE_AGENT); }
            }
    }
};

struct OpFixed {
    const bf16* base; int ld; int alt;
    __device__ __forceinline__ const char* tile(const pg8::Unit& u) const { return (const char*)base + (size_t)(alt ? (u.pm & 1) : 0) * 256 * ld * 2; }
    __device__ __forceinline__ unsigned voff(int R, int C) const { return (unsigned)(R * ld + C) * 2u; }
    __device__ __forceinline__ size_t hstep() const { return (size_t)128 * ld * 2; }
    __device__ __forceinline__ size_t kstep() const { return 128; }
};
struct OpChanL {
    const bf16* hn;
    __device__ __forceinline__ const char* tile(const pg8::Unit& u) const { return (const char*)hn + ((size_t)((u.pn >> 6) * SEQ + 2 * (u.pn & 63)) * D + (u.pm >> 1) * 256) * 2; }
    __device__ __forceinline__ unsigned voff(int R, int C) const { return (unsigned)(128 * R * D + C) * 2u; }
    __device__ __forceinline__ size_t hstep() const { return (size_t)D * 2; }
    __device__ __forceinline__ size_t kstep() const { return 128; }
};
struct OpChanC {
    const bf16* hn;
    __device__ __forceinline__ const char* tile(const pg8::Unit& u) const { return (const char*)hn + ((size_t)(ML + u.pn * CTXL) * D + (u.pm >> 1) * 256) * 2; }
    __device__ __forceinline__ unsigned voff(int R, int C) const { return (unsigned)(R * D + C) * 2u; }
    __device__ __forceinline__ size_t hstep() const { return (size_t)128 * D * 2; }
    __device__ __forceinline__ size_t kstep() const { return 128; }
};
struct OpStage2B {
    const bf16* T2;
    __device__ __forceinline__ const char* tile(const pg8::Unit& u) const { return (const char*)T2 + ((size_t)(u.pn >> 7) * 256 * 128 + (u.pn & 127)) * 512; }
    __device__ __forceinline__ unsigned voff(int R, int C) const { return (unsigned)R * 65536u + (unsigned)C * 2u; }
    __device__ __forceinline__ size_t hstep() const { return (size_t)128 * 65536; }
    __device__ __forceinline__ size_t kstep() const { return 128; }
};
__device__ __forceinline__ v4u pack8(const f32x4& a, const f32x4& b) { v4u w; w.x = pk2(a.x, a.y); w.y = pk2(a.z, a.w); w.z = pk2(b.x, b.y); w.w = pk2(b.z, b.w); return w; }
struct EpiChanL {
    static constexpr bool PERM = true; bf16* YT;
    __device__ __forceinline__ void operator()(const f32x4 (&acc)[2][2][4][2], const pg8::Unit& u, int wr, int wc, int fr, int fq) const {
        const int g = u.pm >> 1, cs = u.pm & 1, b = u.pn >> 6, n2p = u.pn & 63;
#pragma unroll
        for (int ai = 0; ai < 2; ++ai)
#pragma unroll
            for (int m = 0; m < 4; ++m) { const int kc = 128 * ai + 64 * wr + 16 * m + fr;
#pragma unroll
                for (int bj = 0; bj < 2; ++bj) { const unsigned idx = ((((unsigned)(b * 8 + g) * 256u + kc) * 128u + (2 * n2p + bj)) * 2u + cs) * 128u + 32 * wc + 8 * fq;
                    *(v4u*)((char*)YT + (size_t)(idx * 2u)) = pack8(acc[ai][bj][m][0], acc[ai][bj][m][1]); }
                asm volatile("" ::: "memory"); }
    }
};
struct EpiChanC {
    static constexpr bool PERM = true; bf16* YC;
    __device__ __forceinline__ void operator()(const f32x4 (&acc)[2][2][4][2], const pg8::Unit& u, int wr, int wc, int fr, int fq) const {
        const int g = u.pm >> 1, cs = u.pm & 1, b = u.pn;
#pragma unroll
        for (int ai = 0; ai < 2; ++ai)
#pragma unroll
            for (int m = 0; m < 4; ++m) { const int kc = 128 * ai + 64 * wr + 16 * m + fr;
#pragma unroll
                for (int bj = 0; bj < 2; ++bj) { const unsigned idx = (((unsigned)(b * 8 + g) * 256u + kc) * 2u + cs) * 256u + 128 * bj + 32 * wc + 8 * fq;
                    *(v4u*)((char*)YC + (size_t)(idx * 2u)) = pack8(acc[ai][bj][m][0], acc[ai][bj][m][1]); }
                asm volatile("" ::: "memory"); }
    }
};
struct EpiStage1 {
    static constexpr bool PERM = true; bf16* T2; const float* tw;
    __device__ __forceinline__ void operator()(const f32x4 (&acc)[2][2][4][2], const pg8::Unit& u, int wr, int wc, int fr, int fq) const {
#pragma unroll
        for (int m = 0; m < 4; ++m) { const int k1 = 64 * wr + 16 * m + fr, n20 = 32 * wc + 8 * fq;
#pragma unroll
            for (int n = 0; n < 2; ++n) {
                const f32x4 t0 = *(const f32x4*)((const char*)tw + (size_t)((unsigned)(k1 * 128 + n20 + 4 * n) * 8u));
                const f32x4 t1 = *(const f32x4*)((const char*)tw + (size_t)((unsigned)(k1 * 128 + n20 + 4 * n) * 8u + 16u));
#pragma unroll
                for (int bj = 0; bj < 2; ++bj) { const int chq = 2 * u.pn + bj;
                    const f32x4 tr = acc[0][bj][m][n], ti = acc[1][bj][m][n];
                    const f32x4 c = {t0.x, t0.z, t1.x, t1.z}, sn = {t0.y, t0.w, t1.y, t1.w};
                    const f32x4 ur = tr * c - ti * sn, ui = tr * sn + ti * c;
                    const unsigned idx = (((unsigned)chq * 128u + k1) * 2u) * 128u + n20 + 4 * n;
                    v2u w0; w0.x = pk2(ur.x, ur.y); w0.y = pk2(ur.z, ur.w); v2u w1; w1.x = pk2(ui.x, ui.y); w1.y = pk2(ui.z, ui.w);
                    *(v2u*)((char*)T2 + (size_t)(idx * 2u)) = w0; *(v2u*)((char*)T2 + (size_t)(idx * 2u + 256u)) = w1; }
                asm volatile("" ::: "memory"); } }
    }
};
struct EpiStage2 {
    static constexpr bool PERM = true; bf16* FO;
    __device__ __forceinline__ void operator()(const f32x4 (&acc)[2][2][4][2], const pg8::Unit& u, int wr, int wc, int fr, int fq) const {
        const int bg = u.pn >> 7, k1 = u.pn & 127, b = bg >> 3, g = bg & 7;
#pragma unroll
        for (int m = 0; m < 4; ++m) { const int k2 = 64 * wr + 16 * m + fr; const unsigned row = (unsigned)b * SEQ + k1 + 128 * k2;
#pragma unroll
            for (int bj = 0; bj < 2; ++bj) *(v4u*)((char*)FO + (size_t)((row * D + g * 256 + 128 * bj + 32 * wc + 8 * fq) * 2u)) = pack8(acc[0][bj][m][0], acc[0][bj][m][1]);
            asm volatile("" ::: "memory"); }
    }
};
struct EpiCtxDft {
    static constexpr bool PERM = true; bf16* FO;
    __device__ __forceinline__ void operator()(const f32x4 (&acc)[2][2][4][2], const pg8::Unit& u, int wr, int wc, int fr, int fq) const {
        const int b = u.pn >> 3, g = u.pn & 7;
#pragma unroll
        for (int ai = 0; ai < 2; ++ai)
#pragma unroll
            for (int m = 0; m < 4; ++m) { const int k = 128 * ai + 64 * wr + 16 * m + fr; const unsigned row = (unsigned)ML + b * CTXL + k;
#pragma unroll
                for (int bj = 0; bj < 2; ++bj) *(v4u*)((char*)FO + (size_t)((row * D + g * 256 + 128 * bj + 32 * wc + 8 * fq) * 2u)) = pack8(acc[ai][bj][m][0], acc[ai][bj][m][1]);
                asm volatile("" ::: "memory"); }
    }
};

struct OpXM {
    const bf16* base; int div, add;
    __device__ __forceinline__ const char* tile(const pg8::Unit& u) const { return (const char*)base + (size_t)(add + u.pn / div) * XM_STRIDE + (size_t)u.pm * 256 * D * 2; }
    __device__ __forceinline__ unsigned voff(int R, int C) const { return (unsigned)(R * D + C) * 2u; }
    __device__ __forceinline__ size_t hstep() const { return (size_t)128 * D * 2; }
    __device__ __forceinline__ size_t kstep() const { return 128; }
};
struct OpWSel {
    const bf16* base; int div; size_t stride;
    __device__ __forceinline__ const char* tile(const pg8::Unit& u) const { return (const char*)base + (size_t)(u.pn / div) * stride + (size_t)(u.pn % div) * 256 * D * 2; }
    __device__ __forceinline__ unsigned voff(int R, int C) const { return (unsigned)(R * D + C) * 2u; }
    __device__ __forceinline__ size_t hstep() const { return (size_t)128 * D * 2; }
    __device__ __forceinline__ size_t kstep() const { return 128; }
};
struct EpiLora {
    static constexpr bool PERM = true; bf16* LR;
    __device__ __forceinline__ void operator()(const f32x4 (&acc)[2][2][4][2], const pg8::Unit& u, int wr, int wc, int fr, int fq) const {
        const int which = u.pn; bf16* O = (bf16*)((char*)LR + (size_t)which * LR_STRIDE);
#pragma unroll
        for (int ai = 0; ai < 2; ++ai)
#pragma unroll
            for (int m = 0; m < 4; ++m) { const unsigned row = u.pm * 256 + 128 * ai + 64 * wr + 16 * m + fr;
#pragma unroll
                for (int bj = 0; bj < 2; ++bj) { f32x4 a = acc[ai][bj][m][0], b = acc[ai][bj][m][1];
                    if (which == 0) {
#pragma unroll
                        for (int e = 0; e < 4; ++e) { a[e] = 1.f - 2.f * __builtin_amdgcn_rcpf(1.f + __expf(2.f * a[e])); b[e] = 1.f - 2.f * __builtin_amdgcn_rcpf(1.f + __expf(2.f * b[e])); } }
                    else if (which == 2) {
#pragma unroll
                        for (int e = 0; e < 4; ++e) { a[e] = sigmoidf_(a[e]); b[e] = sigmoidf_(b[e]); } }
                    *(v4u*)((char*)O + (size_t)((row * 256u + 128 * bj + 32 * wc + 8 * fq) * 2u)) = pack8(a, b); }
                asm volatile("" ::: "memory"); }
    }
};
struct EpiRkv {
    static constexpr bool PERM = true; bf16* XM;
    __device__ __forceinline__ void operator()(const f32x4 (&acc)[2][2][4][2], const pg8::Unit& u, int wr, int wc, int fr, int fq) const {
        char* O = (char*)XM + (size_t)(3 + u.pn / 8) * XM_STRIDE; const int colt = (u.pn % 8) * 256;
#pragma unroll
        for (int ai = 0; ai < 2; ++ai)
#pragma unroll
            for (int m = 0; m < 4; ++m) { const unsigned row = u.pm * 256 + 128 * ai + 64 * wr + 16 * m + fr;
#pragma unroll
                for (int bj = 0; bj < 2; ++bj) *(v4u*)(O + (size_t)((row * D + colt + 128 * bj + 32 * wc + 8 * fq) * 2u)) = pack8(acc[ai][bj][m][0], acc[ai][bj][m][1]);
                asm volatile("" ::: "memory"); }
    }
};
struct EpiRkvC {
    static constexpr bool PERM = true; bf16* O;
    __device__ __forceinline__ void operator()(const f32x4 (&acc)[2][2][4][2], const pg8::Unit& u, int wr, int wc, int fr, int fq) const {
        char* Op = (char*)O + (size_t)(u.pn / 8) * MC * D * 2; const int colt = (u.pn % 8) * 256;
#pragma unroll
        for (int ai = 0; ai < 2; ++ai)
#pragma unroll
            for (int m = 0; m < 4; ++m) { const unsigned row = (u.pm - 128) * 256 + 128 * ai + 64 * wr + 16 * m + fr;
#pragma unroll
                for (int bj = 0; bj < 2; ++bj) *(v4u*)(Op + (size_t)((row * D + colt + 128 * bj + 32 * wc + 8 * fq) * 2u)) = pack8(acc[ai][bj][m][0], acc[ai][bj][m][1]);
                asm volatile("" ::: "memory"); }
    }
};
template <bool DRY = false> struct EpiMulG {
    static constexpr bool PERM = true; bf16* PO;
    __device__ __forceinline__ void operator()(const f32x4 (&acc)[2][2][4][2], const pg8::Unit& u, int wr, int wc, int fr, int fq) const {
#pragma unroll
        for (int ai = 0; ai < 2; ++ai)
#pragma unroll
            for (int m = 0; m < 4; ++m) { const unsigned row = u.pm * 256 + 128 * ai + 64 * wr + 16 * m + fr;
#pragma unroll
                for (int bj = 0; bj < 2; ++bj) { v4u* ptr = (v4u*)((char*)PO + (size_t)((row * D + u.pn * 256 + 128 * bj + 32 * wc + 8 * fq) * 2u));
                    const v4u o = *ptr; const f32x4 a = acc[ai][bj][m][0], b = acc[ai][bj][m][1];
                    v4u w; w.x = pk2(bflo(o.x) * a.x, bfhi(o.x) * a.y); w.y = pk2(bflo(o.y) * a.z, bfhi(o.y) * a.w); w.z = pk2(bflo(o.z) * b.x, bfhi(o.z) * b.y); w.w = pk2(bflo(o.w) * b.z, bfhi(o.w) * b.w);
                    if (!DRY || w.x == 0x12345678u) *ptr = w; }
                asm volatile("" ::: "memory"); }
    }
};

__device__ __forceinline__ void phase_rowstats(Frame& F, const float* xl, const float* xc, float* RSTD, int r0) {
    int tid_ = threadIdx.x; asm volatile("" : "+v"(tid_)); const int LANE = tid_ & 63, WAVE = __builtin_amdgcn_readfirstlane(tid_ >> 6);
    const int gw = F.vcu * NWAVES + WAVE, NGW = F.G * NWAVES;
    for (int r = r0 + gw; r < MT; r += NGW) {
        const float* xr = r < ML ? xl + (size_t)r * D : xc + (size_t)(r - ML) * D; float ss = 0.f;
#pragma unroll
        for (int j = 0; j < 8; ++j) { const f32x4 v = *(const f32x4*)(xr + 256 * j + 4 * LANE); ss += (v.x * v.x + v.y * v.y) + (v.z * v.z + v.w * v.w); }
        const float rstd = 1.0f / sqrtf(wave_sum(ss) * (1.f / D) + NORM_EPS);
        if (LANE == 0) RSTD[r] = rstd;
    }
}
__device__ __forceinline__ void phase_mix(Frame& F, const ModRef& MR, const float* xl, const float* xc, const float* RSTD, const float* nw, const float* mu, bf16* XM) {
    int tid_ = threadIdx.x; asm volatile("" : "+v"(tid_)); const int TID = tid_, LANE = tid_ & 63, WAVE = __builtin_amdgcn_readfirstlane(tid_ >> 6);
    LAS float* TA = (LAS float*)(F.lds); LAS float* TB = (LAS float*)(F.lds + 24576); LAS float* TM = (LAS float*)(F.lds + 49152);
    for (int i = TID; i < 3 * D / 4; i += NWAVES * 64) { const int who = i / (D / 4), d = (i % (D / 4)) * 4;
        const f32x4 sh = modvF(MR, 1, who, 3 * D + d), sc = modvF(MR, 1, who, 4 * D + d), g = *(const f32x4*)(nw + d);
        *(LAS f32x4*)(TA + who * D + d) = g * (sc + 1.f); *(LAS f32x4*)(TB + who * D + d) = sh; }
    for (int i = TID; i < 6 * D / 4; i += NWAVES * 64) *(LAS f32x4*)(TM + 4 * i) = *(const f32x4*)(mu + 4 * i);
    __syncthreads();
    const int gw = F.vcu * NWAVES + WAVE, NGW = F.G * NWAVES;
    for (int r = gw; r < MT; r += NGW) {
        const int who = who_of_row(r);
        const bool isl = r < ML; const int t = isl ? (r & (SEQ - 1)) : ((r - ML) & (CTXL - 1));
        const float* xr = isl ? xl + (size_t)r * D : xc + (size_t)(r - ML) * D;
        const float rs = RSTD[r];
#pragma unroll
        for (int j = 0; j < 4; ++j) {
            int dt; bool ok;
            if (isl) { const int gx = t & 63, gy = t >> 6; if (j == 0) { dt = -1; ok = gx > 0; } else if (j == 1) { dt = 1; ok = gx < 63; } else if (j == 2) { dt = -64; ok = gy > 0; } else { dt = 64; ok = gy < SEQ / 64 - 1; } }
            else { if ((j & 1) == 0) { dt = -1; ok = t > 0; } else { dt = 1; ok = t < CTXL - 1; } }
            const int d = 512 * j + 8 * LANE;
            const f32x4 a0 = *(const LAS f32x4*)(TA + who * D + d), a1 = *(const LAS f32x4*)(TA + who * D + d + 4), b0 = *(const LAS f32x4*)(TB + who * D + d), b1 = *(const LAS f32x4*)(TB + who * D + d + 4);
            const f32x4 x0 = *(const f32x4*)(xr + d), x1 = *(const f32x4*)(xr + d + 4);
            const f32x4 h0 = x0 * rs * a0 + b0, h1 = x1 * rs * a1 + b1;
            f32x4 s0 = {0.f, 0.f, 0.f, 0.f}, s1 = s0;
            if (ok) { const float rn = RSTD[r + dt]; const float* xn = xr + (ptrdiff_t)dt * D; const f32x4 y0 = *(const f32x4*)(xn + d), y1 = *(const f32x4*)(xn + d + 4); s0 = y0 * rn * a0 + b0; s1 = y1 * rn * a1 + b1; }
            const f32x4 d0 = s0 - h0, d1 = s1 - h1;
#pragma unroll
            for (int p = 0; p < 6; ++p) { const f32x4 m0 = *(const LAS f32x4*)(TM + p * D + d), m1 = *(const LAS f32x4*)(TM + p * D + d + 4);
                *(v4u*)((char*)XM + (size_t)p * XM_STRIDE + ((size_t)r * D + d) * 2) = pack8(h0 + d0 * m0, h1 + d1 * m1); }
        }
    }
}

constexpr int SCAN_BLK = 12544, SC_WQ = 80, SCAN_NW = 14;
constexpr int SC_NSLOT = 4, SC_SLOT = SCAN_BLK;
constexpr int SC_NPROD_A = 5, SC_NPROD_B = 8, SC_QA = 24, SC_QA0 = 6;
constexpr int SC_WF = 0, SC_CONST = 24576, SC_CTL = SC_CONST + 1280, SC_RING = SC_CTL + 128, SC_PROD_A = SC_RING + SC_NSLOT * SC_SLOT, SC_PROD_B = SC_RING, SC_PSTRIDE = 14592;
constexpr int BLK_AR = 0, BLK_G = 4096, BLK_BK = 6144, BLK_VF = 10240, BLK_PCF = 12288;
static_assert(SC_PROD_A + SC_NPROD_A * SC_PSTRIDE <= LDSCTL_OFF && SC_PROD_B + SC_NPROD_B * SC_PSTRIDE <= LDSCTL_OFF && 4608 + 3072 <= 8192 && 8192 + 6400 <= SC_PSTRIDE, "scan LDS map");
__device__ __forceinline__ int scan_row(int b, int z, int s) { if (s < CTXL) return ML + b * CTXL + (z ? CTXL - 1 - s : s); const int sp = s - CTXL; return b * SEQ + (z ? SEQ - 1 - sp : sp); }
__device__ __forceinline__ int sc_chain(int b) { return ((b & 7) | ((b >> 4) << 3)) & 127; }
__device__ __forceinline__ int sc_half(int b) { return (b >> 3) & 1; }
__device__ __forceinline__ int win_lo(int w) { return w == 0 ? 0 : 16 + SC_WQ * (w - 1); }
__device__ __forceinline__ int win_n(int w) { return w == 0 ? 16 : (w == SCAN_NW - 1 ? 1024 - SC_WQ * (SCAN_NW - 2) : SC_WQ); }
template <int N> __device__ __forceinline__ float dpp_row_shr(float v) { return __int_as_float(__builtin_amdgcn_update_dpp(0, __float_as_int(v), 0x110 + N, 0xf, 0xf, true)); }
__device__ __forceinline__ bf16x8 pack_frag(float a0, float a1, float a2, float a3, float a4, float a5, float a6, float a7) { v4u w; w.x = pk2(a0, a1); w.y = pk2(a2, a3); w.z = pk2(a4, a5); w.w = pk2(a6, a7); return __builtin_bit_cast(bf16x8, w); }
#define MFMA32(a, b, c) __builtin_amdgcn_mfma_f32_32x32x16_bf16((a), (b), (c), 0, 0, 0)
#define MFMA16(a, b, c) __builtin_amdgcn_mfma_f32_16x16x32_bf16((a), (b), (c), 0, 0, 0)

__device__ __forceinline__ void scan_setup(const Frame& F, const Args& AR, int tid) {
    const int chain = sc_chain(blockIdx.x), h = (chain >> 1) & 31, z = chain & 1;
    const bf16* W2UP = (const bf16*)(F.ws + WS_WSMALL + WSM_W2UP); const bf16* A2UP = (const bf16*)(F.ws + WS_WSMALL + WSM_A2UP);
    for (int i = tid; i < 2 * 12 * 64; i += NWAVES * 64) { const int which = i / 768, f = (i / 64) % 12, ln = i & 63, ks = f >> 2, mt = f & 3, tau = ln & 15, g = ln >> 4;
        *(LAS v4u*)(F.lds + SC_WF + i * 16) = *(const v4u*)((which ? A2UP : W2UP) + ((size_t)(z * D + h * 64 + 16 * mt + tau)) * LORA + 32 * ks + 8 * g); }
    for (int i = tid; i < 5 * 64; i += NWAVES * 64) { const int k = i / 64, c = h * 64 + (i & 63);
        ((LAS float*)(F.lds + SC_CONST))[i] = k == 0 ? AR.in[13][z * D + c] : k == 1 ? AR.in[16][z * D + c] : k == 2 ? AR.in[21][c] : k == 3 ? AR.in[22][c] : AR.in[23][c]; }
}
__device__ __forceinline__ void scan_produce(const Frame& F, int w, int pw, int lane_in, bool isA) {
    int lane = lane_in;
    LAS unsigned char* scr = F.lds + (isA ? SC_PROD_A : SC_PROD_B) + pw * SC_PSTRIDE;
    const int nq = win_n(w), lo = win_lo(w), qa = (nq == 16) ? SC_QA0 : (nq * 3) / 8;
    const int nhalf = isA ? qa : nq - qa;
    const bf16* RKV = (const bf16*)(F.ws + WS_ACT + ACT_XM + 3 * XM_STRIDE);
    const bf16* TWb = (const bf16*)(F.ws + WS_ACT + ACT_LR); const bf16* TAb = (const bf16*)(F.ws + WS_ACT + ACT_LR + LR_STRIDE);
    unsigned char* wbuf = F.ws + WS_ACT + ACT_WBUF + (size_t)(w & 1) * WBUF_STRIDE;
    float* SA = (float*)(F.ws + WS_SA);
    const int chain = sc_chain(blockIdx.x), b = chain >> 6, h = (chain >> 1) & 31, z = chain & 1, q0 = isA ? 0 : qa;
    if (blockIdx.x >= 256) return;
    v2u r2n[4], k2n[4], v2n[4]; bf16x8 bwn[3], ban[3];
    const bf16* RK0 = w == 0 ? (const bf16*)(F.ws + WS_RKVC) - (size_t)ML * D : RKV; const size_t RKS = w == 0 ? (size_t)MC * D : (size_t)MT * D;
#define SC_LOADS(qq) do { const int row_ = scan_row(b, z, (lo + (qq)) * 16 + (lane & 15)); \
        const unsigned ob_ = ((unsigned)row_ * D + h * 64 + 4 * (lane >> 4)) * 2u, ol_ = ((unsigned)row_ * 256 + z * 96 + 8 * (lane >> 4)) * 2u; \
        _Pragma("unroll") for (int mt = 0; mt < 4; ++mt) { \
            r2n[mt] = *(const v2u*)((const char*)RK0 + (size_t)(ob_ + 32u * mt)); k2n[mt] = *(const v2u*)((const char*)(RK0 + RKS) + (size_t)(ob_ + 32u * mt)); v2n[mt] = *(const v2u*)((const char*)(RK0 + 2 * RKS) + (size_t)(ob_ + 32u * mt)); } \
        _Pragma("unroll") for (int ks = 0; ks < 3; ++ks) { bwn[ks] = *(const bf16x8*)((const char*)TWb + (size_t)(ol_ + 64u * ks)); ban[ks] = *(const bf16x8*)((const char*)TAb + (size_t)(ol_ + 64u * ks)); } } while (0)
    volatile LAS unsigned* tctr = (volatile LAS unsigned*)(F.lds + SC_CTL + 8);
#define SC_GRAB() ({ unsigned v_ = 0; if (lane == 0) v_ = __hip_atomic_fetch_add((LAS unsigned*)(F.lds + SC_CTL + 8), 1u, __ATOMIC_RELAXED, __HIP_MEMORY_SCOPE_WORKGROUP); (int)__builtin_amdgcn_readfirstlane(v_); })
    int qi = pw, qn = SC_GRAB();
    (void)tctr;
    if (qi < nhalf) SC_LOADS(q0 + qi);
#pragma unroll 1
    for (; qi < nhalf; qi = qn, qn = SC_GRAB()) {
        asm volatile("" : "+v"(lane));
        const int tau = lane & 15, g = lane >> 4;
        const int q = q0 + qi;
        const int row = scan_row(b, z, (lo + q) * 16 + tau);
        unsigned char* blk = wbuf + ((size_t)chain * SC_WQ + q) * SCAN_BLK;
        v2u r2[4], k2[4], v2[4]; bf16x8 bw[3], ba[3];
#pragma unroll
        for (int mt = 0; mt < 4; ++mt) { r2[mt] = r2n[mt]; k2[mt] = k2n[mt]; v2[mt] = v2n[mt]; }
#pragma unroll
        for (int ks = 0; ks < 3; ++ks) { bw[ks] = bwn[ks]; ba[ks] = ban[ks]; }
        if (qn < nhalf) SC_LOADS(q0 + qn);
        f32x4 lw[4], la[4];
#pragma unroll
        for (int mt = 0; mt < 4; ++mt) { lw[mt] = (f32x4){0.f, 0.f, 0.f, 0.f}; la[mt] = lw[mt]; }
        {
            bf16x8 wf[12];
#pragma unroll
            for (int f_ = 0; f_ < 12; ++f_) wf[f_] = *(const LAS bf16x8*)(F.lds + SC_WF + (f_ * 64 + lane) * 16);
            asm volatile("" : "+v"(wf[0]), "+v"(wf[1]), "+v"(wf[2]), "+v"(wf[3]), "+v"(wf[4]), "+v"(wf[5]), "+v"(wf[6]), "+v"(wf[7]), "+v"(wf[8]), "+v"(wf[9]), "+v"(wf[10]), "+v"(wf[11]));
            bf16x8 af[12];
#pragma unroll
            for (int f_ = 0; f_ < 12; ++f_) af[f_] = *(const LAS bf16x8*)(F.lds + SC_WF + ((12 + f_) * 64 + lane) * 16);
#pragma unroll
            for (int ks = 0; ks < 3; ++ks)
#pragma unroll
                for (int mt = 0; mt < 4; ++mt) lw[mt] = MFMA16(wf[ks * 4 + mt], bw[ks], lw[mt]);
            asm volatile("" : "+v"(af[0]), "+v"(af[1]), "+v"(af[2]), "+v"(af[3]), "+v"(af[4]), "+v"(af[5]), "+v"(af[6]), "+v"(af[7]), "+v"(af[8]), "+v"(af[9]), "+v"(af[10]), "+v"(af[11]));
#pragma unroll
            for (int ks = 0; ks < 3; ++ks)
#pragma unroll
                for (int mt = 0; mt < 4; ++mt) la[mt] = MFMA16(af[ks * 4 + mt], ba[ks], la[mt]);
        }
        LAS unsigned char* Xs = scr; LAS unsigned char* Ys = scr + 4096;
        LAS bf16* BKs = (LAS bf16*)(scr + 8192); LAS bf16* VFs = (LAS bf16*)(scr + 8192 + 4096); LAS float* PCs = (LAS float*)(scr + 8192 + 6144);
        float lnw[16], asg[16], kk[16], kd[16]; float ss = 0.f, sap = 0.f;
        f32x4 cw0[4], ca0[4], ckk[4], cka[4], crk[4];
#pragma unroll
        for (int mt = 0; mt < 4; ++mt) { const LAS float* cst = (const LAS float*)(F.lds + SC_CONST) + 16 * mt + 4 * g;
            cw0[mt] = *(const LAS f32x4*)(cst); ca0[mt] = *(const LAS f32x4*)(cst + 64); ckk[mt] = *(const LAS f32x4*)(cst + 128); cka[mt] = *(const LAS f32x4*)(cst + 192); crk[mt] = *(const LAS f32x4*)(cst + 256); }
        asm volatile("" : "+v"(cw0[0]), "+v"(cw0[1]), "+v"(cw0[2]), "+v"(cw0[3]), "+v"(ca0[0]), "+v"(ca0[1]), "+v"(ca0[2]), "+v"(ca0[3]), "+v"(ckk[0]), "+v"(ckk[1]), "+v"(ckk[2]), "+v"(ckk[3]), "+v"(cka[0]), "+v"(cka[1]), "+v"(cka[2]), "+v"(cka[3]), "+v"(crk[0]), "+v"(crk[1]), "+v"(crk[2]), "+v"(crk[3]));
#pragma unroll
        for (int mt = 0; mt < 4; ++mt) {
            const f32x4 w0 = cw0[mt], a0 = ca0[mt], kkc = ckk[mt], kac = cka[mt], rkc = crk[mt];
            const float rv[4] = {bflo(r2[mt].x), bfhi(r2[mt].x), bflo(r2[mt].y), bfhi(r2[mt].y)}, kv[4] = {bflo(k2[mt].x), bfhi(k2[mt].x), bflo(k2[mt].y), bfhi(k2[mt].y)};
#pragma unroll
            for (int e = 0; e < 4; ++e) { const int i = 4 * mt + e;
                lnw[i] = -0.6065306597126334f * sigmoidf_(w0[e] + lw[mt][e]);
                asg[i] = sigmoidf_(a0[e] + la[mt][e]);
                const float kr = kv[e] * kkc[e]; kk[i] = kr; ss += kr * kr;
                kd[i] = kv[e] * (1.f + (asg[i] - 1.f) * kac[e]);
                sap += rv[e] * rkc[e] * kd[i]; } }
        ss += __shfl_xor(ss, 16); ss += __shfl_xor(ss, 32); sap += __shfl_xor(sap, 16); sap += __shfl_xor(sap, 32);
        const float inv = __builtin_amdgcn_rsqf(fmaxf(ss, 1e-24f));
        if (g == 0) SA[((size_t)z * MT + row) * 32 + h] = sap;
        float ec_[16], eC_[16];
#pragma unroll
        for (int i = 0; i < 16; ++i) { float c = lnw[i]; c += dpp_row_shr<1>(c); c += dpp_row_shr<2>(c); c += dpp_row_shr<4>(c); c += dpp_row_shr<8>(c); ec_[i] = __expf(c); }
#pragma unroll
        for (int i = 0; i < 16; ++i) eC_[i] = __shfl(ec_[i], (lane & 48) | 15);
        { const int hh0 = (tau >> 2) & 1, jj0 = 4 * (tau >> 3) + (tau & 3), hh1 = tau >> 3, jj1 = tau & 7;
          LAS bf16* bkb0 = BKs + (4 * g + 32 * hh0) * 8 + jj0; LAS bf16* bkb1 = BKs + 512 + (4 * g + 32 * hh1) * 8 + jj1; LAS bf16* vfb = VFs + (4 * g + 32 * hh1) * 8 + jj1;
#pragma unroll
          for (int mt = 0; mt < 4; ++mt) {
            float at[4], rt[4], bt[4], kt[4];
            const float rv[4] = {bflo(r2[mt].x), bfhi(r2[mt].x), bflo(r2[mt].y), bfhi(r2[mt].y)};
            const unsigned short vraw[4] = {(unsigned short)(v2[mt].x & 0xffffu), (unsigned short)(v2[mt].x >> 16), (unsigned short)(v2[mt].y & 0xffffu), (unsigned short)(v2[mt].y >> 16)};
#pragma unroll
            for (int e = 0; e < 4; ++e) { const int i = 4 * mt + e;
                const float ec = ec_[i], en = __builtin_amdgcn_rcpf(ec);
                const float eprev = __int_as_float(__builtin_amdgcn_update_dpp(0x3f800000, __float_as_int(ec), 0x111, 0xf, 0xf, false));
                const float er = eC_[i] * en;
                const float kki = kk[i] * inv, bb = kki * asg[i];
                at[e] = -kki * eprev; rt[e] = rv[e] * ec; bt[e] = bb * en; kt[e] = kd[i] * en;
                const int eo = ((mt >> 1) * 2) * 512 + (16 * (mt & 1) + e) * 8;
                const unsigned wbk = pk2(bb * er, kd[i] * er);
                bkb0[eo] = (bf16)(wbk & 0xffffu); bkb1[eo] = (bf16)(wbk >> 16);
                vfb[(mt >> 1) * 512 + (16 * (mt & 1) + e) * 8] = vraw[e]; }
            const int jb = (4 * (g >> 1)) * 2, cb = (((2 * mt + (g >> 1)) ^ (tau & 7)) << 4) + 8 * (g & 1);
            v2u wa; wa.x = pk2(at[0], at[1]); wa.y = pk2(at[2], at[3]);
            v2u wq; wq.x = pk2(rt[0], rt[1]); wq.y = pk2(rt[2], rt[3]);
            v2u wb; wb.x = pk2(bt[0], bt[1]); wb.y = pk2(bt[2], bt[3]);
            v2u wk; wk.x = pk2(kt[0], kt[1]); wk.y = pk2(kt[2], kt[3]);
            *(v2u*)(blk + BLK_AR + (mt * 64 + tau + 32 * (g & 1)) * 16 + jb) = wa;
            *(v2u*)(blk + BLK_AR + (mt * 64 + 16 + tau + 32 * (g & 1)) * 16 + jb) = wq;
            *(LAS v2u*)(Xs + tau * 128 + cb) = wa; *(LAS v2u*)(Xs + (16 + tau) * 128 + cb) = wq;
            *(LAS v2u*)(Ys + tau * 128 + cb) = wb; *(LAS v2u*)(Ys + (16 + tau) * 128 + cb) = wk;
          }
          if (tau == 0) {
#pragma unroll
              for (int i = 0; i < 16; ++i) { const int j = 16 * (i >> 2) + 4 * g + (i & 3), mtp = j >> 5, jl = j & 31, hq = (jl >> 2) & 1, qq = (jl & 3) + 4 * (jl >> 3); PCs[(hq * 2 + mtp) * 16 + qq] = eC_[i]; } }
        }
        LDS_WAIT();
        f32x16 dm;
#pragma unroll
        for (int i = 0; i < 16; ++i) dm[i] = 0.f;
        { const int r31 = lane & 31, hh = lane >> 5;
#pragma unroll
          for (int ks = 0; ks < 4; ++ks) { const int co = ((2 * ks + hh) ^ (r31 & 7)) << 4; const bf16x8 xa = *(const LAS bf16x8*)(Xs + r31 * 128 + co), yb = *(const LAS bf16x8*)(Ys + r31 * 128 + co); dm = MFMA32(xa, yb, dm); }
          LDS_WAIT();
          LAS float* Dm = (LAS float*)scr;
#pragma unroll
          for (int q_ = 0; q_ < 16; ++q_) Dm[((q_ & 3) + 8 * (q_ >> 2) + 4 * hh) * 36 + r31] = dm[q_];
        }
        LDS_WAIT();
        float xs[16], os[16];
        { const LAS float* Dm = (const LAS float*)scr; const int c = lane & 31, cc = (c - 16) & 15; const bool lo16 = c < 16;
          float ak[16], rk[16];
#pragma unroll
          for (int t = 0; t < 16; ++t) { ak[t] = Dm[t * 36 + 16 + cc]; rk[t] = Dm[(16 + t) * 36 + 16 + cc]; }
          asm volatile("" : "+v"(ak[0]), "+v"(ak[1]), "+v"(ak[2]), "+v"(ak[3]), "+v"(ak[4]), "+v"(ak[5]), "+v"(ak[6]), "+v"(ak[7]), "+v"(ak[8]), "+v"(ak[9]), "+v"(ak[10]), "+v"(ak[11]), "+v"(ak[12]), "+v"(ak[13]), "+v"(ak[14]), "+v"(ak[15]));
          asm volatile("" : "+v"(rk[0]), "+v"(rk[1]), "+v"(rk[2]), "+v"(rk[3]), "+v"(rk[4]), "+v"(rk[5]), "+v"(rk[6]), "+v"(rk[7]), "+v"(rk[8]), "+v"(rk[9]), "+v"(rk[10]), "+v"(rk[11]), "+v"(rk[12]), "+v"(rk[13]), "+v"(rk[14]), "+v"(rk[15]) :: "memory");
#pragma unroll
          for (int t = 0; t < 16; ++t) { const float one = (t == c) ? 1.f : 0.f, akm = (cc < t) ? ak[t] : 0.f, rkm = (cc <= t) ? rk[t] : 0.f; xs[t] = lo16 ? one : akm; os[t] = lo16 ? 0.f : rkm; }
#pragma unroll
          for (int tb = 0; tb < 4; ++tb) {
              f32x4 ar[4][4];
#pragma unroll
              for (int r = 0; r < 4; ++r)
#pragma unroll
                  for (int u4 = 0; u4 <= tb; ++u4) ar[r][u4] = *(const LAS f32x4*)(Dm + (4 * tb + r) * 36 + 4 * u4);
#pragma unroll
              for (int r = 0; r < 4; ++r) { if (tb == 0) asm volatile("" : "+v"(ar[r][0]) :: "memory"); else if (tb == 1) asm volatile("" : "+v"(ar[r][0]), "+v"(ar[r][1]) :: "memory"); else if (tb == 2) asm volatile("" : "+v"(ar[r][0]), "+v"(ar[r][1]), "+v"(ar[r][2]) :: "memory"); else asm volatile("" : "+v"(ar[r][0]), "+v"(ar[r][1]), "+v"(ar[r][2]), "+v"(ar[r][3]) :: "memory"); }
#pragma unroll
              for (int r = 0; r < 4; ++r) { const int t = 4 * tb + r;
#pragma unroll
                  for (int tau_ = 0; tau_ < t; ++tau_) xs[t] += ar[r][tau_ >> 2][tau_ & 3] * xs[tau_]; }
              asm volatile("" : "+v"(xs[4 * tb]), "+v"(xs[4 * tb + 1]), "+v"(xs[4 * tb + 2]), "+v"(xs[4 * tb + 3]) :: "memory");
          }
#pragma unroll
          for (int tb = 0; tb < 4; ++tb) {
              f32x4 ar[4][4];
#pragma unroll
              for (int r = 0; r < 4; ++r)
#pragma unroll
                  for (int u4 = 0; u4 <= tb; ++u4) ar[r][u4] = *(const LAS f32x4*)(Dm + (16 + 4 * tb + r) * 36 + 4 * u4);
#pragma unroll
              for (int r = 0; r < 4; ++r) { if (tb == 0) asm volatile("" : "+v"(ar[r][0]) :: "memory"); else if (tb == 1) asm volatile("" : "+v"(ar[r][0]), "+v"(ar[r][1]) :: "memory"); else if (tb == 2) asm volatile("" : "+v"(ar[r][0]), "+v"(ar[r][1]), "+v"(ar[r][2]) :: "memory"); else asm volatile("" : "+v"(ar[r][0]), "+v"(ar[r][1]), "+v"(ar[r][2]), "+v"(ar[r][3]) :: "memory"); }
#pragma unroll
              for (int r = 0; r < 4; ++r) { const int t = 4 * tb + r;
#pragma unroll
                  for (int tau_ = 0; tau_ <= t; ++tau_) os[t] += ar[r][tau_ >> 2][tau_ & 3] * xs[tau_]; }
              asm volatile("" : "+v"(os[4 * tb]), "+v"(os[4 * tb + 1]), "+v"(os[4 * tb + 2]), "+v"(os[4 * tb + 3]) :: "memory");
          }
        }
        LDS_WAIT();
        { LAS bf16* Gs = (LAS bf16*)(scr + 4608);
          if (lane < 32) { const int c = lane;
              int ks, hh, jj; if (c < 16) { ks = 0; hh = (c >> 2) & 1; jj = 4 * (c >> 3) + (c & 3); } else { ks = 2; hh = (c - 16) >> 3; jj = (c - 16) & 7; }
#pragma unroll
              for (int t = 0; t < 16; ++t) { Gs[(ks * 64 + t + 32 * hh) * 8 + jj] = (bf16)(pk2(xs[t], 0.f) & 0xffffu); Gs[(ks * 64 + 16 + t + 32 * hh) * 8 + jj] = (bf16)(pk2(os[t], 0.f) & 0xffffu); } }
        }
        LDS_WAIT();
        { v4u cg[2], cbk[7];
          cg[0] = *(const LAS v4u*)(scr + 4608 + lane * 16); cg[1] = *(const LAS v4u*)(scr + 4608 + (2 * 64 + lane) * 16);
#pragma unroll
          for (int i = 0; i < 6; ++i) cbk[i] = *(const LAS v4u*)(scr + 8192 + (i * 64 + lane) * 16);
          cbk[6] = *(const LAS v4u*)(scr + 8192 + (6 * 64 + (lane & 15)) * 16);
          asm volatile("" : "+v"(cg[0]), "+v"(cg[1]), "+v"(cbk[0]), "+v"(cbk[1]), "+v"(cbk[2]), "+v"(cbk[3]), "+v"(cbk[4]), "+v"(cbk[5]), "+v"(cbk[6]));
#pragma unroll
          for (int i = 0; i < 2; ++i) *(v4u*)(blk + BLK_G + (i * 64 + lane) * 16) = cg[i];
#pragma unroll
          for (int i = 0; i < 6; ++i) *(v4u*)(blk + BLK_BK + (i * 64 + lane) * 16) = cbk[i];
          if (lane < 16) *(v4u*)(blk + BLK_BK + (6 * 64 + lane) * 16) = cbk[6]; }
    }
#undef SC_LOADS
#undef SC_GRAB
}

__device__ __forceinline__ void scan_consume(const Frame& F, int w  , int lane, int ih) {
    const int nq = win_n(w), lo = win_lo(w);
    const unsigned char* wbuf = F.ws + WS_ACT + ACT_WBUF + (size_t)(w & 1) * WBUF_STRIDE;
    float* SST = (float*)(F.ws + WS_SST);
    const int r31 = lane & 31, hh = lane >> 5;
    for (int p = blockIdx.x; p < 256; p += 256) {
        const int chain = sc_chain(p), b = chain >> 6, h = (chain >> 1) & 31, z = chain & 1; const int sp_ = chain * 2 + ih;
        bf16* YB = (bf16*)(F.ws + WS_ACT + (z ? ACT_YB1 : ACT_YB0));
        f32x16 st0, st1;
        if (w == 0) {
#pragma unroll
            for (int i = 0; i < 16; ++i) { st0[i] = 0.f; st1[i] = 0.f; } }
        else {
#pragma unroll
            for (int i = 0; i < 16; ++i) { st0[i] = SST[((size_t)sp_ * 32 + i) * 64 + lane]; st1[i] = SST[((size_t)sp_ * 32 + 16 + i) * 64 + lane]; } }
        volatile LAS unsigned* ctl = (volatile LAS unsigned*)(F.lds + SC_CTL);
        bf16x8 gmid;
        { unsigned e8[8];
#pragma unroll
          for (int jj = 0; jj < 8; ++jj) { const int pi = 8 * (jj >> 2) + 4 * hh + (jj & 3); e8[jj] = (r31 >= 16 && r31 - 16 == pi) ? 0x3f80u : 0u; }
          v4u m_; m_.x = e8[0] | (e8[1] << 16); m_.y = e8[2] | (e8[3] << 16); m_.z = e8[4] | (e8[5] << 16); m_.w = e8[6] | (e8[7] << 16); gmid = __builtin_bit_cast(bf16x8, m_); }
        unsigned yoff[8];
#pragma unroll
        for (int q_ = 8; q_ < 16; ++q_) { const int t = (q_ & 3) + 8 * ((q_ >> 2) & 1) + 4 * hh; yoff[q_ - 8] = (unsigned)((z ? 15 - t : t) * D + h * 64 + 32 * ih + r31) * 2u; }
#pragma unroll 1
        for (int q = 0; q < nq; ++q) {
            { unsigned sp = 0; _Pragma("unroll 1") while ((int)ctl[0] <= q) { __builtin_amdgcn_s_sleep(1); if (++sp > (1u << 24)) break; } }
            asm volatile("" ::: "memory");
            const LAS unsigned char* sl = F.lds + SC_RING + (q % SC_NSLOT) * SC_SLOT;
            bf16x8 arf[4], gf[3], bkf[2][2], vf; f32x4 pc[8];
#pragma unroll
            for (int ks = 0; ks < 4; ++ks) arf[ks] = *(const LAS bf16x8*)(sl + BLK_AR + (ks * 64 + lane) * 16);
            gf[0] = *(const LAS bf16x8*)(sl + BLK_G + lane * 16); gf[2] = *(const LAS bf16x8*)(sl + BLK_G + (64 + lane) * 16); gf[1] = gmid;
#pragma unroll
            for (int mj = 0; mj < 2; ++mj)
#pragma unroll
                for (int ks = 0; ks < 2; ++ks) bkf[mj][ks] = *(const LAS bf16x8*)(sl + BLK_BK + ((mj * 2 + ks) * 64 + lane) * 16);
            vf = *(const LAS bf16x8*)(sl + BLK_VF + (ih * 64 + lane) * 16);
#pragma unroll
            for (int i = 0; i < 8; ++i) pc[i] = *(const LAS f32x4*)(sl + BLK_PCF + hh * 128 + i * 16);
            LDS_WAIT();
            asm volatile("" ::: "memory"); if (lane == 0) ctl[ih ? 4 : 1] = (unsigned)(q + 1);
            const bf16x8 s0 = pack_frag(st0[0], st0[1], st0[2], st0[3], st0[4], st0[5], st0[6], st0[7]), s1 = pack_frag(st0[8], st0[9], st0[10], st0[11], st0[12], st0[13], st0[14], st0[15]);
            const bf16x8 s2 = pack_frag(st1[0], st1[1], st1[2], st1[3], st1[4], st1[5], st1[6], st1[7]), s3 = pack_frag(st1[8], st1[9], st1[10], st1[11], st1[12], st1[13], st1[14], st1[15]);
            const f32x16 zero16 = {0.f, 0.f, 0.f, 0.f, 0.f, 0.f, 0.f, 0.f, 0.f, 0.f, 0.f, 0.f, 0.f, 0.f, 0.f, 0.f};
            f32x16 zz = MFMA32(arf[0], s0, zero16);
            zz = MFMA32(arf[1], s1, zz);
            zz = MFMA32(arf[2], s2, zz);
            zz = MFMA32(arf[3], s3, zz);
#pragma unroll
            for (int i = 0; i < 16; ++i) { st0[i] *= pc[i >> 2][i & 3]; st1[i] *= pc[4 + (i >> 2)][i & 3]; }
            f32x16 oo = MFMA32(gf[2], vf, zero16);
            oo = MFMA32(gf[0], pack_frag(zz[0], zz[1], zz[2], zz[3], zz[4], zz[5], zz[6], zz[7]), oo);
            oo = MFMA32(gf[1], pack_frag(zz[8], zz[9], zz[10], zz[11], zz[12], zz[13], zz[14], zz[15]), oo);
            st0 = MFMA32(bkf[0][1], vf, st0); st1 = MFMA32(bkf[1][1], vf, st1);
            const bf16x8 uf = pack_frag(oo[0], oo[1], oo[2], oo[3], oo[4], oo[5], oo[6], oo[7]);
            st0 = MFMA32(bkf[0][0], uf, st0); st1 = MFMA32(bkf[1][0], uf, st1);
            if (w > 0) {
                const int sp0 = (lo + q) * 16 - CTXL;
                const int rlow = __builtin_amdgcn_readfirstlane(b * SEQ + (z ? SEQ - 1 - sp0 - 15 : sp0));
                char* yb = (char*)YB + (size_t)rlow * (D * 2);
#pragma unroll
                for (int q_ = 8; q_ < 16; ++q_) *(bf16*)(yb + yoff[q_ - 8]) = (bf16)(pk2(oo[q_], 0.f) & 0xffffu); }
        }
#pragma unroll
        for (int i = 0; i < 16; ++i) { SST[((size_t)sp_ * 32 + i) * 64 + lane] = st0[i]; SST[((size_t)sp_ * 32 + 16 + i) * 64 + lane] = st1[i]; }
    }
}
__device__ __forceinline__ void scan_loader(const Frame& F, int w, int lane) {
    const int nq = win_n(w);
    const int p = blockIdx.x; if (p >= 256) return;
    const unsigned char* cbase = F.ws + WS_ACT + ACT_WBUF + (size_t)(w & 1) * WBUF_STRIDE + (size_t)sc_chain(p) * SC_WQ * SCAN_BLK + lane * 16;
    volatile LAS unsigned* ctl = (volatile LAS unsigned*)(F.lds + SC_CTL);
#pragma unroll 1
    for (int q = 0; q < nq; ++q) {
        { unsigned sp = 0; while (q - (int)ctl[1] >= SC_NSLOT || q - (int)ctl[4] >= SC_NSLOT) { __builtin_amdgcn_s_sleep(1); if (++sp > (1u << 24)) break; } }
        asm volatile("" ::: "memory");
        const unsigned char* src = cbase + (size_t)q * SCAN_BLK; LAS unsigned char* dst = F.lds + SC_RING + (q % SC_NSLOT) * SC_SLOT;
#pragma unroll
        for (int i_ = 0; i_ < 12; ++i_) __builtin_amdgcn_global_load_lds((const unsigned*)(src + i_ * 1024), (LAS unsigned*)(dst + i_ * 1024), 16, 0, 0);
        if (lane < 16) __builtin_amdgcn_global_load_lds((const unsigned*)(src + BLK_PCF), (LAS unsigned*)(dst + BLK_PCF), 16, 0, 0);
        asm volatile("s_waitcnt vmcnt(26)" ::: "memory");
        if (lane == 0 && q >= 1) ctl[0] = (unsigned)(q - 1);
    }
    asm volatile("s_waitcnt vmcnt(0)" ::: "memory");
    if (lane == 0) ctl[0] = (unsigned)nq;
}
__device__ __forceinline__ void phase_scan_step(Frame& F, const Args& AR, int w) {
    int tid_ = threadIdx.x; asm volatile("" : "+v"(tid_)); const int LANE = tid_ & 63, WAVE = __builtin_amdgcn_readfirstlane(tid_ >> 6);
    if (w == 0) scan_setup(F, AR, tid_);
    const bool isA = sc_half(blockIdx.x) == 0;
    if (tid_ < 8) ((volatile LAS unsigned*)(F.lds + SC_CTL))[tid_] = tid_ == 2 ? (unsigned)(isA ? SC_NPROD_A : SC_NPROD_B) : 0u;
    __syncthreads();
    if (isA) {
        if (WAVE <= 1) { if (w >= 1) scan_consume(F, w - 1, LANE, WAVE); }
        else if (WAVE == 2) { if (w >= 1) scan_loader(F, w - 1, LANE); }
        else { if (w < SCAN_NW) scan_produce(F, w, WAVE - 3, LANE, true); }
    } else { if (w < SCAN_NW) scan_produce(F, w, WAVE, LANE, false); }
}
__device__ __forceinline__ void phase_combine(Frame& F, const Args& AR, bf16* PO) {
    int tid_ = threadIdx.x; asm volatile("" : "+v"(tid_)); const int TID = tid_, LANE = tid_ & 63, WAVE = __builtin_amdgcn_readfirstlane(tid_ >> 6);
    const bf16* VP = (const bf16*)(F.ws + WS_ACT + ACT_XM + 5 * XM_STRIDE);
    const bf16* YB0 = (const bf16*)(F.ws + WS_ACT + ACT_YB0); const bf16* YB1 = (const bf16*)(F.ws + WS_ACT + ACT_YB1);
    const float* SA = (const float*)(F.ws + WS_SA);
    LAS float* TC = (LAS float*)F.lds;
    for (int i = TID; i < D / 4; i += NWAVES * 64) { *(LAS f32x4*)(TC + 4 * i) = *(const f32x4*)(AR.in[24] + 4 * i); *(LAS f32x4*)(TC + D + 4 * i) = *(const f32x4*)(AR.in[25] + 4 * i); }
    __syncthreads();
    const int gw = F.vcu * NWAVES + WAVE, NGW = F.G * NWAVES;
    v4u yaA[4], ybA[4], vqA[4], yaB[4], ybB[4], vqB[4]; float s0A[4], s1A[4], s0B[4], s1B[4];
#define CB_LOAD(ya, yb, vq, s0, s1, r_) do { _Pragma("unroll") for (int c = 0; c < 4; ++c) { const unsigned o = (unsigned)((r_) * D + 512 * c + 8 * LANE) * 2u; \
            ya[c] = *(const v4u*)((const char*)YB0 + o); yb[c] = *(const v4u*)((const char*)YB1 + o); vq[c] = *(const v4u*)((const char*)VP + o); \
            s0[c] = SA[(r_) * 32 + 8 * c + (LANE >> 3)]; s1[c] = SA[(MT + (r_)) * 32 + 8 * c + (LANE >> 3)]; } } while (0)
#define CB_COMP(ya, yb, vq, s0, s1, r_) do { _Pragma("unroll") for (int c = 0; c < 4; ++c) { const int d = 512 * c + 8 * LANE; \
            const unsigned aw[4] = {ya[c].x, ya[c].y, ya[c].z, ya[c].w}, bw[4] = {yb[c].x, yb[c].y, yb[c].z, yb[c].w}, vw[4] = {vq[c].x, vq[c].y, vq[c].z, vq[c].w}; \
            float y[8]; float sum = 0.f; \
            _Pragma("unroll") for (int e = 0; e < 4; ++e) { y[2 * e] = bflo(aw[e]) + bflo(bw[e]); y[2 * e + 1] = bfhi(aw[e]) + bfhi(bw[e]); sum += y[2 * e] + y[2 * e + 1]; } \
            sum += __shfl_xor(sum, 1); sum += __shfl_xor(sum, 2); sum += __shfl_xor(sum, 4); \
            const float mean = sum * (1.f / 64.f); float vs = 0.f; \
            _Pragma("unroll") for (int i = 0; i < 8; ++i) { const float dl = y[i] - mean; vs += dl * dl; } \
            vs += __shfl_xor(vs, 1); vs += __shfl_xor(vs, 2); vs += __shfl_xor(vs, 4); \
            const float rstd = 1.0f / sqrtf(vs * (1.f / 64.f) + GN_EPS); \
            const float sb = 0.5f * (s0[c] + s1[c]);        \
            const f32x4 l0 = *(const LAS f32x4*)(TC + d), l1 = *(const LAS f32x4*)(TC + d + 4), b0 = *(const LAS f32x4*)(TC + D + d), b1 = *(const LAS f32x4*)(TC + D + d + 4); \
            const float lw_[8] = {l0.x, l0.y, l0.z, l0.w, l1.x, l1.y, l1.z, l1.w}, lb_[8] = {b0.x, b0.y, b0.z, b0.w, b1.x, b1.y, b1.z, b1.w}; \
            float o[8]; \
            _Pragma("unroll") for (int e = 0; e < 4; ++e) { o[2 * e] = (y[2 * e] - mean) * rstd * lw_[2 * e] + lb_[2 * e] + sb * bflo(vw[e]); o[2 * e + 1] = (y[2 * e + 1] - mean) * rstd * lw_[2 * e + 1] + lb_[2 * e + 1] + sb * bfhi(vw[e]); } \
            v4u w_; w_.x = pk2(o[0], o[1]); w_.y = pk2(o[2], o[3]); w_.z = pk2(o[4], o[5]); w_.w = pk2(o[6], o[7]); \
            *(v4u*)((char*)PO + (unsigned)((r_) * D + d) * 2u) = w_; } } while (0)
    int r = gw;
    if (r < ML) CB_LOAD(yaA, ybA, vqA, s0A, s1A, r);
#pragma unroll 1
    for (; r < ML; r += 2 * NGW) {
        const int r1 = r + NGW, r2 = r + 2 * NGW;
        if (r1 < ML) CB_LOAD(yaB, ybB, vqB, s0B, s1B, r1);
        CB_COMP(yaA, ybA, vqA, s0A, s1A, r);
        if (r2 < ML) CB_LOAD(yaA, ybA, vqA, s0A, s1A, r2);
        if (r1 < ML) CB_COMP(yaB, ybB, vqB, s0B, s1B, r1);
    }
#undef CB_LOAD
#undef CB_COMP
}

template <class RowMap, bool BLK = false>
__device__ __forceinline__ void transpose_item(const float* W, int K, int N, bf16* WT, const RowMap& rm, LAS float* scr, int item, int lane) {
    const int nblk = N / 32, kb = item / nblk, nb = item % nblk, k0 = 64 * kb, n0 = 32 * nb;
#pragma unroll 8
    for (int i = 0; i < 32; ++i) { const int kk = 2 * i + (lane >> 5); scr[kk * 33 + (lane & 31)] = W[(size_t)(k0 + kk) * N + n0 + (lane & 31)]; }
    LDS_WAIT(); asm volatile("" ::: "memory");
    const int c = lane & 7;
#pragma unroll
    for (int j = 0; j < 4; ++j) { const int n = (lane >> 3) + 8 * j; const LAS float* s = scr + (8 * c) * 33 + n;
        v4u o; o.x = pk2(s[0 * 33], s[1 * 33]); o.y = pk2(s[2 * 33], s[3 * 33]); o.z = pk2(s[4 * 33], s[5 * 33]); o.w = pk2(s[6 * 33], s[7 * 33]);
        const int nr = rm(n0 + n);
        if (BLK) *(v4u*)(WT + ((size_t)(nr >> 8) * (K / 64) + (k0 >> 6)) * 16384 + (size_t)(nr & 255) * 64 + 8 * c) = o;
        else *(v4u*)(WT + (size_t)nr * K + k0 + 8 * c) = o; }
    LDS_WAIT(); asm volatile("" ::: "memory");
}
struct RmId { __device__ __forceinline__ int operator()(int n) const { return n; } };
struct RmW13 { __device__ __forceinline__ int operator()(int n) const { const int bj = n >= DFF ? 1 : 0, j = n - bj * DFF; return 256 * (j >> 7) + 128 * bj + (j & 127); } };

__device__ __forceinline__ void p0_prologue(Frame& F, const Args& AR) {
    int tid_ = threadIdx.x; asm volatile("" : "+v"(tid_)); const int TID = tid_, LANE = tid_ & 63, WAVE = __builtin_amdgcn_readfirstlane(tid_ >> 6);
    const float* x_c = AR.in[1]; const float* c_ctx = AR.in[3]; const float* mod_w = AR.in[4];
    for (int i = blockIdx.x * (NWAVES * 64) + TID; i < 6 * 262144 / 4; i += F.G * NWAVES * 64) ((f32x4*)(F.ws + WS_PS))[i] = (f32x4){0.f, 0.f, 0.f, 0.f};
    {
        LAS float* sil = (LAS float*)(F.lds);
        LAS f32x4* red = (LAS f32x4*)(F.lds + 24576);
        for (int i = TID; i < 3 * D; i += NWAVES * 64) { const int who = i / D, k = i % D; const float v = who < 2 ? x_c[who * D + k] : c_ctx[k]; sil[i] = v * sigmoidf_(v); }
        __syncthreads();
        for (int t = blockIdx.x; t < 576; t += F.G) {
            const int q = t & 3, cb = (t >> 2) % 72, layer = t / 288;
            const int r0 = q * 512 + WAVE * 64;
            const float* wp = mod_w + ((size_t)layer * D + r0) * NMODV + cb * 256 + LANE * 4;
            f32x4 a0 = {0.f, 0.f, 0.f, 0.f}, a1 = a0, a2 = a0;
#pragma unroll 8
            for (int r = 0; r < 64; ++r) { const f32x4 w = *(const f32x4*)(wp + (size_t)r * NMODV); a0 += w * sil[r0 + r]; a1 += w * sil[D + r0 + r]; a2 += w * sil[2 * D + r0 + r]; }
            red[(WAVE * 3 + 0) * 64 + LANE] = a0; red[(WAVE * 3 + 1) * 64 + LANE] = a1; red[(WAVE * 3 + 2) * 64 + LANE] = a2;
            __syncthreads();
            if (WAVE < 3) { f32x4 s = {0.f, 0.f, 0.f, 0.f};
#pragma unroll
                for (int w = 0; w < 8; ++w) s += red[(w * 3 + WAVE) * 64 + LANE];
                *(f32x4*)((float*)(F.ws + WS_MODP) + ((size_t)(q * 2 + layer) * 3 + WAVE) * NMODV + cb * 256 + LANE * 4) = s; }
            __syncthreads();
        }
    }
    LAS float* scr = (LAS float*)(F.lds + WAVE * 16384);
    const int gw = F.vcu * NWAVES + WAVE, NGW = F.G * NWAVES;
    {
        constexpr int I13 = (D / 64) * (2 * DFF / 32), I2 = (DFF / 64) * (D / 32), IDD = (D / 64) * (D / 32);
        constexpr int NIT = 4 * I13 + 4 * I2 + 5 * IDD + 2 * (D / 64) * (256 / 32) / 1;
        for (int it = gw; it < NIT; it += NGW) {
            int r = it;
            if (r < 4 * I13) { const int lf = r / I13; r -= lf * I13; const int l = lf >> 1, f = lf & 1;
                transpose_item<RmW13, true>(AR.in[7] + (size_t)lf * D * 2 * DFF, D, 2 * DFF, (bf16*)(F.ws + (l ? WS_WL1 : WS_WL0) + (size_t)f * 44 * MiB), RmW13(), scr, r, LANE); continue; }
            r -= 4 * I13;
            if (r < 4 * I2) { const int lf = r / I2; r -= lf * I2; const int l = lf >> 1, f = lf & 1;
                transpose_item<RmId, true>(AR.in[8] + (size_t)lf * DFF * D, DFF, D, (bf16*)(F.ws + (l ? WS_WL1 : WS_WL0) + 88 * MiB + (size_t)f * 22 * MiB), RmId(), scr, r, LANE); continue; }
            r -= 4 * I2;
            if (r < IDD) { transpose_item(AR.in[9], D, D, (bf16*)(F.ws + WS_WFO), RmId(), scr, r, LANE); continue; }
            r -= IDD;
            if (r < 3 * IDD) { const int p = r / IDD; r -= p * IDD; transpose_item(AR.in[12] + (size_t)p * D * D, D, D, (bf16*)(F.ws + WS_WRKV + (size_t)p * 8 * MiB), RmId(), scr, r, LANE); continue; }
            r -= 3 * IDD;
            if (r < IDD) { transpose_item(AR.in[26], D, D, (bf16*)(F.ws + WS_WRO), RmId(), scr, r, LANE); continue; }
            r -= IDD;
            if (r < 256) { transpose_item(AR.in[19], D, 256, (bf16*)(F.ws + WS_WSMALL + WSM_G1T), RmId(), scr, r, LANE); continue; }
            r -= 256;
            transpose_item(AR.in[20], 256, D, (bf16*)(F.ws + WS_WSMALL + WSM_G2T), RmId(), scr, r, LANE);
        }
    }
    {
        const int gt = (F.vcu * NWAVES + WAVE) * 64 + LANE, NGT = F.G * NWAVES * 64;
        for (int i = gt; i < 2 * 256 * D; i += NGT) { const int which = i / (256 * D), rr = (i / D) % 256, k = i % D;
            float v = 0.f; if (rr < 192) { const int z = rr / 96, r = rr % 96; v = AR.in[which ? 17 : 14][((size_t)z * D + k) * LORA + r]; }
            ((bf16*)(F.ws + WS_WSMALL + (which ? WSM_A1CAT : WSM_W1CAT)))[(size_t)rr * D + k] = (bf16)(pk2(v, 0.f) & 0xffffu); }
        for (int i = gt; i < 2 * 2 * D * LORA; i += NGT) { const int which = i / (2 * D * LORA), j = i % (2 * D * LORA), z = j / (D * LORA), n = (j / LORA) % D, r = j % LORA;
            const float v = AR.in[which ? 18 : 15][((size_t)z * LORA + r) * D + n];
            ((bf16*)(F.ws + WS_WSMALL + (which ? WSM_A2UP : WSM_W2UP)))[j] = (bf16)(pk2(v, 0.f) & 0xffffu); }
        for (int i = gt; i < MC * D / 4; i += NGT) ((f32x4*)(F.ws + WS_XC))[i] = ((const f32x4*)AR.in[2])[i];
        const float RS128 = 0.08838834764831845f;
        bf16* dm = (bf16*)(F.ws + WS_TAB + TAB_DMAT); bf16* m1 = (bf16*)(F.ws + WS_TAB + TAB_M1); bf16* m2 = (bf16*)(F.ws + WS_TAB + TAB_M2); bf16* m3 = (bf16*)(F.ws + WS_TAB + TAB_M3);
        f32x2* tw = (f32x2*)(F.ws + WS_TAB + TAB_TW);
        for (int i = gt; i < 512 * 256; i += NGT) { const int r = i >> 8, ch = i & 255, cs = r >> 8, kc = r & 255; float s, c; sincospif((float)((kc * ch) & 255) * (1.f / 128.f), &s, &c);
            dm[i] = (bf16)(pk2((cs ? s : c) * 0.0625f, 0.f) & 0xffffu); }
        for (int i = gt; i < 256 * 256; i += NGT) { const int r = i >> 8, ci = i & 255, ri = r >> 7, k1 = r & 127, cs = ci >> 7, n1 = ci & 127; float s, c; sincospif((float)((k1 * n1) & 127) * (1.f / 64.f), &s, &c);
            const float v1 = ri == 0 ? (cs == 0 ? c : -s) : (cs == 0 ? s : c);
            m1[i] = (bf16)(pk2(v1 * RS128, 0.f) & 0xffffu);
            const float v2 = r < 128 ? (cs == 0 ? c : -s) : 0.f;
            m2[i] = (bf16)(pk2(v2 * RS128, 0.f) & 0xffffu); }
        for (int i = gt; i < 256 * 512; i += NGT) { const int k = i >> 9, ci = i & 511, cs = ci >> 8, n = ci & 255; float s, c; sincospif((float)((k * n) & 255) * (1.f / 128.f), &s, &c);
            m3[i] = (bf16)(pk2((cs ? -s : c) * 0.0625f, 0.f) & 0xffffu); }
        for (int i = gt; i < 128 * 128; i += NGT) { const int k1 = i >> 7, n2 = i & 127; float s, c; sincospif((float)(k1 * n2) * (1.f / 8192.f), &s, &c); tw[i] = (f32x2){c, s}; }
    }
}

template <bool BLK = false, bool FIRST = false> __device__ __forceinline__ void phase_norm(Frame& F, const float* xl, const float* xc, int r0, int Mrows, const float* nw, int layer, int sidx, bf16* HN) {
    int tid_ = threadIdx.x; asm volatile("" : "+v"(tid_)); const int TID = tid_, LANE = tid_ & 63, WAVE = __builtin_amdgcn_readfirstlane(tid_ >> 6);
    LAS float* TA = (LAS float*)(F.lds);
    LAS float* TB = (LAS float*)(F.lds + 24576);
    for (int i = TID; i < 3 * D / 4; i += NWAVES * 64) { const int who = i / (D / 4), d = (i % (D / 4)) * 4;
        const ModRef MR{(const float*)(F.ws + WS_MODP), F.modb, (const float*)(F.ws + WS_MODV)};
        const f32x4 sh = FIRST ? modv4(MR, layer, who, sidx * D + d) : modvF(MR, layer, who, sidx * D + d), sc = FIRST ? modv4(MR, layer, who, (sidx + 1) * D + d) : modvF(MR, layer, who, (sidx + 1) * D + d), g = *(const f32x4*)(nw + d);
        *(LAS f32x4*)(TA + who * D + d) = g * (sc + 1.f); *(LAS f32x4*)(TB + who * D + d) = sh; }
    if (FIRST) {
        const ModRef MR{(const float*)(F.ws + WS_MODP), F.modb, nullptr}; float* MV = (float*)(F.ws + WS_MODV);
        for (int i = F.vcu * (NWAVES * 64) + TID; i < 6 * NMODV / 4; i += F.G * NWAVES * 64) { const int lw = i / (NMODV / 4), c = (i % (NMODV / 4)) * 4; *(f32x4*)(MV + (size_t)lw * NMODV + c) = modv4(MR, lw / 3, lw % 3, c); }
    }
    __syncthreads();
    const int gw = F.vcu * NWAVES + WAVE, NGW = F.G * NWAVES;
    for (int r = r0 + gw; r < Mrows; r += NGW) {
        const int who = who_of_row(r);
        const float* xr = r < ML ? xl + (size_t)r * D : xc + (size_t)(r - ML) * D;
        f32x4 v[4][2]; float ss = 0.f;
#pragma unroll
        for (int j = 0; j < 4; ++j)
#pragma unroll
            for (int h = 0; h < 2; ++h) { v[j][h] = *(const f32x4*)(xr + 512 * j + 8 * LANE + 4 * h); ss += (v[j][h].x * v[j][h].x + v[j][h].y * v[j][h].y) + (v[j][h].z * v[j][h].z + v[j][h].w * v[j][h].w); }
        const float rstd = 1.0f / sqrtf(wave_sum(ss) * (1.f / D) + NORM_EPS);
#pragma unroll
        for (int j = 0; j < 4; ++j) { const int d = 512 * j + 8 * LANE;
            const f32x4 a0 = *(const LAS f32x4*)(TA + who * D + d), a1 = *(const LAS f32x4*)(TA + who * D + d + 4), b0 = *(const LAS f32x4*)(TB + who * D + d), b1 = *(const LAS f32x4*)(TB + who * D + d + 4);
            const f32x4 o0 = v[j][0] * rstd * a0 + b0, o1 = v[j][1] * rstd * a1 + b1;
            v4u w; w.x = pk2(o0.x, o0.y); w.y = pk2(o0.z, o0.w); w.z = pk2(o1.x, o1.y); w.w = pk2(o1.z, o1.w);
            if (BLK) *(v4u*)(HN + ((size_t)(r >> 8) * (D / 64) + (d >> 6)) * 16384 + (size_t)(r & 255) * 64 + (d & 63)) = w;
            else *(v4u*)(HN + (size_t)r * D + d) = w; }
    }
}
__device__ __forceinline__ void phase_final(Frame& F, float* x, const float* w) {
    int tid_ = threadIdx.x; asm volatile("" : "+v"(tid_)); const int TID = tid_, LANE = tid_ & 63, WAVE = __builtin_amdgcn_readfirstlane(tid_ >> 6);
    const int gw = F.vcu * NWAVES + WAVE, NGW = F.G * NWAVES;
    for (int r = gw; r < ML; r += NGW) {
        float* xr = x + (size_t)r * D;
        f32x4 v[8]; float ss = 0.f;
#pragma unroll
        for (int j = 0; j < 8; ++j) { v[j] = *(const f32x4*)(xr + 256 * j + 4 * LANE); ss += (v[j].x * v[j].x + v[j].y * v[j].y) + (v[j].z * v[j].z + v[j].w * v[j].w); }
        const float rstd = 1.0f / sqrtf(wave_sum(ss) * (1.f / D) + NORM_EPS);
#pragma unroll
        for (int j = 0; j < 8; ++j) { const f32x4 g = *(const f32x4*)(w + 256 * j + 4 * LANE); *(f32x4*)(xr + 256 * j + 4 * LANE) = v[j] * rstd * g; }
    }
}

#if MK_DEBUG
__device__ __forceinline__ void dbg_flag(unsigned* ctl, unsigned code) { atomicMax(ctl + CW_DBG, code); }
__device__ __forceinline__ bool dbg_bad(float got, float ref, float atol, float rtol) { const float e = fabsf(got - ref); return !(e <= atol + rtol * fabsf(ref)); }
__device__ __forceinline__ unsigned dbg_hash(unsigned x) { x ^= x >> 16; x *= 0x7feb352du; x ^= x >> 15; x *= 0x846ca68bu; x ^= x >> 16; return x; }
__device__ __noinline__ void dbg_check_mod(unsigned char* ws, const float* c, const float* c_ctx, const float* mod_w, const float* modb) {
    const int lane = threadIdx.x & 63, gw = blockIdx.x * 8 + (threadIdx.x >> 6);
    if (gw >= 96) return;
    const unsigned h = dbg_hash(gw * 2654435761u + 17u); const int layer = h & 1, who = (h >> 1) % 3, col = ((h >> 4) % NMODV) & ~3;
    float s = 0.f;
    for (int k = lane; k < D; k += 64) { const float v = who < 2 ? c[who * D + k] : c_ctx[k]; s += v / (1.f + expf(-v)) * mod_w[((size_t)layer * D + k) * NMODV + col]; }
    s = wave_sum(s) + modb[(size_t)layer * NMODV + col];
    const ModRef MR{(const float*)(ws + WS_MODP), modb};
    const f32x4 g = modv4(MR, layer, who, col);
    if (lane == 0 && dbg_bad(g.x, s, 2e-3f, 2e-3f)) dbg_flag((unsigned*)(ws + WS_CTL), 1u);
}
__device__ __noinline__ void dbg_check_hn(unsigned char* ws, const float* x, const float* ctx, const float* nw, const float* modb, int layer, int sidx, unsigned code) {
    const int lane = threadIdx.x & 63, gw = blockIdx.x * 8 + (threadIdx.x >> 6);
    if (gw >= 64) return;
    const int r = (gw < 48) ? (int)(dbg_hash(gw + 99u) % ML) : ML + (int)(dbg_hash(gw + 7u) % MC);
    const float* xr = r < ML ? x + (size_t)r * D : ctx + (size_t)(r - ML) * D; const int who = who_of_row(r);
    float ss = 0.f; for (int d = lane; d < D; d += 64) ss += xr[d] * xr[d];
    const float rstd = 1.0f / sqrtf(wave_sum(ss) / D + NORM_EPS);
    const ModRef MR{(const float*)(ws + WS_MODP), modb}; const bf16* HN = (const bf16*)(ws + WS_ACT + ACT_HN);
    bool bad = false;
    for (int d4 = lane * 4; d4 < D; d4 += 256) { const f32x4 sh = modv4(MR, layer, who, sidx * D + d4), sc = modv4(MR, layer, who, (sidx + 1) * D + d4);
        for (int e = 0; e < 4; ++e) { const float ref = xr[d4 + e] * rstd * nw[d4 + e] * (1.f + sc[e]) + sh[e]; bad |= dbg_bad(bf2f(HN[(size_t)r * D + d4 + e]), ref, 0.03f, 0.01f); } }
    if (bad) dbg_flag((unsigned*)(ws + WS_CTL), code);
}
__device__ __noinline__ void dbg_check_h(unsigned char* ws, const float* w13) {
    const int lane = threadIdx.x & 63, gw = blockIdx.x * 8 + (threadIdx.x >> 6);
    if (gw >= 512) return;
    const unsigned h = dbg_hash(gw + 1234u); const int r = (gw & 7) == 7 ? ML + (int)(h % MC) : (int)(h % ML), j = (int)((h >> 7) % DFF);
    const bf16* HN = (const bf16*)(ws + WS_ACT + ACT_HN); const bf16* HB = (const bf16*)(ws + WS_ACT + ACT_H);
    float g = 0.f, u = 0.f;
    for (int k = lane; k < D; k += 64) { const float a = bf2f(HN[(size_t)r * D + k]); g += a * w13[(size_t)k * 2 * DFF + j]; u += a * w13[(size_t)k * 2 * DFF + DFF + j]; }
    g = wave_sum(g); u = wave_sum(u);
    const float ref = g / (1.f + expf(-g)) * u;
    if (lane == 0 && dbg_bad(bf2f(HB[(size_t)r * DFF + j]), ref, 0.03f, 0.03f)) dbg_flag((unsigned*)(ws + WS_CTL), 3u);
}
__device__ __noinline__ void dbg_check_w2(unsigned char* ws, const float* x, const float* ctx, const float* out, const float* w2, const float* modb) {
    const int lane = threadIdx.x & 63, gw = blockIdx.x * 8 + (threadIdx.x >> 6);
    if (gw >= 512) return;
    const unsigned h = dbg_hash(gw + 4321u); const int r = (gw & 7) == 7 ? ML + (int)(h % MC) : (int)(h % ML), col = (int)((h >> 7) % D) & ~3;
    const bf16* HB = (const bf16*)(ws + WS_ACT + ACT_H);
    float a = 0.f; for (int j = lane; j < DFF; j += 64) a += bf2f(HB[(size_t)r * DFF + j]) * w2[(size_t)j * D + col];
    a = wave_sum(a);
    const ModRef MR{(const float*)(ws + WS_MODP), modb}; const f32x4 gt = modv4(MR, 0, who_of_row(r), 2 * D + col);
    const float base = r < ML ? x[(size_t)r * D + col] : ctx[(size_t)(r - ML) * D + col];
    const float got = r < ML ? out[(size_t)r * D + col] : ((const float*)(ws + WS_XC))[(size_t)(r - ML) * D + col];
    if (lane == 0 && dbg_bad(got, base + 0.5f * gt.x * a, 0.02f, 0.01f)) dbg_flag((unsigned*)(ws + WS_CTL), 4u);
}
__device__ __noinline__ void dbg_check_fourier(unsigned char* ws, const float* xl, const float* nw, const float* modb, LAS float* red) {
    const int lane = threadIdx.x & 63, wave = threadIdx.x >> 6;
    if (blockIdx.x >= 40) return;
    const unsigned h = dbg_hash(blockIdx.x + 555u); const bool isc = blockIdx.x >= 32;
    const int L = isc ? CTXL : SEQ, b = h & 1, k = (int)((h >> 1) % (unsigned)L), g = (h >> 17) & 7, ch = (h >> 20) & 255;
    const float* xb = isc ? (const float*)(ws + WS_XC) + (size_t)b * CTXL * D : xl + (size_t)b * SEQ * D; const int who = isc ? 2 : b;
    const ModRef MR{(const float*)(ws + WS_MODP), modb};
    const int c0 = g * 256 + lane * 4; const f32x4 sh = modv4(MR, 0, who, 3 * D + c0), sc = modv4(MR, 0, who, 4 * D + c0);
    float acc = 0.f;
    for (int n = wave; n < L; n += 8) { const float* xr = xb + (size_t)n * D;
        float ss = 0.f; for (int d = lane; d < D; d += 64) ss += xr[d] * xr[d];
        const float rstd = 1.0f / sqrtf(wave_sum(ss) / D + NORM_EPS);
        const float fl = (float)((k * n) % L) / (float)L;
        for (int e = 0; e < 4; ++e) { const int c = lane * 4 + e; float hv = xr[c0 + e] * rstd * nw[c0 + e] * (1.f + sc[e]) + sh[e]; hv = bflo(pk2(hv, 0.f));
            acc += hv * cospif(2.f * (fl + (float)((ch * c) & 255) * (1.f / 256.f))); } }
    acc = wave_sum(acc); if (lane == 0) red[wave] = acc; __syncthreads();
    if (threadIdx.x == 0) { float t = 0.f; for (int w = 0; w < 8; ++w) t += red[w]; t *= isc ? (1.f / 256.f) : (1.f / 2048.f);
        const size_t row = isc ? (size_t)ML + b * CTXL + k : (size_t)b * SEQ + k; const float got = bf2f(((const bf16*)(ws + WS_ACT + ACT_HN))[row * D + g * 256 + ch]);
        if (dbg_bad(got, t, 0.04f, 0.02f)) dbg_flag((unsigned*)(ws + WS_CTL), isc ? 6u : 5u); }
}
__device__ __noinline__ void dbg_check_rkv(unsigned char* ws, const float* wrkv) {
    const int lane = threadIdx.x & 63, gw = blockIdx.x * 8 + (threadIdx.x >> 6);
    if (gw >= 768) return;
    const unsigned h = dbg_hash(gw + 777u); const int wsel = gw % 3, r = (gw & 7) == 7 ? ML + (int)(h % MC) : (int)(h % ML), col = (int)((h >> 9) % D);
    const bf16* A = (const bf16*)(ws + WS_ACT + ACT_XM + (size_t)wsel * XM_STRIDE); const bf16* O = (const bf16*)(ws + WS_ACT + ACT_XM + (size_t)(3 + wsel) * XM_STRIDE);
    float a = 0.f; for (int k = lane; k < D; k += 64) a += bf2f(A[(size_t)r * D + k]) * wrkv[((size_t)wsel * D + k) * D + col];
    a = wave_sum(a);
    if (lane == 0 && dbg_bad(bf2f(O[(size_t)r * D + col]), a, 0.03f, 0.02f)) dbg_flag((unsigned*)(ws + WS_CTL), 8u);
}
__device__ __noinline__ void dbg_check_lora(unsigned char* ws, const float* w1, const float* a1, const float* g1) {
    const int lane = threadIdx.x & 63, gw = blockIdx.x * 8 + (threadIdx.x >> 6);
    if (gw >= 768) return;
    const unsigned h = dbg_hash(gw + 888u); const int which = gw % 3, r = (gw & 7) == 7 ? ML + (int)(h % MC) : (int)(h % ML);
    const int col = which == 2 ? (int)((h >> 9) % 256) : (int)((h >> 9) % 192);
    const bf16* A = (const bf16*)(ws + WS_ACT + ACT_XM + (size_t)(3 + which) * XM_STRIDE); const bf16* O = (const bf16*)(ws + WS_ACT + ACT_LR + (size_t)which * LR_STRIDE);
    float a = 0.f;
    for (int k = lane; k < D; k += 64) { const float wv = which == 2 ? g1[(size_t)k * 256 + col] : (which ? a1 : w1)[((size_t)(col / 96) * D + k) * LORA + (col % 96)]; a += bf2f(A[(size_t)r * D + k]) * wv; }
    a = wave_sum(a); const float ref = which == 0 ? tanhf(a) : (which == 2 ? 1.f / (1.f + expf(-a)) : a);
    if (lane == 0 && dbg_bad(bf2f(O[(size_t)r * 256 + col]), ref, 0.02f, 0.02f)) dbg_flag((unsigned*)(ws + WS_CTL), 9u);
}
__device__ __noinline__ void dbg_check_scan(unsigned char* ws, const float* p_w0, const float* p_a0, const float* p_kk, const float* p_ka, const float* p_w2, const float* p_a2) {
    const int lane = threadIdx.x & 63, gw = blockIdx.x * 8 + (threadIdx.x >> 6);
    if (gw >= 64) return;
    const unsigned hsh = dbg_hash(gw + 31337u); const int chain = hsh & 127, i = (hsh >> 8) & 63, b = chain >> 6, hd = (chain >> 1) & 31, z = chain & 1;
    const bf16* RKV = (const bf16*)(ws + WS_ACT + ACT_XM + 3 * XM_STRIDE);
    const bf16* TWb = (const bf16*)(ws + WS_ACT + ACT_LR); const bf16* TAb = (const bf16*)(ws + WS_ACT + ACT_LR + LR_STRIDE);
    const bf16* YB = (const bf16*)(ws + WS_ACT + (z ? ACT_YB1 : ACT_YB0));
    const int ch = hd * 64 + lane;
    const float w0 = p_w0[z * D + ch], a0 = p_a0[z * D + ch], kkc = p_kk[ch], kac = p_ka[ch];
    float st = 0.f; float worst = 0.f;
    for (int s_ = 0; s_ < CTXL + SEQ; ++s_) {
        const int row = scan_row(b, z, s_);
        float lwv = 0.f, lav = 0.f;
        for (int r = 0; r < LORA; ++r) { lwv += bf2f(TWb[(size_t)row * 256 + z * 96 + r]) * p_w2[((size_t)z * LORA + r) * D + ch]; lav += bf2f(TAb[(size_t)row * 256 + z * 96 + r]) * p_a2[((size_t)z * LORA + r) * D + ch]; }
        const float xw = w0 + lwv, logw = -log1pf(expf(-xw)) - 0.5f, dec = expf(-expf(logw));
        const float asig = 1.f / (1.f + expf(-(a0 + lav)));
        const float rj = bf2f(RKV[(size_t)row * D + ch]), kj = bf2f(RKV[(size_t)MT * D + (size_t)row * D + ch]), vi = bf2f(RKV[2 * (size_t)MT * D + (size_t)row * D + hd * 64 + i]);
        const float kr = kj * kkc; const float nrm = wave_sum(kr * kr); const float kkj = kr / sqrtf(fmaxf(nrm, 1e-24f));
        const float aj = -kkj, bj = kkj * asig, kdj = kj * (1.f + (asig - 1.f) * kac);
        const float sa = wave_sum(st * aj);
        st = st * dec + sa * bj + vi * kdj;
        const float y = wave_sum(st * rj);
        if (s_ >= CTXL) { const float got = bf2f(YB[(size_t)row * D + hd * 64 + i]); const float e = fabsf(got - y) / (0.05f + 0.03f * fabsf(y)); worst = fmaxf(worst, e); }
    }
    if (lane == 0 && !(worst <= 1.f)) dbg_flag((unsigned*)(ws + WS_CTL), 10u);
}
__device__ __noinline__ void dbg_check_combine(unsigned char* ws, const float* p_ka, const float* p_rk, const float* p_lnw, const float* p_lnb) {
    const int lane = threadIdx.x & 63, gw = blockIdx.x * 8 + (threadIdx.x >> 6);
    if (gw >= 256) return;
    const unsigned hsh = dbg_hash(gw + 4242u); const int r = (int)(hsh % ML), hd = (hsh >> 20) & 31, ch = hd * 64 + lane;
    const bf16* RKV = (const bf16*)(ws + WS_ACT + ACT_XM + 3 * XM_STRIDE);
    const float y = bf2f(((const bf16*)(ws + WS_ACT + ACT_YB0))[(size_t)r * D + ch]) + bf2f(((const bf16*)(ws + WS_ACT + ACT_YB1))[(size_t)r * D + ch]);
    const float mean = wave_sum(y) / 64.f, var = wave_sum((y - mean) * (y - mean)) / 64.f;
    const float rj = bf2f(RKV[(size_t)r * D + ch]), kj = bf2f(RKV[(size_t)MT * D + (size_t)r * D + ch]), vj = bf2f(RKV[2 * (size_t)MT * D + (size_t)r * D + ch]);
    const float* SA = (const float*)(ws + WS_SA);
    const float sb = wave_sum(rj * p_rk[ch] * kj * (1.f - p_ka[ch])) + 0.5f * (SA[(size_t)r * 32 + hd] + SA[((size_t)MT + r) * 32 + hd]);
    const float ref = (y - mean) / sqrtf(var + GN_EPS) * p_lnw[ch] + p_lnb[ch] + sb * vj;
    const float got = bf2f(((const bf16*)(ws + WS_ACT + ACT_PO))[(size_t)r * D + ch]);
    if (dbg_bad(got, ref, 0.03f, 0.02f)) dbg_flag((unsigned*)(ws + WS_CTL), 12u);
}
__device__ __noinline__ void dbg_final(unsigned char* ws, float* out) {
    const unsigned code = __hip_atomic_load((unsigned*)(ws + WS_CTL) + CW_DBG, __ATOMIC_RELAXED, __HIP_MEMORY_SCOPE_AGENT);
    if (code) for (size_t i = (size_t)blockIdx.x * 512 + threadIdx.x; i < (size_t)ML * D; i += (size_t)gridDim.x * 512) out[i] = 1000.f * code;
}
#define DBG_PHASE(stmt) PH_BEGIN stmt; PH_END
#else
#define DBG_PHASE(stmt)
#endif

constexpr int NPH = 42;
__global__ void __launch_bounds__(NWAVES * 64, 2) mk_fwd(const Args args) {
    const Args& AR = args;
    extern __shared__ __attribute__((aligned(16))) unsigned char lds[];
    Frame F;
    F.lds = (LAS unsigned char*)lds;
    F.MISC = (volatile LAS unsigned*)(F.lds + LDSCTL_OFF);
    F.G = gridDim.x; { const int bx = blockIdx.x; F.vcu = (F.G % 8 == 0) ? (bx % 8) * (F.G / 8) + bx / 8 : bx; }
    F.ws = args.ws; F.ctl = (unsigned*)(args.ws + WS_CTL); F.out = args.out;
    F.modb = args.in[5];
    if (threadIdx.x < 16) ((LAS unsigned*)(F.lds + LDSCTL_OFF))[threadIdx.x] = 0u;
    __syncthreads();
    XcdBarrier bar; bar.bar = F.ctl + CW_BAR; bar.x = 0; bar.st = nullptr;
    if (!MK_PER_PHASE) bar = xcd_barrier_post(F.ctl + CW_BAR, F.MISC + 8);
    const int lo = args.ph_lo, hi = args.ph_hi;
    int ph = 0;
#define PH_BEGIN if (ph >= lo && ph < hi) {
#define PH_END   if (ph + 1 < hi) { if (MK_PER_PHASE) { if (threadIdx.x == 0) __hip_atomic_store(F.ctl + 0, 0xBADu, __ATOMIC_RELAXED, __HIP_MEMORY_SCOPE_AGENT); } else { xcd_barrier(bar); if (MK_PROBE & 16384) xcd_barrier(bar); } } } ++ph;

    float* XC = (float*)(F.ws + WS_XC);
    const ModRef MR{(const float*)(F.ws + WS_MODP), args.in[5], (const float*)(F.ws + WS_MODV)};
    bf16* HN = (bf16*)(F.ws + WS_ACT + ACT_HN);
    bf16* HB = (bf16*)(F.ws + WS_ACT + ACT_H);
    bf16* HNA = (bf16*)(F.ws + WS_ACT + 500 * MiB);
    float* PSB = (float*)(F.ws + WS_PS); float* RSTD = (float*)(F.ws + WS_RSTD);

    REP(16) PH_BEGIN p0_prologue(F, args); PH_END
    DBG_PHASE(dbg_check_mod(F.ws, AR.in[1], AR.in[3], AR.in[4], AR.in[5]))

#define FFN_STAGE(s_) do { constexpr int s = (s_); constexpr int layer = s >> 1, f = s & 1; constexpr int Mrows = (s == 3) ? ML : MT; \
        const float* srcL = (s == 0) ? AR.in[0] : F.out; const float* srcC = XC; \
        bf16* HNs = (s & 1) ? HNA : HN;        \
        if (s == 0) { REP(4) PH_BEGIN phase_norm<true, true>(F, srcL, srcC, 0, Mrows, AR.in[6] + (size_t)(layer * 3 + (f ? 2 : 0)) * D, layer, f ? 6 : 0, HNs); PH_END } \
        else if (s != 3) { PH_BEGIN phase_norm<true>(F, srcL, srcC, ML, Mrows, AR.in[6] + (size_t)(layer * 3 + (f ? 2 : 0)) * D, layer, f ? 6 : 0, HNs); PH_END }        \
        if (s == 0) { DBG_PHASE(dbg_check_hn(F.ws, AR.in[0], AR.in[2], AR.in[6], AR.in[5], 0, 0, 2u)) } \
        REP(s == 0 ? 2 : 0) PH_BEGIN { \
            OpBlk A{HNs, D / 64, true}, B{(const bf16*)(F.ws + (layer ? WS_WL1 : WS_WL0) + (size_t)f * 44 * MiB), D / 64, false}; \
            pg8::StaticOrder S; S.init(Mrows / 256, DFF / 128, F.G, (int)blockIdx.x); \
            EpiSwiGLU E{HB}; \
            pg8::gemm_phase(F.lds + RING_OFF, D, A, B, S, E); \
        } PH_END \
        if (s == 0) { DBG_PHASE(dbg_check_h(F.ws, AR.in[7])) } \
        PH_BEGIN { \
            OpHBlk A{HB, -1, 0}; OpBlk B{(const bf16*)(F.ws + (layer ? WS_WL1 : WS_WL0) + 88 * MiB + (size_t)f * 22 * MiB), HKT, false}; \
            pg8::StaticOrder S; S.init(ML / 256, D / 256, F.G, (int)blockIdx.x, 4, 0, 1); \
              \
            constexpr int NX = (s == 0) ? 2 : (s == 1) ? 1 : (s == 2) ? 3 : 4; constexpr int site = (s == 0) ? 0 : (s == 1) ? 2 : (s == 2) ? 3 : 5; \
            const float* nwn = (s == 0) ? AR.in[6] + (size_t)(0 * 3 + 1) * D : (s == 1) ? AR.in[6] + (size_t)(1 * 3 + 0) * D : AR.in[27]; \
            EpiResidNorm<false, true, NX> E{MR, srcL, F.out, nullptr, layer, f ? 8 : 2, nwn, (s == 0) ? 0 : 1, (s == 0) ? 3 : 0, HN, RSTD, PSB + (size_t)site * 262144, F.ctl + CW_PCNT + site * 1024, F.lds + RING_BYTES}; \
            pg8::gemm_phase(F.lds + RING_OFF, DFF, A, B, S, E); \
            if (Mrows > ML) { OpHBlk Ac{HB, 128, HKT / 4}; OpBlkK Bc{(const bf16*)(F.ws + (layer ? WS_WL1 : WS_WL0) + 88 * MiB + (size_t)f * 22 * MiB), HKT}; \
                OrderCtxK Sc{F.G, (int)blockIdx.x}; EpiCtxAtomic<false, true> Ec{MR, XC, nullptr, layer, f ? 8 : 2}; \
                pg8::gemm_phase(F.lds + RING_OFF, DFF / 4, Ac, Bc, Sc, Ec); } \
        } PH_END \
        if (s == 0) { DBG_PHASE(dbg_check_w2(F.ws, AR.in[0], AR.in[2], F.out, AR.in[8], AR.in[5])) } \
    } while (0)

    FFN_STAGE(0);
        {
            bf16* YT = (bf16*)(F.ws + WS_ACT + ACT_YT); bf16* T2 = (bf16*)(F.ws + WS_ACT + ACT_T2); bf16* YC = (bf16*)(F.ws + WS_ACT + ACT_YC);
            PH_BEGIN phase_norm<false>(F, F.out, XC, ML, MT, AR.in[6] + (size_t)(0 * 3 + 1) * D, 0, 3, HN); PH_END
            REP(64) PH_BEGIN {
                { OpFixed A{(const bf16*)(F.ws + WS_TAB + TAB_DMAT), 256, 1}; OpChanL B{HN}; pg8::StaticOrder S; S.init(16, 128, F.G, (int)blockIdx.x); EpiChanL E{YT};
                  pg8::gemm_phase(F.lds + RING_OFF, 256, A, B, S, E); }
                { OpFixed A{(const bf16*)(F.ws + WS_TAB + TAB_DMAT), 256, 1}; OpChanC B{HN}; pg8::StaticOrder S; S.init(16, 2, F.G, (int)blockIdx.x); EpiChanC E{YC};
                  pg8::gemm_phase(F.lds + RING_OFF, 256, A, B, S, E); }
            } PH_END
            REP(64) PH_BEGIN {
                { OpFixed A{(const bf16*)(F.ws + WS_TAB + TAB_M1), 256, 0}; pg8::OpPlain B{YT, 256, false}; pg8::StaticOrder S; S.init(1, 2048, F.G, (int)blockIdx.x); EpiStage1 E{T2, (const float*)(F.ws + WS_TAB + TAB_TW)};
                  pg8::gemm_phase(F.lds + RING_OFF, 256, A, B, S, E); }
                { OpFixed A{(const bf16*)(F.ws + WS_TAB + TAB_M3), 512, 0}; pg8::OpPlain B{YC, 512, false}; pg8::StaticOrder S; S.init(1, 16, F.G, (int)blockIdx.x); EpiCtxDft E{HN};
                  pg8::gemm_phase(F.lds + RING_OFF, 512, A, B, S, E); }
            } PH_END
            REP(64) PH_BEGIN {
                OpFixed A{(const bf16*)(F.ws + WS_TAB + TAB_M2), 256, 0}; OpStage2B B{T2}; pg8::StaticOrder S; S.init(1, 2048, F.G, (int)blockIdx.x); EpiStage2 E{HN};
                pg8::gemm_phase(F.lds + RING_OFF, 256, A, B, S, E);
            } PH_END
            DBG_PHASE(dbg_check_fourier(F.ws, F.out, AR.in[6] + D, AR.in[5], (LAS float*)F.lds))
            PH_BEGIN {
                pg8::OpPlain A{HN, D, true}, B{(const bf16*)(F.ws + WS_WFO), D, false};
                pg8::StaticOrder S; S.init(ML / 256, D / 256, F.G, (int)blockIdx.x, 4);
                EpiResidNorm<true, false, 1> E{MR, F.out, F.out, AR.in[10], 0, 5, AR.in[6] + (size_t)(0 * 3 + 2) * D, 0, 6, HNA, RSTD, PSB + (size_t)1 * 262144, F.ctl + CW_PCNT + 1 * 1024, F.lds + RING_BYTES};
                pg8::gemm_phase(F.lds + RING_OFF, D, A, B, S, E);
                OpKSplit Ac{HN + (size_t)ML * D, D, D / 4, true}, Bc{(const bf16*)(F.ws + WS_WFO), D, D / 4, false};
                OrderCtxK Sc{F.G, (int)blockIdx.x}; EpiCtxAtomic<true, false> Ec{MR, XC, AR.in[10], 0, 5};
                pg8::gemm_phase(F.lds + RING_OFF, D / 4, Ac, Bc, Sc, Ec);
            } PH_END
        }
    FFN_STAGE(1);
    FFN_STAGE(2);
    {
        bf16* XM = (bf16*)(F.ws + WS_ACT + ACT_XM); bf16* LR = (bf16*)(F.ws + WS_ACT + ACT_LR); bf16* PO = (bf16*)(F.ws + WS_ACT + ACT_PO);
        REP(8) PH_BEGIN phase_rowstats(F, F.out, XC, RSTD, ML); PH_END
        REP(4096) PH_BEGIN phase_mix(F, MR, F.out, XC, RSTD, AR.in[6] + (size_t)(1 * 3 + 1) * D, AR.in[11], XM); PH_END
        REP(128) PH_BEGIN {
            OpXM A{XM, 1, 3}; OpWSel B{(const bf16*)(F.ws + WS_WSMALL), 1, 1 * MiB}; pg8::StaticOrder S; S.init(MT / 256, 3, F.G, (int)blockIdx.x); EpiLora E{LR};
            pg8::gemm_phase(F.lds + RING_OFF, D, A, B, S, E);
            { OpXM Ac{XM, 8, 0}; OpWSel Bc{(const bf16*)(F.ws + WS_WRKV), 8, 8 * MiB}; pg8::StaticOrder Sc; Sc.init(2, 24, F.G, (int)((blockIdx.x + F.G - 140) % F.G), pg8::WGM, 128); EpiRkvC Ec{(bf16*)(F.ws + WS_RKVC)};
              pg8::gemm_phase(F.lds + RING_OFF, D, Ac, Bc, Sc, Ec); }
        } PH_END
        DBG_PHASE(dbg_check_lora(F.ws, AR.in[14], AR.in[17], AR.in[19]))
        REP(512) PH_BEGIN {
            OpXM A{XM, 8, 0}; OpWSel B{(const bf16*)(F.ws + WS_WRKV), 8, 8 * MiB}; pg8::StaticOrder S; S.init(ML / 256, 24, F.G, (int)blockIdx.x); EpiRkv E{XM};
            pg8::gemm_phase(F.lds + RING_OFF, D, A, B, S, E);
        } PH_END
        DBG_PHASE(dbg_check_rkv(F.ws, AR.in[12]))
        REP(1)
#pragma unroll 1
        for (int w = 0; w <= SCAN_NW; ++w) { PH_BEGIN phase_scan_step(F, args, w); PH_END }
        DBG_PHASE(dbg_check_scan(F.ws, AR.in[13], AR.in[16], AR.in[21], AR.in[22], AR.in[15], AR.in[18]))
        REP(256) PH_BEGIN phase_combine(F, args, PO); PH_END
        DBG_PHASE(dbg_check_combine(F.ws, AR.in[22], AR.in[23], AR.in[24], AR.in[25]))
        PH_BEGIN {
            pg8::OpPlain A{(const bf16*)((const char*)LR + 2 * LR_STRIDE), 256, true}, B{(const bf16*)(F.ws + WS_WSMALL + WSM_G2T), 256, false};
            pg8::StaticOrder S; S.init(ML / 256, D / 256, F.G, (int)blockIdx.x); EpiMulG<> E{PO};
            if (MK_PROBE & 32768) { EpiMulG<true> Ed{PO}; pg8::gemm_phase(F.lds + RING_OFF, 256, A, B, S, Ed); }
            pg8::gemm_phase(F.lds + RING_OFF, 256, A, B, S, E);
        } PH_END
        PH_BEGIN {
            pg8::OpPlain A{PO, D, true}, B{(const bf16*)(F.ws + WS_WRO), D, false};
            pg8::StaticOrder S; S.init(ML / 256, D / 256, F.G, (int)blockIdx.x, 4);
            EpiResidNorm<false, false, 1> E{MR, F.out, F.out, nullptr, 1, 5, AR.in[6] + (size_t)(1 * 3 + 2) * D, 1, 6, HNA, RSTD, PSB + (size_t)4 * 262144, F.ctl + CW_PCNT + 4 * 1024, F.lds + RING_BYTES};
            pg8::gemm_phase(F.lds + RING_OFF, D, A, B, S, E);
        } PH_END
    }
    FFN_STAGE(3);
    DBG_PHASE(dbg_final(F.ws, F.out))
#undef PH_BEGIN
#undef PH_END
}

extern "C" void kernel_launch(void* const* d_in, const int* in_sizes, int n_in, void* d_out, int out_size, void* d_ws, size_t ws_size, hipStream_t stream) {
    static int grid = 0;
    if (grid == 0) {
        if (n_in != 28 || out_size != ML * D || ws_size < WS_END) { fprintf(stderr, "kernel_launch: unexpected shapes (n_in %d, out %d, ws %zu < %zu)\n", n_in, out_size, ws_size, (size_t)WS_END); grid = -1; return; }
        int dev = 0, cus = 0, per_cu = 0;
        if (hipGetDevice(&dev) != hipSuccess || hipDeviceGetAttribute(&cus, hipDeviceAttributeMultiprocessorCount, dev) != hipSuccess) { grid = -1; return; }
        if (hipFuncSetAttribute((const void*)mk_fwd, hipFuncAttributeMaxDynamicSharedMemorySize, LDS_BYTES) != hipSuccess) { fprintf(stderr, "kernel_launch: hipFuncSetAttribute failed\n"); grid = -1; return; }
        if (hipOccupancyMaxActiveBlocksPerMultiprocessor(&per_cu, (const void*)mk_fwd, NWAVES * 64, LDS_BYTES) != hipSuccess || per_cu < 1)
            fprintf(stderr, "kernel_launch: occupancy query reports %d per CU\n", per_cu);
        (void)hipGetLastError();
        grid = cus;
        if (cus != 256) { fprintf(stderr, "kernel_launch: built for a 256-CU device (the scan phase maps its 256 chains-halves onto 256 workgroups); found %d CUs, nothing launched\n", cus); grid = -1; return; }
    }
    if (grid < 0) return;
    if (hipMemsetAsync((char*)d_ws + WS_CTL, 0, CTL_ZERO_BYTES, stream) != hipSuccess) return;
    Args a{};
    for (int i = 0; i < 28; ++i) a.in[i] = (const float*)d_in[i];
    a.out = (float*)d_out; a.ws = (unsigned char*)d_ws;
#if MK_PER_PHASE
    for (int p = 0; p < NPH; ++p) { a.ph_lo = p; a.ph_hi = p + 1; hipLaunchKernelGGL(mk_fwd, dim3(grid), dim3(NWAVES * 64), LDS_BYTES, stream, a); }
#else
    a.ph_lo = 0; a.ph_hi = 100000;
    hipLaunchKernelGGL(mk_fwd, dim3(grid), dim3(NWAVES * 64), LDS_BYTES, stream, a);
#endif
}
```

```cpp
#include <hip/hip_runtime.h>
#include <cstdio>
#include <cstdint>

#ifndef MK_PER_PHASE
#define MK_PER_PHASE 0
#endif
#ifndef MK_PROBE
#define MK_PROBE 0
#endif
#define REP(mask) _Pragma("unroll 1") for (int rep_ = 0; rep_ < ((MK_PROBE & (mask)) ? 2 : 1); ++rep_)
#ifndef MK_DEBUG
#define MK_DEBUG 0
#endif

#define GAS __attribute__((address_space(1)))
#define LAS __attribute__((address_space(3)))
typedef unsigned short bf16;
typedef unsigned v4u __attribute__((ext_vector_type(4)));
typedef unsigned v2u __attribute__((ext_vector_type(2)));
typedef float f32x4 __attribute__((ext_vector_type(4)));
typedef float f32x2 __attribute__((ext_vector_type(2)));
typedef float f32x16 __attribute__((ext_vector_type(16)));
typedef short bf16x8 __attribute__((ext_vector_type(8)));
typedef __bf16 bf2_t __attribute__((ext_vector_type(2)));

constexpr int D = 2048, NBATCH = 2, SEQ = 16384, CTXL = 256, DFF = 5632, NMODV = 9 * 2048, NH = 32, HD = 64;
constexpr int ML = NBATCH * SEQ, MC = NBATCH * CTXL, MT = ML + MC;
constexpr int LORA = 96;
constexpr int HKT = DFF / 64;
constexpr int NWAVES = 8;
constexpr float NORM_EPS = 1e-6f, GN_EPS = 64e-5f;

constexpr size_t MiB = 1u << 20;
constexpr size_t WS_CTL = 0, CTL_ZERO_BYTES = 64 * 1024;
constexpr size_t WS_MODP = 1 * MiB;
constexpr size_t WS_TAB = 3 * MiB;
constexpr size_t TAB_DMAT = 0, TAB_M1 = 262144, TAB_M2 = 393216, TAB_M3 = 524288, TAB_TW = 786432;
constexpr size_t WS_RSTD = 4 * MiB;
constexpr size_t WS_SA = 5 * MiB;
constexpr size_t WS_XC = 14 * MiB;
constexpr size_t WS_WSMALL = 18 * MiB;
constexpr size_t WSM_W1CAT = 0, WSM_A1CAT = 1 * MiB, WSM_G1T = 2 * MiB, WSM_W2UP = 3 * MiB, WSM_A2UP = 4 * MiB, WSM_G2T = 5 * MiB;
constexpr size_t WS_WFO = 24 * MiB, WS_WRO = 32 * MiB, WS_WRKV = 40 * MiB;
constexpr size_t WS_WL0 = 64 * MiB, WS_WL1 = 196 * MiB;
constexpr size_t WS_ACT = 328 * MiB;
constexpr size_t ACT_HN = 0, ACT_H = 130 * MiB;
constexpr size_t ACT_YT = 130 * MiB, ACT_T2 = 386 * MiB, ACT_YC = 642 * MiB;
constexpr size_t ACT_XM = 0, XM_STRIDE = 130 * MiB, ACT_LR = 780 * MiB, LR_STRIDE = 17039360;
constexpr size_t ACT_WBUF = 0, WBUF_STRIDE = 123 * MiB, ACT_YB0 = 248 * MiB, ACT_YB1 = 829 * MiB, ACT_PO = 0;
constexpr size_t WS_SST = WS_ACT + 957 * MiB;
constexpr size_t WS_RKVC = WS_SST + 2 * MiB;
constexpr size_t WS_PS = WS_RKVC + 6 * MiB;
constexpr size_t WS_MODV = WS_PS + 6 * MiB;
constexpr size_t WS_DUMP = WS_MODV + 1 * MiB;
constexpr size_t WS_END = WS_DUMP + 16 * MiB;
static_assert(WS_END <= 1476395008ull, "workspace map exceeds the guaranteed minimum");
static_assert((size_t)MT * D * 2 == 130 * MiB, "XM size");

constexpr int CW_DBG = 8;
constexpr int CW_BAR = 4096;
constexpr int CW_PCNT = 8192;

#define LDS_WAIT() asm volatile("s_waitcnt lgkmcnt(0)" ::: "memory")
#define VM_WAIT() asm volatile("s_waitcnt vmcnt(0)" ::: "memory")
__device__ __forceinline__ unsigned pk2(float lo, float hi) { f32x2 v = {lo, hi}; bf2_t b = __builtin_convertvector(v, bf2_t); return __builtin_bit_cast(unsigned, b); }
__device__ __forceinline__ float bf2f(bf16 b) { return __uint_as_float(((unsigned)b) << 16); }
__device__ __forceinline__ float bflo(unsigned w) { return __uint_as_float(w << 16); }
__device__ __forceinline__ float bfhi(unsigned w) { return __uint_as_float(w & 0xffff0000u); }
__device__ __forceinline__ float wave_sum(float v) {
#pragma unroll
    for (int o = 1; o < 64; o <<= 1) v += __shfl_xor(v, o);
    return v;
}
__device__ __forceinline__ float sigmoidf_(float x) { return __builtin_amdgcn_rcpf(1.f + __expf(-x)); }

#define XB_TMO      128
#define XB_XCNT(j)  (256  + 64 * (j))
#define XB_XSUB(j)  (1280 + 64 * (j))
#define XB_XGEN(j)  (2304 + 64 * (j))
#define XB_TOP      3328
#define XB_TOPGEN   3392
#define XCD_BAR_WORDS 3456
#define XB_SPIN_CAP (1u << 22)

__device__ __forceinline__ unsigned xb_ld(unsigned* p)              { return __hip_atomic_load(p, __ATOMIC_RELAXED, __HIP_MEMORY_SCOPE_AGENT); }
__device__ __forceinline__ unsigned xb_add(unsigned* p, unsigned v) { return __hip_atomic_fetch_add(p, v, __ATOMIC_RELAXED, __HIP_MEMORY_SCOPE_AGENT); }
__device__ __forceinline__ unsigned xb_xcc_id() { return (unsigned)__builtin_amdgcn_s_getreg((3 << 11) | 20) & 0xFu; }
#define XB_SPIN(cond, bar) do { unsigned _sp = 0; while (cond) { __builtin_amdgcn_s_sleep(1); \
    if ((++_sp & 255u) == 0u) { if (xb_ld(&(bar)[XB_TMO])) break; if (_sp > XB_SPIN_CAP) { atomicAdd(&(bar)[XB_TMO], 1u); break; } } } } while (0)

struct XcdBarrier { unsigned* bar; unsigned x; volatile LAS unsigned* st; };

__device__ __forceinline__ XcdBarrier xcd_barrier_post(unsigned* bar, volatile LAS unsigned* st) {
    XcdBarrier b; b.bar = bar; b.x = xb_xcc_id(); b.st = st;
    if (threadIdx.x == 0) (void)xb_add(&bar[XB_XCNT(b.x)], 1u);
    return b;
}
__device__ __forceinline__ void xcd_barrier_complete(unsigned* bar, unsigned x, unsigned& nloc, unsigned& nx) {
    const unsigned G = gridDim.x * gridDim.y * gridDim.z;
    unsigned sum, cnt, mine, sp = 0u;
    for (;;) {
        sum = 0u; cnt = 0u; mine = 0u;
#pragma unroll
        for (unsigned j = 0; j < 16; ++j) { const unsigned c = xb_ld(&bar[XB_XCNT(j)]); sum += c; cnt += (c > 0u) ? 1u : 0u; mine = (j == x) ? c : mine; }
        if (sum == G) break;
        __builtin_amdgcn_s_sleep(1);
        if ((++sp & 255u) == 0u) { if (xb_ld(&bar[XB_TMO])) break; if (sp > XB_SPIN_CAP) { atomicAdd(&bar[XB_TMO], 1u); break; } }
    }
    nloc = mine > 0u ? mine : 1u; nx = cnt > 0u ? cnt : 1u;
}
__device__ __forceinline__ void xcd_barrier(const XcdBarrier& b) {
    asm volatile("s_waitcnt vmcnt(0)" ::: "memory");
    __syncthreads();
    if (threadIdx.x == 0) {
        unsigned* bar = b.bar;
        __builtin_amdgcn_s_waitcnt(0);
        unsigned nloc = b.st[0], nx = b.st[1];
        if (nloc == 0u) { xcd_barrier_complete(bar, b.x, nloc, nx); b.st[0] = nloc; b.st[1] = nx; }
        const unsigned old = xb_add(&bar[XB_XSUB(b.x)], 1u);
        const unsigned gen = old / nloc;
        if (old + 1u == (gen + 1u) * nloc) {
            __builtin_amdgcn_fence(__ATOMIC_RELEASE, "agent");
            asm volatile("s_waitcnt vmcnt(0)" ::: "memory");
            const unsigned og = xb_add(&bar[XB_TOP], 1u);
            const unsigned tg = og / nx;
            if (og + 1u == (tg + 1u) * nx) xb_add(&bar[XB_TOPGEN], 1u);
            else XB_SPIN(xb_ld(&bar[XB_TOPGEN]) == tg, bar);
            __builtin_amdgcn_fence(__ATOMIC_ACQUIRE, "agent");
            xb_add(&bar[XB_XGEN(b.x)], 1u);
            asm volatile("s_waitcnt vmcnt(0)" ::: "memory");
        } else {
            XB_SPIN(xb_ld(&bar[XB_XGEN(b.x)]) == gen, bar);
            __builtin_amdgcn_fence(__ATOMIC_ACQUIRE, "agent");
            asm volatile("s_waitcnt vmcnt(0)" ::: "memory");
        }
    }
    __syncthreads();
}

namespace pg8 {
constexpr int BM = 256, BK = 64, HALF = 128, HTB = HALF * BK * 2, STAGE_BYTES = 8 * HTB, NXCD = 8, WGM = 8;
__host__ __device__ __forceinline__ int lds_byte(int r, int c) { const int st = (r >> 4) * 2 + (c >> 5), rr = r & 15, cc = c & 31, ob = rr * 64 + cc * 2; return st * 1024 + (ob ^ (((ob >> 9) & 1) << 5)); }
__host__ __device__ __forceinline__ void stage_rc(int b, int& R, int& C) { const int st = b / 1024, sb = b % 1024, swz = sb ^ (((sb >> 9) & 1) << 5); R = (st >> 1) * 16 + swz / 64; C = (st & 1) * 32 + (swz % 64) / 2; }
__host__ __device__ __forceinline__ int perm32(int rho) { const int n = rho >> 4, i = rho & 15; return 8 * (i >> 2) + 4 * n + (i & 3); }

struct Unit { int pm, pn; };
struct StaticOrder {
    int nM, nN, nwg, G, c, wgm, pm0, rev;
    __host__ __device__ void init(int nM_, int nN_, int G_, int c_, int wgm_ = WGM, int pm0_ = 0, int rev_ = 0) { nM = nM_; nN = nN_; nwg = nM * nN; G = G_; c = c_; wgm = wgm_; pm0 = pm0_; rev = rev_; }
    __host__ __device__ bool next(int i, Unit& u) const {
        const long L = (long)i * G + c; if (L >= nwg) return false;
        int wgid = (int)L; { const int q = nwg / NXCD, r = nwg % NXCD, xcd = wgid % NXCD, off = wgid / NXCD; wgid = (xcd < r ? xcd * (q + 1) : r * (q + 1) + (xcd - r) * q) + off; }
        const int nig = wgm * nN, gid = wgid / nig, fm = gid * wgm, gsz = (nM - fm) < wgm ? (nM - fm) : wgm;
        const int pmi = fm + ((wgid % nig) % gsz); u.pm = pm0 + (rev ? nM - 1 - pmi : pmi); u.pn = (wgid % nig) / gsz; return true;
    }
};
struct OpPlain {
    const bf16* base; int ld; bool isA;
    __device__ __forceinline__ const char* tile(const Unit& u) const { return (const char*)base + (size_t)(isA ? u.pm : u.pn) * 256 * ld * 2; }
    __device__ __forceinline__ unsigned voff(int R, int C) const { return (unsigned)(R * ld + C) * 2u; }
    __device__ __forceinline__ size_t hstep() const { return (size_t)HALF * ld * 2; }
    __device__ __forceinline__ size_t kstep() const { return 128; }
};

template <class AOp, class BOp, class Epi, class Sched>
__device__ __forceinline__ void gemm_phase(LAS unsigned char* lds, const int K, const AOp& Aop, const BOp& Bop, const Sched& S, const Epi& E) {
    int tid = threadIdx.x; asm volatile("" : "+v"(tid));
    const int wid = __builtin_amdgcn_readfirstlane(tid >> 6), lane = tid & 63, wr = wid >> 2, wc = wid & 3, fr = lane & 15, fq = lane >> 4;
    int nt = K / BK; asm volatile("" : "+s"(nt));
    unsigned voffA[2], voffB[2];
#pragma unroll
    for (int i = 0; i < 2; ++i) { int R, C; stage_rc(tid * 16 + i * 8192, R, C); const int Rb = Epi::PERM ? ((R & ~31) + perm32(R & 31)) : R;
        voffA[i] = Aop.voff(R, C); voffB[i] = Bop.voff(Rb, C); }
    const size_t kstepA = Aop.kstep(), kstepB = Bop.kstep();
    const size_t hstepA = Aop.hstep(), hstepB = Bop.hstep();
    const unsigned ldsw = (unsigned)wid * 1024u;
    const int aoff = lds_byte(wr * 64 + fr, fq * 8), boff = lds_byte(wc * 32 + fr, fq * 8);
#define PG8_SA(b, h) (((b) * 2 + (h)) * HTB)
#define PG8_SB(b, h) ((4 + (b) * 2 + (h)) * HTB)
#define PG8_STAGE(bufoff, gbase, voff) do { _Pragma("unroll") for (int _i = 0; _i < 2; ++_i) \
        __builtin_amdgcn_global_load_lds((const unsigned*)((const char*)(gbase) + (voff)[_i]), (LAS unsigned*)(lds + (bufoff) + ldsw + _i * 8192), 16, 0, 0); } while (0)
#define PG8_LDA(dst, b, h) do { _Pragma("unroll") for (int m = 0; m < 4; ++m) _Pragma("unroll") for (int k = 0; k < 2; ++k) dst[m][k] = *(const LAS bf16x8*)(lds + PG8_SA(b, h) + aoff + m * 2048 + k * 1024); } while (0)
#define PG8_LDB(dst, b, h) do { _Pragma("unroll") for (int n = 0; n < 2; ++n) _Pragma("unroll") for (int k = 0; k < 2; ++k) dst[n][k] = *(const LAS bf16x8*)(lds + PG8_SB(b, h) + boff + n * 2048 + k * 1024); } while (0)
#define PG8_MMA(ai, bj, At, Bt) do { __builtin_amdgcn_s_setprio(1); _Pragma("unroll") for (int m = 0; m < 4; ++m) _Pragma("unroll") for (int n = 0; n < 2; ++n) _Pragma("unroll") for (int k = 0; k < 2; ++k) \
        acc[ai][bj][m][n] = __builtin_amdgcn_mfma_f32_16x16x32_bf16(Bt[n][k], At[m][k], acc[ai][bj][m][n], 0, 0, 0); __builtin_amdgcn_s_setprio(0); } while (0)
#define PG8_WAIT_V(n) asm volatile("s_waitcnt vmcnt(" #n ")" ::: "memory")
#define PG8_WAIT_L(n) asm volatile("s_waitcnt lgkmcnt(" #n ")" ::: "memory")
#define PG8_BAR __builtin_amdgcn_s_barrier()
#define PG8_SCHED __builtin_amdgcn_sched_barrier(0)
    Unit cur, nxt; int ui = 0;
    if (!S.next(0, cur)) return;
    f32x4 acc[2][2][4][2];
#pragma unroll
    for (int a = 0; a < 2; ++a)
#pragma unroll
        for (int b = 0; b < 2; ++b)
#pragma unroll
            for (int m = 0; m < 4; ++m)
#pragma unroll
                for (int n = 0; n < 2; ++n) acc[a][b][m][n] = (f32x4){0.f, 0.f, 0.f, 0.f};
    bf16x8 At[4][2], B0[2][2], B1[2][2];
    const char* cA = Aop.tile(cur); const char* cB = Bop.tile(cur);
    PG8_STAGE(PG8_SB(0, 0), cB, voffB); PG8_STAGE(PG8_SB(0, 1), cB + hstepB, voffB); PG8_STAGE(PG8_SA(0, 0), cA, voffA); PG8_STAGE(PG8_SA(0, 1), cA + hstepA, voffA);
    if (wr == 1) PG8_BAR;
    PG8_WAIT_V(2); PG8_BAR;
    PG8_STAGE(PG8_SB(1, 0), cB + kstepB, voffB); PG8_STAGE(PG8_SA(1, 0), cA + kstepA, voffA); PG8_STAGE(PG8_SB(1, 1), cB + hstepB + kstepB, voffB);
    PG8_WAIT_V(6); PG8_BAR;
    for (;;) {
        const bool has_next = S.next(ui + 1, nxt);
        const char* nA = has_next ? Aop.tile(nxt) : cA; const char* nB = has_next ? Bop.tile(nxt) : cB;
#pragma unroll 1
        for (int t = 0; t < nt; t += 2) {
            const bool last = (t == nt - 2);
            const char* a1 = cA + (size_t)(t + 1) * kstepA;
            const char* a2 = last ? nA : cA + (size_t)(t + 2) * kstepA; const char* b2 = last ? nB : cB + (size_t)(t + 2) * kstepB;
            const char* a3 = a2 + kstepA; const char* b3 = b2 + kstepB;
            PG8_LDB(B0, 0, 0); PG8_LDB(B1, 0, 1); PG8_SCHED; PG8_LDA(At, 0, 0); PG8_STAGE(PG8_SA(1, 1), a1 + hstepA, voffA);
            PG8_WAIT_V(8); PG8_WAIT_L(0); PG8_BAR; PG8_MMA(0, 0, At, B0); PG8_MMA(0, 1, At, B1); PG8_BAR; PG8_SCHED;
            PG8_LDA(At, 0, 1); PG8_STAGE(PG8_SB(0, 0), b2, voffB); PG8_STAGE(PG8_SB(0, 1), b2 + hstepB, voffB); PG8_STAGE(PG8_SA(0, 0), a2, voffA);
            PG8_WAIT_V(8); PG8_WAIT_L(0); PG8_BAR; PG8_MMA(1, 0, At, B0); PG8_MMA(1, 1, At, B1); PG8_BAR; PG8_SCHED;
            PG8_LDB(B0, 1, 0); PG8_LDB(B1, 1, 1); PG8_SCHED; PG8_LDA(At, 1, 0); PG8_STAGE(PG8_SA(0, 1), a2 + hstepA, voffA);
            PG8_WAIT_V(8); PG8_WAIT_L(0); PG8_BAR; PG8_MMA(0, 0, At, B0); PG8_MMA(0, 1, At, B1); PG8_BAR; PG8_SCHED;
            PG8_LDA(At, 1, 1); PG8_STAGE(PG8_SB(1, 0), b3, voffB); PG8_STAGE(PG8_SB(1, 1), b3 + hstepB, voffB); PG8_STAGE(PG8_SA(1, 0), a3, voffA);
            PG8_WAIT_V(8); PG8_WAIT_L(0); PG8_BAR; PG8_MMA(1, 0, At, B0); PG8_MMA(1, 1, At, B1); PG8_BAR; PG8_SCHED;
        }
        if (wr == 0) PG8_BAR;
        E(acc, cur, wr, wc, fr, fq);
        if (!has_next) break;
#pragma unroll
        for (int a = 0; a < 2; ++a)
#pragma unroll
            for (int b = 0; b < 2; ++b)
#pragma unroll
                for (int m = 0; m < 4; ++m)
#pragma unroll
                    for (int n = 0; n < 2; ++n) acc[a][b][m][n] = (f32x4){0.f, 0.f, 0.f, 0.f};
        cur = nxt; cA = nA; cB = nB; ++ui;
        if (wr == 1) PG8_BAR;
    }
    PG8_WAIT_V(0);
    PG8_BAR;
#undef PG8_SA
#undef PG8_SB
#undef PG8_STAGE
#undef PG8_LDA
#undef PG8_LDB
#undef PG8_MMA
#undef PG8_WAIT_V
#undef PG8_WAIT_L
#undef PG8_BAR
#undef PG8_SCHED
}
}

constexpr int RING_OFF = 0, RING_BYTES = 131072;
constexpr int LDSCTL_OFF = 160 * 1024 - 64;
constexpr int LDS_BYTES = 160 * 1024;

struct Args { const float* in[28]; float* out; unsigned char* ws; int ph_lo, ph_hi; };
struct Frame {
    LAS unsigned char* lds;
    volatile LAS unsigned* MISC;
    unsigned* ctl;
    int vcu, G;
    float* out; unsigned char* ws; const float* modb;
};
struct ModRef { const float* modp; const float* modb; const float* modv; };
__device__ __forceinline__ f32x4 modv4(const ModRef& M, int layer, int who, int col  ) {
    const float* p = M.modp + ((size_t)(layer * 3 + who)) * NMODV + col;
    f32x4 s = *(const f32x4*)(M.modb + (size_t)layer * NMODV + col);
#pragma unroll
    for (int q = 0; q < 4; ++q) s += *(const f32x4*)(p + (size_t)q * 6 * NMODV);
    return s;
}
__device__ __forceinline__ f32x4 modvF(const ModRef& M, int layer, int who, int col) { return *(const f32x4*)(M.modv + ((size_t)(layer * 3 + who)) * NMODV + col); }
__device__ __forceinline__ int who_of_row(int r) { return r < SEQ ? 0 : (r < ML ? 1 : 2); }

struct EpiSwiGLU {
    static constexpr bool PERM = true;
    bf16* H;
    __device__ __forceinline__ void operator()(const f32x4 (&acc)[2][2][4][2], const pg8::Unit& u, int wr, int wc, int fr, int fq) const {
        const int rl0 = wr * 64 + fr; const size_t tb = ((size_t)u.pm * HKT + 2 * u.pn + (wc >> 1)) * 16384 + 32 * (wc & 1) + 8 * fq;
#pragma unroll
        for (int ai = 0; ai < 2; ++ai)
#pragma unroll
            for (int m = 0; m < 4; ++m) {
                bf16* rowp = H + tb + (size_t)(rl0 + ai * 128 + m * 16) * 64;
                float h[8];
#pragma unroll
                for (int n = 0; n < 2; ++n)
#pragma unroll
                    for (int e = 0; e < 4; ++e) { const float g = acc[ai][0][m][n][e], up = acc[ai][1][m][n][e]; h[4 * n + e] = g * sigmoidf_(g) * up; }
                v4u w; w.x = pk2(h[0], h[1]); w.y = pk2(h[2], h[3]); w.z = pk2(h[4], h[5]); w.w = pk2(h[6], h[7]);
                *(v4u*)rowp = w;
            }
    }
};
template <bool HAS_BIAS, bool HALF, bool DRY = false> struct EpiResid {
    static constexpr bool PERM = false;
    ModRef MR; const float* baseL; const float* baseC; float* outL; float* outC; const float* bias; int layer, gidx;
    __device__ __forceinline__ void operator()(const f32x4 (&acc)[2][2][4][2], const pg8::Unit& u, int wr, int wc, int fr, int fq) const {
        const int who = u.pm < 64 ? 0 : (u.pm < 128 ? 1 : 2);
        const bool isl = u.pm < 128;
        const int rbase = (isl ? u.pm : u.pm - 128) * 256 + wr * 64 + fr;
        const float* bp = isl ? baseL : baseC; float* op = isl ? outL : outC;
        const int col0 = u.pn * 256 + wc * 32 + 4 * fq;
        f32x4 gv[2][2], bv[2][2];
#pragma unroll
        for (int bj = 0; bj < 2; ++bj)
#pragma unroll
            for (int n = 0; n < 2; ++n) { gv[bj][n] = modvF(MR, layer, who, gidx * D + col0 + bj * 128 + n * 16) * (HALF ? 0.5f : 1.0f);
                bv[bj][n] = (f32x4){0.f, 0.f, 0.f, 0.f}; if (HAS_BIAS) bv[bj][n] = *(const f32x4*)(bias + col0 + bj * 128 + n * 16); }
#pragma unroll
        for (int ai = 0; ai < 2; ++ai) {
            f32x4 bs[4][2][2];
#pragma unroll
            for (int m = 0; m < 4; ++m)
#pragma unroll
                for (int bj = 0; bj < 2; ++bj)
#pragma unroll
                    for (int n = 0; n < 2; ++n) bs[m][bj][n] = *(const f32x4*)(bp + (size_t)(rbase + ai * 128 + m * 16) * D + col0 + bj * 128 + n * 16);
#pragma unroll
            for (int m = 0; m < 4; ++m) asm volatile("" : "+v"(bs[m][0][0]), "+v"(bs[m][0][1]), "+v"(bs[m][1][0]), "+v"(bs[m][1][1]));
#pragma unroll
            for (int m = 0; m < 4; ++m)
#pragma unroll
                for (int bj = 0; bj < 2; ++bj)
#pragma unroll
                    for (int n = 0; n < 2; ++n) { const f32x4 o_ = bs[m][bj][n] + gv[bj][n] * (acc[ai][bj][m][n] + bv[bj][n]);
                        if (!DRY || o_.x == 123456.789f) *(f32x4*)(op + (size_t)(rbase + ai * 128 + m * 16) * D + col0 + bj * 128 + n * 16) = o_; }
            asm volatile("" ::: "memory");
        }
    }
};

template <bool HAS_BIAS, bool HALF, int NX> struct EpiResidNorm {
    static constexpr bool PERM = false;
    ModRef MR; const float* baseL; float* outL; const float* bias; int layer, gidx;
    const float* nw; int nlayer, sidx; bf16* HN; float* RSTD; float* PS; unsigned* cnt; LAS unsigned char* sl;
    __device__ __forceinline__ void operator()(const f32x4 (&acc)[2][2][4][2], const pg8::Unit& u, int wr, int wc, int fr_, int fq_) const {
        int fr = fr_, fq = fq_; asm volatile("" : "+v"(fr), "+v"(fq));
        const int who = u.pm < 64 ? 0 : 1;
        const int rbase = u.pm * 256 + wr * 64 + fr;
        const int col0 = u.pn * 256 + wc * 32 + 4 * fq;
        const unsigned eo0 = (unsigned)(rbase * D + col0) * 4u;
        char* dump = (char*)RSTD + (WS_DUMP - WS_RSTD) + (size_t)blockIdx.x * 65536 + ((wr * 4 + wc) * 64 + fq * 16 + fr) * 16;
        f32x4 xn[2][2][4][2]; float ssq[2][4];
        {
            f32x4 gv[2][2];
#pragma unroll
            for (int bj = 0; bj < 2; ++bj)
#pragma unroll
                for (int n = 0; n < 2; ++n) { gv[bj][n] = modvF(MR, layer, who, gidx * D + col0 + bj * 128 + n * 16) * (HALF ? 0.5f : 1.0f);
                    f32x4 bv = (f32x4){0.f, 0.f, 0.f, 0.f}; if (HAS_BIAS) bv = *(const f32x4*)(bias + col0 + bj * 128 + n * 16);
#pragma unroll
                    for (int ai = 0; ai < 2; ++ai)
#pragma unroll
                        for (int m = 0; m < 4; ++m) { xn[ai][bj][m][n] = acc[ai][bj][m][n]; if (HAS_BIAS) xn[ai][bj][m][n] += bv; } }
#pragma unroll
            for (int ai = 0; ai < 2; ++ai) {
                f32x4 bs[4][2][2];
#pragma unroll
                for (int m = 0; m < 4; ++m)
#pragma unroll
                    for (int bj = 0; bj < 2; ++bj)
#pragma unroll
                        for (int n = 0; n < 2; ++n) bs[m][bj][n] = *(const f32x4*)((const char*)baseL + (size_t)(eo0 + (unsigned)((ai * 128 + m * 16) * D) * 4u) + (bj * 128 + n * 16) * 4);
#pragma unroll
                for (int m = 0; m < 4; ++m) asm volatile("" : "+v"(bs[m][0][0]), "+v"(bs[m][0][1]), "+v"(bs[m][1][0]), "+v"(bs[m][1][1]));
#pragma unroll
                for (int m = 0; m < 4; ++m) { float sq = 0.f;
#pragma unroll
                    for (int bj = 0; bj < 2; ++bj)
#pragma unroll
                        for (int n = 0; n < 2; ++n) { const f32x4 o_ = bs[m][bj][n] + gv[bj][n] * xn[ai][bj][m][n];
                            if (NX != 4) *(f32x4*)((char*)outL + (size_t)(eo0 + (unsigned)((ai * 128 + m * 16) * D) * 4u) + (bj * 128 + n * 16) * 4) = o_;
                            else *(f32x4*)(dump + ((m * 4 + bj * 2 + n) & 7) * 512) = o_;
                            xn[ai][bj][m][n] = o_; sq += (o_.x * o_.x + o_.y * o_.y) + (o_.z * o_.z + o_.w * o_.w); }
                    ssq[ai][m] = sq; }
                asm volatile("" ::: "memory");
            }
        }
        f32x4 a4[2][2], b4[2][2];
        if (NX != 3) {
#pragma unroll
            for (int bj = 0; bj < 2; ++bj)
#pragma unroll
                for (int n = 0; n < 2; ++n) { const int col = col0 + bj * 128 + n * 16;
                    a4[bj][n] = *(const f32x4*)(nw + col); b4[bj][n] = (f32x4){0.f, 0.f, 0.f, 0.f};
                    if (NX != 4) { a4[bj][n] = a4[bj][n] * (modvF(MR, nlayer, who, (sidx + 1) * D + col) + 1.f); b4[bj][n] = modvF(MR, nlayer, who, sidx * D + col); } }
        }
        LAS float* P = (LAS float*)sl; LAS float* RS = P + 1024;
#pragma unroll
        for (int ai = 0; ai < 2; ++ai)
#pragma unroll
            for (int m = 0; m < 4; ++m) { float v = ssq[ai][m]; v += __shfl_xor(v, 16); v += __shfl_xor(v, 32); if (fq == 0) P[wc * 256 + ai * 128 + wr * 64 + m * 16 + fr] = v; }
        LDS_WAIT(); __builtin_amdgcn_s_barrier(); asm volatile("" ::: "memory");
        const int wid = wr * 4 + wc, t = wid * 64 + fq * 16 + fr;
        if (wid < 4) {
            const float v = (P[t] + P[256 + t]) + (P[512 + t] + P[768 + t]);
            unsigned* slot = (unsigned*)PS + (size_t)u.pm * 2048 + t;
            __hip_atomic_store(slot + u.pn * 256, __float_as_uint(v) | 1u, __ATOMIC_RELAXED, __HIP_MEMORY_SCOPE_AGENT);
            float tot = 0.f;
            for (int it = 0; it < (1 << 20); ++it) { unsigned w[8]; bool ok = true;
#pragma unroll
                for (int j = 0; j < 8; ++j) { w[j] = __hip_atomic_load(slot + j * 256, __ATOMIC_RELAXED, __HIP_MEMORY_SCOPE_AGENT); ok = ok && (w[j] != 0u); }
                if (__all(ok)) { tot = ((__uint_as_float(w[0]) + __uint_as_float(w[1])) + (__uint_as_float(w[2]) + __uint_as_float(w[3]))) + ((__uint_as_float(w[4]) + __uint_as_float(w[5])) + (__uint_as_float(w[6]) + __uint_as_float(w[7]))); break; }
                __builtin_amdgcn_s_sleep(1); }
            const float rstd = 1.0f / sqrtf(tot * (1.f / D) + NORM_EPS); RS[t] = rstd;
            if (NX == 3 && u.pn == 0) RSTD[u.pm * 256 + t] = rstd; }
        LDS_WAIT(); __builtin_amdgcn_s_barrier(); asm volatile("" ::: "memory");
        if (NX == 3) return;
        asm volatile("" : "+v"(fr), "+v"(fq));
        const int rl0 = wr * 64 + fr, cb = u.pn * 256 + wc * 32 + 4 * fq;
        float rs[2][4];
#pragma unroll
        for (int ai = 0; ai < 2; ++ai)
#pragma unroll
            for (int m = 0; m < 4; ++m) rs[ai][m] = RS[ai * 128 + m * 16 + rl0];
#pragma unroll
        for (int bj = 0; bj < 2; ++bj)
#pragma unroll
            for (int n = 0; n < 2; ++n) { const int col = cb + bj * 128 + n * 16;
#pragma unroll
                for (int ai = 0; ai < 2; ++ai)
#pragma unroll
                    for (int m = 0; m < 4; ++m) { const int rl = ai * 128 + m * 16 + rl0; const f32x4 o_ = xn[ai][bj][m][n] * rs[ai][m] * a4[bj][n] + b4[bj][n];
                        if (NX == 4) *(f32x4*)((char*)outL + (unsigned)((u.pm * 256 + rl) * D + col) * 4u) = o_;
                        else { f32x2 w; w.x = __uint_as_float(pk2(o_.x, o_.y)); w.y = __uint_as_float(pk2(o_.z, o_.w));
                            if (NX == 1) *(f32x2*)((char*)HN + (unsigned)((u.pm * (D / 64) + (col >> 6)) * 16384 + rl * 64 + (col & 63)) * 2u) = w;
                            else *(f32x2*)((char*)HN + (unsigned)((u.pm * 256 + rl) * D + col) * 2u) = w; } }
                asm volatile("" ::: "memory"); }
    }
};

struct OpHBlk {
    const bf16* base; int pm0, kt0;
    __device__ __forceinline__ const char* tile(const pg8::Unit& u) const { return (const char*)base + ((size_t)(pm0 < 0 ? u.pm : pm0 + (u.pm & 1)) * HKT + (pm0 < 0 ? 0 : (u.pm >> 1) * kt0)) * 32768; }
    __device__ __forceinline__ unsigned voff(int R, int C) const { return (unsigned)(R * 64 + C) * 2u; }
    __device__ __forceinline__ size_t hstep() const { return 16384; }
    __device__ __forceinline__ size_t kstep() const { return 32768; }
};
struct OpBlk {
    const bf16* base; int nkt; bool isA;
    __device__ __forceinline__ const char* tile(const pg8::Unit& u) const { return (const char*)base + (size_t)(isA ? u.pm : u.pn) * nkt * 32768; }
    __device__ __forceinline__ unsigned voff(int R, int C) const { return (unsigned)(R * 64 + C) * 2u; }
    __device__ __forceinline__ size_t hstep() const { return 16384; }
    __device__ __forceinline__ size_t kstep() const { return 32768; }
};
struct OpBlkK {
    const bf16* base; int nkt;
    __device__ __forceinline__ const char* tile(const pg8::Unit& u) const { return (const char*)base + ((size_t)(u.pn & 7) * nkt + (size_t)(u.pn >> 3) * (nkt / 4)) * 32768; }
    __device__ __forceinline__ unsigned voff(int R, int C) const { return (unsigned)(R * 64 + C) * 2u; }
    __device__ __forceinline__ size_t hstep() const { return 16384; }
    __device__ __forceinline__ size_t kstep() const { return 32768; }
};
struct OrderCtxK { int G, c; __device__ __forceinline__ bool next(int i, pg8::Unit& u) const { const int L = i * G + c; if (L >= 64) return false; const int kq = L >> 4; u.pm = (L & 1) + 2 * kq; u.pn = ((L >> 1) & 7) + 8 * kq; return true; } };
struct OpKSplit {
    const bf16* base; int ld, klen; bool isA;
    __device__ __forceinline__ const char* tile(const pg8::Unit& u) const { const int t = isA ? (u.pm & 1) : (u.pn & 7), kq = isA ? (u.pm >> 1) : (u.pn >> 3); return (const char*)base + ((size_t)t * 256 * ld + (size_t)kq * klen) * 2; }
    __device__ __forceinline__ unsigned voff(int R, int C) const { return (unsigned)(R * ld + C) * 2u; }
    __device__ __forceinline__ size_t hstep() const { return (size_t)128 * ld * 2; }
    __device__ __forceinline__ size_t kstep() const { return 128; }
};
template <bool HAS_BIAS, bool HALF> struct EpiCtxAtomic {
    static constexpr bool PERM = false;
    ModRef MR; float* XC; const float* bias; int layer, gidx;
    __device__ __forceinline__ void operator()(const f32x4 (&acc)[2][2][4][2], const pg8::Unit& u, int wr, int wc, int fr, int fq) const {
        const int panel = u.pm & 1, ct = u.pn & 7, kq = u.pn >> 3;
        const int rbase = panel * 256 + wr * 64 + fr, col0 = ct * 256 + wc * 32 + 4 * fq;
#pragma unroll
        for (int bj = 0; bj < 2; ++bj)
#pragma unroll
            for (int n = 0; n < 2; ++n) {
                const f32x4 gv = modvF(MR, layer, 2, gidx * D + col0 + bj * 128 + n * 16) * (HALF ? 0.5f : 1.0f);
                f32x4 bv = {0.f, 0.f, 0.f, 0.f}; if (HAS_BIAS) { if (kq == 0) bv = *(const f32x4*)(bias + col0 + bj * 128 + n * 16); }
#pragma unroll
                for (int ai = 0; ai < 2; ++ai)
#pragma unroll
                    for (int m = 0; m < 4; ++m) { float* op = XC + (size_t)(rbase + ai * 128 + m * 16) * D + col0 + bj * 128 + n * 16; const f32x4 v = gv * (acc[ai][bj][m][n] + bv);
#pragma unroll
                        for (int e = 0; e < 4; ++e) (void)__hip_atomic_fetch_add(op + e, v[e], __ATOMIC_RELAXED, __HIP_MEMORY_SCOPE_AGENT); }
            }
    }
};

struct OpFixed {
    const bf16* base; int ld; int alt;
    __device__ __forceinline__ const char* tile(const pg8::Unit& u) const { return (const char*)base + (size_t)(alt ? (u.pm & 1) : 0) * 256 * ld * 2; }
    __device__ __forceinline__ unsigned voff(int R, int C) const { return (unsigned)(R * ld + C) * 2u; }
    __device__ __forceinline__ size_t hstep() const { return (size_t)128 * ld * 2; }
    __device__ __forceinline__ size_t kstep() const { return 128; }
};
struct OpChanL {
    const bf16* hn;
    __device__ __forceinline__ const char* tile(const pg8::Unit& u) const { return (const char*)hn + ((size_t)((u.pn >> 6) * SEQ + 2 * (u.pn & 63)) * D + (u.pm >> 1) * 256) * 2; }
    __device__ __forceinline__ unsigned voff(int R, int C) const { return (unsigned)(128 * R * D + C) * 2u; }
    __device__ __forceinline__ size_t hstep() const { return (size_t)D * 2; }
    __device__ __forceinline__ size_t kstep() const { return 128; }
};
struct OpChanC {
    const bf16* hn;
    __device__ __forceinline__ const char* tile(const pg8::Unit& u) const { return (const char*)hn + ((size_t)(ML + u.pn * CTXL) * D + (u.pm >> 1) * 256) * 2; }
    __device__ __forceinline__ unsigned voff(int R, int C) const { return (unsigned)(R * D + C) * 2u; }
    __device__ __forceinline__ size_t hstep() const { return (size_t)128 * D * 2; }
    __device__ __forceinline__ size_t kstep() const { return 128; }
};
struct OpStage2B {
    const bf16* T2;
    __device__ __forceinline__ const char* tile(const pg8::Unit& u) const { return (const char*)T2 + ((size_t)(u.pn >> 7) * 256 * 128 + (u.pn & 127)) * 512; }
    __device__ __forceinline__ unsigned voff(int R, int C) const { return (unsigned)R * 65536u + (unsigned)C * 2u; }
    __device__ __forceinline__ size_t hstep() const { return (size_t)128 * 65536; }
    __device__ __forceinline__ size_t kstep() const { return 128; }
};
__device__ __forceinline__ v4u pack8(const f32x4& a, const f32x4& b) { v4u w; w.x = pk2(a.x, a.y); w.y = pk2(a.z, a.w); w.z = pk2(b.x, b.y); w.w = pk2(b.z, b.w); return w; }
struct EpiChanL {
    static constexpr bool PERM = true; bf16* YT;
    __device__ __forceinline__ void operator()(const f32x4 (&acc)[2][2][4][2], const pg8::Unit& u, int wr, int wc, int fr, int fq) const {
        const int g = u.pm >> 1, cs = u.pm & 1, b = u.pn >> 6, n2p = u.pn & 63;
#pragma unroll
        for (int ai = 0; ai < 2; ++ai)
#pragma unroll
            for (int m = 0; m < 4; ++m) { const int kc = 128 * ai + 64 * wr + 16 * m + fr;
#pragma unroll
                for (int bj = 0; bj < 2; ++bj) { const unsigned idx = ((((unsigned)(b * 8 + g) * 256u + kc) * 128u + (2 * n2p + bj)) * 2u + cs) * 128u + 32 * wc + 8 * fq;
                    *(v4u*)((char*)YT + (size_t)(idx * 2u)) = pack8(acc[ai][bj][m][0], acc[ai][bj][m][1]); }
                asm volatile("" ::: "memory"); }
    }
};
struct EpiChanC {
    static constexpr bool PERM = true; bf16* YC;
    __device__ __forceinline__ void operator()(const f32x4 (&acc)[2][2][4][2], const pg8::Unit& u, int wr, int wc, int fr, int fq) const {
        const int g = u.pm >> 1, cs = u.pm & 1, b = u.pn;
#pragma unroll
        for (int ai = 0; ai < 2; ++ai)
#pragma unroll
            for (int m = 0; m < 4; ++m) { const int kc = 128 * ai + 64 * wr + 16 * m + fr;
#pragma unroll
                for (int bj = 0; bj < 2; ++bj) { const unsigned idx = (((unsigned)(b * 8 + g) * 256u + kc) * 2u + cs) * 256u + 128 * bj + 32 * wc + 8 * fq;
                    *(v4u*)((char*)YC + (size_t)(idx * 2u)) = pack8(acc[ai][bj][m][0], acc[ai][bj][m][1]); }
                asm volatile("" ::: "memory"); }
    }
};
struct EpiStage1 {
    static constexpr bool PERM = true; bf16* T2; const float* tw;
    __device__ __forceinline__ void operator()(const f32x4 (&acc)[2][2][4][2], const pg8::Unit& u, int wr, int wc, int fr, int fq) const {
#pragma unroll
        for (int m = 0; m < 4; ++m) { const int k1 = 64 * wr + 16 * m + fr, n20 = 32 * wc + 8 * fq;
#pragma unroll
            for (int n = 0; n < 2; ++n) {
                const f32x4 t0 = *(const f32x4*)((const char*)tw + (size_t)((unsigned)(k1 * 128 + n20 + 4 * n) * 8u));
                const f32x4 t1 = *(const f32x4*)((const char*)tw + (size_t)((unsigned)(k1 * 128 + n20 + 4 * n) * 8u + 16u));
#pragma unroll
                for (int bj = 0; bj < 2; ++bj) { const int chq = 2 * u.pn + bj;
                    const f32x4 tr = acc[0][bj][m][n], ti = acc[1][bj][m][n];
                    const f32x4 c = {t0.x, t0.z, t1.x, t1.z}, sn = {t0.y, t0.w, t1.y, t1.w};
                    const f32x4 ur = tr * c - ti * sn, ui = tr * sn + ti * c;
                    const unsigned idx = (((unsigned)chq * 128u + k1) * 2u) * 128u + n20 + 4 * n;
                    v2u w0; w0.x = pk2(ur.x, ur.y); w0.y = pk2(ur.z, ur.w); v2u w1; w1.x = pk2(ui.x, ui.y); w1.y = pk2(ui.z, ui.w);
                    *(v2u*)((char*)T2 + (size_t)(idx * 2u)) = w0; *(v2u*)((char*)T2 + (size_t)(idx * 2u + 256u)) = w1; }
                asm volatile("" ::: "memory"); } }
    }
};
struct EpiStage2 {
    static constexpr bool PERM = true; bf16* FO;
    __device__ __forceinline__ void operator()(const f32x4 (&acc)[2][2][4][2], const pg8::Unit& u, int wr, int wc, int fr, int fq) const {
        const int bg = u.pn >> 7, k1 = u.pn & 127, b = bg >> 3, g = bg & 7;
#pragma unroll
        for (int m = 0; m < 4; ++m) { const int k2 = 64 * wr + 16 * m + fr; const unsigned row = (unsigned)b * SEQ + k1 + 128 * k2;
#pragma unroll
            for (int bj = 0; bj < 2; ++bj) *(v4u*)((char*)FO + (size_t)((row * D + g * 256 + 128 * bj + 32 * wc + 8 * fq) * 2u)) = pack8(acc[0][bj][m][0], acc[0][bj][m][1]);
            asm volatile("" ::: "memory"); }
    }
};
struct EpiCtxDft {
    static constexpr bool PERM = true; bf16* FO;
    __device__ __forceinline__ void operator()(const f32x4 (&acc)[2][2][4][2], const pg8::Unit& u, int wr, int wc, int fr, int fq) const {
        const int b = u.pn >> 3, g = u.pn & 7;
#pragma unroll
        for (int ai = 0; ai < 2; ++ai)
#pragma unroll
            for (int m = 0; m < 4; ++m) { const int k = 128 * ai + 64 * wr + 16 * m + fr; const unsigned row = (unsigned)ML + b * CTXL + k;
#pragma unroll
                for (int bj = 0; bj < 2; ++bj) *(v4u*)((char*)FO + (size_t)((row * D + g * 256 + 128 * bj + 32 * wc + 8 * fq) * 2u)) = pack8(acc[ai][bj][m][0], acc[ai][bj][m][1]);
                asm volatile("" ::: "memory"); }
    }
};

struct OpXM {
    const bf16* base; int div, add;
    __device__ __forceinline__ const char* tile(const pg8::Unit& u) const { return (const char*)base + (size_t)(add + u.pn / div) * XM_STRIDE + (size_t)u.pm * 256 * D * 2; }
    __device__ __forceinline__ unsigned voff(int R, int C) const { return (unsigned)(R * D + C) * 2u; }
    __device__ __forceinline__ size_t hstep() const { return (size_t)128 * D * 2; }
    __device__ __forceinline__ size_t kstep() const { return 128; }
};
struct OpWSel {
    const bf16* base; int div; size_t stride;
    __device__ __forceinline__ const char* tile(const pg8::Unit& u) const { return (const char*)base + (size_t)(u.pn / div) * stride + (size_t)(u.pn % div) * 256 * D * 2; }
    __device__ __forceinline__ unsigned voff(int R, int C) const { return (unsigned)(R * D + C) * 2u; }
    __device__ __forceinline__ size_t hstep() const { return (size_t)128 * D * 2; }
    __device__ __forceinline__ size_t kstep() const { return 128; }
};
struct EpiLora {
    static constexpr bool PERM = true; bf16* LR;
    __device__ __forceinline__ void operator()(const f32x4 (&acc)[2][2][4][2], const pg8::Unit& u, int wr, int wc, int fr, int fq) const {
        const int which = u.pn; bf16* O = (bf16*)((char*)LR + (size_t)which * LR_STRIDE);
#pragma unroll
        for (int ai = 0; ai < 2; ++ai)
#pragma unroll
            for (int m = 0; m < 4; ++m) { const unsigned row = u.pm * 256 + 128 * ai + 64 * wr + 16 * m + fr;
#pragma unroll
                for (int bj = 0; bj < 2; ++bj) { f32x4 a = acc[ai][bj][m][0], b = acc[ai][bj][m][1];
                    if (which == 0) {
#pragma unroll
                        for (int e = 0; e < 4; ++e) { a[e] = 1.f - 2.f * __builtin_amdgcn_rcpf(1.f + __expf(2.f * a[e])); b[e] = 1.f - 2.f * __builtin_amdgcn_rcpf(1.f + __expf(2.f * b[e])); } }
                    else if (which == 2) {
#pragma unroll
                        for (int e = 0; e < 4; ++e) { a[e] = sigmoidf_(a[e]); b[e] = sigmoidf_(b[e]); } }
                    *(v4u*)((char*)O + (size_t)((row * 256u + 128 * bj + 32 * wc + 8 * fq) * 2u)) = pack8(a, b); }
                asm volatile("" ::: "memory"); }
    }
};
struct EpiRkv {
    static constexpr bool PERM = true; bf16* XM;
    __device__ __forceinline__ void operator()(const f32x4 (&acc)[2][2][4][2], const pg8::Unit& u, int wr, int wc, int fr, int fq) const {
        char* O = (char*)XM + (size_t)(3 + u.pn / 8) * XM_STRIDE; const int colt = (u.pn % 8) * 256;
#pragma unroll
        for (int ai = 0; ai < 2; ++ai)
#pragma unroll
            for (int m = 0; m < 4; ++m) { const unsigned row = u.pm * 256 + 128 * ai + 64 * wr + 16 * m + fr;
#pragma unroll
                for (int bj = 0; bj < 2; ++bj) *(v4u*)(O + (size_t)((row * D + colt + 128 * bj + 32 * wc + 8 * fq) * 2u)) = pack8(acc[ai][bj][m][0], acc[ai][bj][m][1]);
                asm volatile("" ::: "memory"); }
    }
};
struct EpiRkvC {
    static constexpr bool PERM = true; bf16* O;
    __device__ __forceinline__ void operator()(const f32x4 (&acc)[2][2][4][2], const pg8::Unit& u, int wr, int wc, int fr, int fq) const {
        char* Op = (char*)O + (size_t)(u.pn / 8) * MC * D * 2; const int colt = (u.pn % 8) * 256;
#pragma unroll
        for (int ai = 0; ai < 2; ++ai)
#pragma unroll
            for (int m = 0; m < 4; ++m) { const unsigned row = (u.pm - 128) * 256 + 128 * ai + 64 * wr + 16 * m + fr;
#pragma unroll
                for (int bj = 0; bj < 2; ++bj) *(v4u*)(Op + (size_t)((row * D + colt + 128 * bj + 32 * wc + 8 * fq) * 2u)) = pack8(acc[ai][bj][m][0], acc[ai][bj][m][1]);
                asm volatile("" ::: "memory"); }
    }
};
struct EpiCombGate {
    static constexpr bool PERM = true;
    bf16* PO; const bf16* YB0; const bf16* YB1; const bf16* VP; const float* SA; const float* lnw; const float* lnb; LAS unsigned char* sl;
    __device__ __forceinline__ void operator()(const f32x4 (&acc)[2][2][4][2], const pg8::Unit& u, int wr, int wc, int fr_, int fq_) const {
        int tl = threadIdx.x; asm volatile("" : "+v"(tl)); int fr = tl & 15, fq = (tl >> 4) & 3; (void)fr_; (void)fq_;
        const int wid = wr * 4 + wc;
#pragma unroll
        for (int ai = 0; ai < 2; ++ai)
#pragma unroll
            for (int bj = 0; bj < 2; ++bj) {
                const int c0 = u.pn * 256 + 128 * bj + 32 * wc + 8 * fq, hd = c0 >> 6, r0 = u.pm * 256 + 128 * ai + 64 * wr + fr;
                v4u ya[4], yb[4], vv[4]; float sbv[4];
#pragma unroll
                for (int m = 0; m < 4; ++m) { const unsigned o = (unsigned)((r0 + 16 * m) * D + c0) * 2u;
                    ya[m] = *(const v4u*)((const char*)YB0 + o); yb[m] = *(const v4u*)((const char*)YB1 + o);
                    sbv[m] = 0.5f * (*(const float*)((const char*)SA + (unsigned)(((r0 + 16 * m) * 32 + hd) * 4)) + *(const float*)((const char*)SA + (unsigned)(((MT + r0 + 16 * m) * 32 + hd) * 4))); }
                float y[4][8], ma[4], m2[4];
#pragma unroll
                for (int m = 0; m < 4; ++m) { const unsigned aw[4] = {ya[m].x, ya[m].y, ya[m].z, ya[m].w}, bw[4] = {yb[m].x, yb[m].y, yb[m].z, yb[m].w};
#pragma unroll
                    for (int e = 0; e < 4; ++e) { y[m][2 * e] = bflo(aw[e]) + bflo(bw[e]); y[m][2 * e + 1] = bfhi(aw[e]) + bfhi(bw[e]); } }
#pragma unroll
                for (int m = 0; m < 4; ++m) { asm volatile("" : "+v"(y[m][0]), "+v"(y[m][1]), "+v"(y[m][2]), "+v"(y[m][3]), "+v"(y[m][4]), "+v"(y[m][5]), "+v"(y[m][6]), "+v"(y[m][7]));
                    vv[m] = *(const v4u*)((const char*)VP + (unsigned)((r0 + 16 * m) * D + c0) * 2u); }
#pragma unroll
                for (int m = 0; m < 4; ++m) { float sm = 0.f;
#pragma unroll
                    for (int i = 0; i < 8; ++i) sm += y[m][i];
                    sm += __shfl_xor(sm, 16); sm += __shfl_xor(sm, 32); ma[m] = sm * (1.f / 32.f); float sq = 0.f;
#pragma unroll
                    for (int i = 0; i < 8; ++i) { const float dl = y[m][i] - ma[m]; sq += dl * dl; }
                    sq += __shfl_xor(sq, 16); sq += __shfl_xor(sq, 32); m2[m] = sq; }
                LAS f32x2* P = (LAS f32x2*)(sl + ((ai * 2 + bj) & 1) * 4096);
                if (fq == 0) {
#pragma unroll
                    for (int m = 0; m < 4; ++m) P[(wid * 4 + m) * 16 + fr] = (f32x2){ma[m], m2[m]}; }
                LDS_WAIT(); __builtin_amdgcn_s_barrier(); asm volatile("" ::: "memory");
                asm volatile("" : "+v"(tl)); const int fr2 = tl & 15, fq2 = (tl >> 4) & 3, c1 = u.pn * 256 + 128 * bj + 32 * wc + 8 * fq2, r1 = u.pm * 256 + 128 * ai + 64 * wr + fr2;
                const f32x4 l0 = *(const f32x4*)(lnw + c1), l1 = *(const f32x4*)(lnw + c1 + 4), g0 = *(const f32x4*)(lnb + c1), g1 = *(const f32x4*)(lnb + c1 + 4);
                const float lw_[8] = {l0.x, l0.y, l0.z, l0.w, l1.x, l1.y, l1.z, l1.w}, lb_[8] = {g0.x, g0.y, g0.z, g0.w, g1.x, g1.y, g1.z, g1.w};
#pragma unroll
                for (int m = 0; m < 4; ++m) { const f32x2 pp = P[((wid ^ 1) * 4 + m) * 16 + fr2];
                    const float mean = 0.5f * (ma[m] + pp.x), dm = ma[m] - pp.x, var = (m2[m] + pp.y + 16.f * dm * dm) * (1.f / 64.f);
                    const float rstd = 1.0f / sqrtf(var + GN_EPS), sb = sbv[m];
                    const unsigned vw[4] = {vv[m].x, vv[m].y, vv[m].z, vv[m].w}; const f32x4 ga = acc[ai][bj][m][0], gb = acc[ai][bj][m][1]; const float gt[8] = {ga.x, ga.y, ga.z, ga.w, gb.x, gb.y, gb.z, gb.w};
                    float o[8];
#pragma unroll
                    for (int e = 0; e < 4; ++e) { o[2 * e] = ((y[m][2 * e] - mean) * rstd * lw_[2 * e] + lb_[2 * e] + sb * bflo(vw[e])) * gt[2 * e];
                        o[2 * e + 1] = ((y[m][2 * e + 1] - mean) * rstd * lw_[2 * e + 1] + lb_[2 * e + 1] + sb * bfhi(vw[e])) * gt[2 * e + 1]; }
                    v4u w_; w_.x = pk2(o[0], o[1]); w_.y = pk2(o[2], o[3]); w_.z = pk2(o[4], o[5]); w_.w = pk2(o[6], o[7]);
                    *(v4u*)((char*)PO + (unsigned)((r1 + 16 * m) * D + c1) * 2u) = w_; }
                asm volatile("" ::: "memory");
            }
    }
};
template <bool DRY = false> struct EpiMulG {
    static constexpr bool PERM = true; bf16* PO;
    __device__ __forceinline__ void operator()(const f32x4 (&acc)[2][2][4][2], const pg8::Unit& u, int wr, int wc, int fr, int fq) const {
#pragma unroll
        for (int ai = 0; ai < 2; ++ai)
#pragma unroll
            for (int m = 0; m < 4; ++m) { const unsigned row = u.pm * 256 + 128 * ai + 64 * wr + 16 * m + fr;
#pragma unroll
                for (int bj = 0; bj < 2; ++bj) { v4u* ptr = (v4u*)((char*)PO + (size_t)((row * D + u.pn * 256 + 128 * bj + 32 * wc + 8 * fq) * 2u));
                    const v4u o = *ptr; const f32x4 a = acc[ai][bj][m][0], b = acc[ai][bj][m][1];
                    v4u w; w.x = pk2(bflo(o.x) * a.x, bfhi(o.x) * a.y); w.y = pk2(bflo(o.y) * a.z, bfhi(o.y) * a.w); w.z = pk2(bflo(o.z) * b.x, bfhi(o.z) * b.y); w.w = pk2(bflo(o.w) * b.z, bfhi(o.w) * b.w);
                    if (!DRY || w.x == 0x12345678u) *ptr = w; }
                asm volatile("" ::: "memory"); }
    }
};

__device__ __forceinline__ void phase_rowstats(Frame& F, const float* xl, const float* xc, float* RSTD, int r0) {
    int tid_ = threadIdx.x; asm volatile("" : "+v"(tid_)); const int LANE = tid_ & 63, WAVE = __builtin_amdgcn_readfirstlane(tid_ >> 6);
    const int gw = F.vcu * NWAVES + WAVE, NGW = F.G * NWAVES;
    for (int r = r0 + gw; r < MT; r += NGW) {
        const float* xr = r < ML ? xl + (size_t)r * D : xc + (size_t)(r - ML) * D; float ss = 0.f;
#pragma unroll
        for (int j = 0; j < 8; ++j) { const f32x4 v = *(const f32x4*)(xr + 256 * j + 4 * LANE); ss += (v.x * v.x + v.y * v.y) + (v.z * v.z + v.w * v.w); }
        const float rstd = 1.0f / sqrtf(wave_sum(ss) * (1.f / D) + NORM_EPS);
        if (LANE == 0) RSTD[r] = rstd;
    }
}
__device__ __forceinline__ void phase_mix(Frame& F, const ModRef& MR, const float* xl, const float* xc, const float* RSTD, const float* nw, const float* mu, bf16* XM) {
    int tid_ = threadIdx.x; asm volatile("" : "+v"(tid_)); const int TID = tid_, LANE = tid_ & 63, WAVE = __builtin_amdgcn_readfirstlane(tid_ >> 6);
    LAS float* TA = (LAS float*)(F.lds); LAS float* TB = (LAS float*)(F.lds + 24576); LAS float* TM = (LAS float*)(F.lds + 49152);
    for (int i = TID; i < 3 * D / 4; i += NWAVES * 64) { const int who = i / (D / 4), d = (i % (D / 4)) * 4;
        const f32x4 sh = modvF(MR, 1, who, 3 * D + d), sc = modvF(MR, 1, who, 4 * D + d), g = *(const f32x4*)(nw + d);
        *(LAS f32x4*)(TA + who * D + d) = g * (sc + 1.f); *(LAS f32x4*)(TB + who * D + d) = sh; }
    for (int i = TID; i < 6 * D / 4; i += NWAVES * 64) *(LAS f32x4*)(TM + 4 * i) = *(const f32x4*)(mu + 4 * i);
    __syncthreads();
    const int gw = F.vcu * NWAVES + WAVE, NGW = F.G * NWAVES;
    for (int r = gw; r < MT; r += NGW) {
        const int who = who_of_row(r);
        const bool isl = r < ML; const int t = isl ? (r & (SEQ - 1)) : ((r - ML) & (CTXL - 1));
        const float* xr = isl ? xl + (size_t)r * D : xc + (size_t)(r - ML) * D;
        const float rs = RSTD[r];
#pragma unroll
        for (int j = 0; j < 4; ++j) {
            int dt; bool ok;
            if (isl) { const int gx = t & 63, gy = t >> 6; if (j == 0) { dt = -1; ok = gx > 0; } else if (j == 1) { dt = 1; ok = gx < 63; } else if (j == 2) { dt = -64; ok = gy > 0; } else { dt = 64; ok = gy < SEQ / 64 - 1; } }
            else { if ((j & 1) == 0) { dt = -1; ok = t > 0; } else { dt = 1; ok = t < CTXL - 1; } }
            const int d = 512 * j + 8 * LANE;
            const f32x4 a0 = *(const LAS f32x4*)(TA + who * D + d), a1 = *(const LAS f32x4*)(TA + who * D + d + 4), b0 = *(const LAS f32x4*)(TB + who * D + d), b1 = *(const LAS f32x4*)(TB + who * D + d + 4);
            const f32x4 x0 = *(const f32x4*)(xr + d), x1 = *(const f32x4*)(xr + d + 4);
            const f32x4 h0 = x0 * rs * a0 + b0, h1 = x1 * rs * a1 + b1;
            f32x4 s0 = {0.f, 0.f, 0.f, 0.f}, s1 = s0;
            if (ok) { const float rn = RSTD[r + dt]; const float* xn = xr + (ptrdiff_t)dt * D; const f32x4 y0 = *(const f32x4*)(xn + d), y1 = *(const f32x4*)(xn + d + 4); s0 = y0 * rn * a0 + b0; s1 = y1 * rn * a1 + b1; }
            const f32x4 d0 = s0 - h0, d1 = s1 - h1;
#pragma unroll
            for (int p = 0; p < 6; ++p) { const f32x4 m0 = *(const LAS f32x4*)(TM + p * D + d), m1 = *(const LAS f32x4*)(TM + p * D + d + 4);
                *(v4u*)((char*)XM + (size_t)p * XM_STRIDE + ((size_t)r * D + d) * 2) = pack8(h0 + d0 * m0, h1 + d1 * m1); }
        }
    }
}

constexpr int SCAN_BLK = 12544, SC_WQ = 80, SCAN_NW = 14;
constexpr int SC_NSLOT = 4, SC_SLOT = SCAN_BLK;
constexpr int SC_NPROD_A = 5, SC_NPROD_B = 8, SC_QA = 24, SC_QA0 = 6;
constexpr int SC_WF = 0, SC_CONST = 24576, SC_CTL = SC_CONST + 1280, SC_RING = SC_CTL + 128, SC_PROD_A = SC_RING + SC_NSLOT * SC_SLOT, SC_PROD_B = SC_RING, SC_PSTRIDE = 14592;
constexpr int BLK_AR = 0, BLK_G = 4096, BLK_BK = 6144, BLK_VF = 10240, BLK_PCF = 12288;
static_assert(SC_PROD_A + SC_NPROD_A * SC_PSTRIDE <= LDSCTL_OFF && SC_PROD_B + SC_NPROD_B * SC_PSTRIDE <= LDSCTL_OFF && 4608 + 3072 <= 8192 && 8192 + 6400 <= SC_PSTRIDE, "scan LDS map");
__device__ __forceinline__ int scan_row(int b, int z, int s) { if (s < CTXL) return ML + b * CTXL + (z ? CTXL - 1 - s : s); const int sp = s - CTXL; return b * SEQ + (z ? SEQ - 1 - sp : sp); }
__device__ __forceinline__ int sc_chain(int b) { return ((b & 7) | ((b >> 4) << 3)) & 127; }
__device__ __forceinline__ int sc_half(int b) { return (b >> 3) & 1; }
__device__ __forceinline__ int win_lo(int w) { return w == 0 ? 0 : 16 + SC_WQ * (w - 1); }
__device__ __forceinline__ int win_n(int w) { return w == 0 ? 16 : (w == SCAN_NW - 1 ? 1024 - SC_WQ * (SCAN_NW - 2) : SC_WQ); }
template <int N> __device__ __forceinline__ float dpp_row_shr(float v) { return __int_as_float(__builtin_amdgcn_update_dpp(0, __float_as_int(v), 0x110 + N, 0xf, 0xf, true)); }
__device__ __forceinline__ bf16x8 pack_frag(float a0, float a1, float a2, float a3, float a4, float a5, float a6, float a7) { v4u w; w.x = pk2(a0, a1); w.y = pk2(a2, a3); w.z = pk2(a4, a5); w.w = pk2(a6, a7); return __builtin_bit_cast(bf16x8, w); }
#define MFMA32(a, b, c) __builtin_amdgcn_mfma_f32_32x32x16_bf16((a), (b), (c), 0, 0, 0)
#define MFMA16(a, b, c) __builtin_amdgcn_mfma_f32_16x16x32_bf16((a), (b), (c), 0, 0, 0)

__device__ __forceinline__ void scan_setup(const Frame& F, const Args& AR, int tid) {
    const int chain = sc_chain(blockIdx.x), h = (chain >> 1) & 31, z = chain & 1;
    const bf16* W2UP = (const bf16*)(F.ws + WS_WSMALL + WSM_W2UP); const bf16* A2UP = (const bf16*)(F.ws + WS_WSMALL + WSM_A2UP);
    for (int i = tid; i < 2 * 12 * 64; i += NWAVES * 64) { const int which = i / 768, f = (i / 64) % 12, ln = i & 63, ks = f >> 2, mt = f & 3, tau = ln & 15, g = ln >> 4;
        *(LAS v4u*)(F.lds + SC_WF + i * 16) = *(const v4u*)((which ? A2UP : W2UP) + ((size_t)(z * D + h * 64 + 16 * mt + tau)) * LORA + 32 * ks + 8 * g); }
    for (int i = tid; i < 5 * 64; i += NWAVES * 64) { const int k = i / 64, c = h * 64 + (i & 63);
        ((LAS float*)(F.lds + SC_CONST))[i] = k == 0 ? AR.in[13][z * D + c] : k == 1 ? AR.in[16][z * D + c] : k == 2 ? AR.in[21][c] : k == 3 ? AR.in[22][c] : AR.in[23][c]; }
}
__device__ __forceinline__ void scan_produce(const Frame& F, int w, int pw, int lane_in, bool isA) {
    int lane = lane_in;
    LAS unsigned char* scr = F.lds + (isA ? SC_PROD_A : SC_PROD_B) + pw * SC_PSTRIDE;
    const int nq = win_n(w), lo = win_lo(w), qa = (nq == 16) ? SC_QA0 : (nq * 3) / 8;
    const int nhalf = isA ? qa : nq - qa;
    const bf16* RKV = (const bf16*)(F.ws + WS_ACT + ACT_XM + 3 * XM_STRIDE);
    const bf16* TWb = (const bf16*)(F.ws + WS_ACT + ACT_LR); const bf16* TAb = (const bf16*)(F.ws + WS_ACT + ACT_LR + LR_STRIDE);
    unsigned char* wbuf = F.ws + WS_ACT + ACT_WBUF + (size_t)(w & 1) * WBUF_STRIDE;
    float* SA = (float*)(F.ws + WS_SA);
    const int chain = sc_chain(blockIdx.x), b = chain >> 6, h = (chain >> 1) & 31, z = chain & 1, q0 = isA ? 0 : qa;
    if (blockIdx.x >= 256) return;
    v2u r2n[4], k2n[4], v2n[4]; bf16x8 bwn[3], ban[3];
    const bf16* RK0 = w == 0 ? (const bf16*)(F.ws + WS_RKVC) - (size_t)ML * D : RKV; const size_t RKS = w == 0 ? (size_t)MC * D : (size_t)MT * D;
#define SC_LOADS(qq) do { const int row_ = scan_row(b, z, (lo + (qq)) * 16 + (lane & 15)); \
        const unsigned ob_ = ((unsigned)row_ * D + h * 64 + 4 * (lane >> 4)) * 2u, ol_ = ((unsigned)row_ * 256 + z * 96 + 8 * (lane >> 4)) * 2u; \
        _Pragma("unroll") for (int mt = 0; mt < 4; ++mt) { \
            r2n[mt] = *(const v2u*)((const char*)RK0 + (size_t)(ob_ + 32u * mt)); k2n[mt] = *(const v2u*)((const char*)(RK0 + RKS) + (size_t)(ob_ + 32u * mt)); v2n[mt] = *(const v2u*)((const char*)(RK0 + 2 * RKS) + (size_t)(ob_ + 32u * mt)); } \
        _Pragma("unroll") for (int ks = 0; ks < 3; ++ks) { bwn[ks] = *(const bf16x8*)((const char*)TWb + (size_t)(ol_ + 64u * ks)); ban[ks] = *(const bf16x8*)((const char*)TAb + (size_t)(ol_ + 64u * ks)); } } while (0)
    volatile LAS unsigned* tctr = (volatile LAS unsigned*)(F.lds + SC_CTL + 8);
#define SC_GRAB() ({ unsigned v_ = 0; if (lane == 0) v_ = __hip_atomic_fetch_add((LAS unsigned*)(F.lds + SC_CTL + 8), 1u, __ATOMIC_RELAXED, __HIP_MEMORY_SCOPE_WORKGROUP); (int)__builtin_amdgcn_readfirstlane(v_); })
    int qi = pw, qn = SC_GRAB();
    (void)tctr;
    if (qi < nhalf) SC_LOADS(q0 + qi);
#pragma unroll 1
    for (; qi < nhalf; qi = qn, qn = SC_GRAB()) {
        asm volatile("" : "+v"(lane));
        const int tau = lane & 15, g = lane >> 4;
        const int q = q0 + qi;
        const int row = scan_row(b, z, (lo + q) * 16 + tau);
        unsigned char* blk = wbuf + ((size_t)chain * SC_WQ + q) * SCAN_BLK;
        v2u r2[4], k2[4], v2[4]; bf16x8 bw[3], ba[3];
#pragma unroll
        for (int mt = 0; mt < 4; ++mt) { r2[mt] = r2n[mt]; k2[mt] = k2n[mt]; v2[mt] = v2n[mt]; }
#pragma unroll
        for (int ks = 0; ks < 3; ++ks) { bw[ks] = bwn[ks]; ba[ks] = ban[ks]; }
        if (qn < nhalf) SC_LOADS(q0 + qn);
        f32x4 lw[4], la[4];
#pragma unroll
        for (int mt = 0; mt < 4; ++mt) { lw[mt] = (f32x4){0.f, 0.f, 0.f, 0.f}; la[mt] = lw[mt]; }
        {
            bf16x8 wf[12];
#pragma unroll
            for (int f_ = 0; f_ < 12; ++f_) wf[f_] = *(const LAS bf16x8*)(F.lds + SC_WF + (f_ * 64 + lane) * 16);
            asm volatile("" : "+v"(wf[0]), "+v"(wf[1]), "+v"(wf[2]), "+v"(wf[3]), "+v"(wf[4]), "+v"(wf[5]), "+v"(wf[6]), "+v"(wf[7]), "+v"(wf[8]), "+v"(wf[9]), "+v"(wf[10]), "+v"(wf[11]));
            bf16x8 af[12];
#pragma unroll
            for (int f_ = 0; f_ < 12; ++f_) af[f_] = *(const LAS bf16x8*)(F.lds + SC_WF + ((12 + f_) * 64 + lane) * 16);
#pragma unroll
            for (int ks = 0; ks < 3; ++ks)
#pragma unroll
                for (int mt = 0; mt < 4; ++mt) lw[mt] = MFMA16(wf[ks * 4 + mt], bw[ks], lw[mt]);
            asm volatile("" : "+v"(af[0]), "+v"(af[1]), "+v"(af[2]), "+v"(af[3]), "+v"(af[4]), "+v"(af[5]), "+v"(af[6]), "+v"(af[7]), "+v"(af[8]), "+v"(af[9]), "+v"(af[10]), "+v"(af[11]));
#pragma unroll
            for (int ks = 0; ks < 3; ++ks)
#pragma unroll
                for (int mt = 0; mt < 4; ++mt) la[mt] = MFMA16(af[ks * 4 + mt], ba[ks], la[mt]);
        }
        LAS unsigned char* Xs = scr; LAS unsigned char* Ys = scr + 4096;
        LAS bf16* BKs = (LAS bf16*)(scr + 8192); LAS bf16* VFs = (LAS bf16*)(scr + 8192 + 4096); LAS float* PCs = (LAS float*)(scr + 8192 + 6144);
        float lnw[16], asg[16], kk[16], kd[16]; float ss = 0.f, sap = 0.f;
        f32x4 cw0[4], ca0[4], ckk[4], cka[4], crk[4];
#pragma unroll
        for (int mt = 0; mt < 4; ++mt) { const LAS float* cst = (const LAS float*)(F.lds + SC_CONST) + 16 * mt + 4 * g;
            cw0[mt] = *(const LAS f32x4*)(cst); ca0[mt] = *(const LAS f32x4*)(cst + 64); ckk[mt] = *(const LAS f32x4*)(cst + 128); cka[mt] = *(const LAS f32x4*)(cst + 192); crk[mt] = *(const LAS f32x4*)(cst + 256); }
        asm volatile("" : "+v"(cw0[0]), "+v"(cw0[1]), "+v"(cw0[2]), "+v"(cw0[3]), "+v"(ca0[0]), "+v"(ca0[1]), "+v"(ca0[2]), "+v"(ca0[3]), "+v"(ckk[0]), "+v"(ckk[1]), "+v"(ckk[2]), "+v"(ckk[3]), "+v"(cka[0]), "+v"(cka[1]), "+v"(cka[2]), "+v"(cka[3]), "+v"(crk[0]), "+v"(crk[1]), "+v"(crk[2]), "+v"(crk[3]));
#pragma unroll
        for (int mt = 0; mt < 4; ++mt) {
            const f32x4 w0 = cw0[mt], a0 = ca0[mt], kkc = ckk[mt], kac = cka[mt], rkc = crk[mt];
            const float rv[4] = {bflo(r2[mt].x), bfhi(r2[mt].x), bflo(r2[mt].y), bfhi(r2[mt].y)}, kv[4] = {bflo(k2[mt].x), bfhi(k2[mt].x), bflo(k2[mt].y), bfhi(k2[mt].y)};
#pragma unroll
            for (int e = 0; e < 4; ++e) { const int i = 4 * mt + e;
                lnw[i] = -0.6065306597126334f * sigmoidf_(w0[e] + lw[mt][e]);
                asg[i] = sigmoidf_(a0[e] + la[mt][e]);
                const float kr = kv[e] * kkc[e]; kk[i] = kr; ss += kr * kr;
                kd[i] = kv[e] * (1.f + (asg[i] - 1.f) * kac[e]);
                sap += rv[e] * rkc[e] * kd[i]; } }
        ss += __shfl_xor(ss, 16); ss += __shfl_xor(ss, 32); sap += __shfl_xor(sap, 16); sap += __shfl_xor(sap, 32);
        const float inv = __builtin_amdgcn_rsqf(fmaxf(ss, 1e-24f));
        if (g == 0) SA[((size_t)z * MT + row) * 32 + h] = sap;
        float ec_[16], eC_[16];
#pragma unroll
        for (int i = 0; i < 16; ++i) { float c = lnw[i]; c += dpp_row_shr<1>(c); c += dpp_row_shr<2>(c); c += dpp_row_shr<4>(c); c += dpp_row_shr<8>(c); ec_[i] = __expf(c); }
#pragma unroll
        for (int i = 0; i < 16; ++i) eC_[i] = __shfl(ec_[i], (lane & 48) | 15);
        { const int hh0 = (tau >> 2) & 1, jj0 = 4 * (tau >> 3) + (tau & 3), hh1 = tau >> 3, jj1 = tau & 7;
          LAS bf16* bkb0 = BKs + (4 * g + 32 * hh0) * 8 + jj0; LAS bf16* bkb1 = BKs + 512 + (4 * g + 32 * hh1) * 8 + jj1; LAS bf16* vfb = VFs + (4 * g + 32 * hh1) * 8 + jj1;
#pragma unroll
          for (int mt = 0; mt < 4; ++mt) {
            float at[4], rt[4], bt[4], kt[4];
            const float rv[4] = {bflo(r2[mt].x), bfhi(r2[mt].x), bflo(r2[mt].y), bfhi(r2[mt].y)};
            const unsigned short vraw[4] = {(unsigned short)(v2[mt].x & 0xffffu), (unsigned short)(v2[mt].x >> 16), (unsigned short)(v2[mt].y & 0xffffu), (unsigned short)(v2[mt].y >> 16)};
#pragma unroll
            for (int e = 0; e < 4; ++e) { const int i = 4 * mt + e;
                const float ec = ec_[i], en = __builtin_amdgcn_rcpf(ec);
                const float eprev = __int_as_float(__builtin_amdgcn_update_dpp(0x3f800000, __float_as_int(ec), 0x111, 0xf, 0xf, false));
                const float er = eC_[i] * en;
                const float kki = kk[i] * inv, bb = kki * asg[i];
                at[e] = -kki * eprev; rt[e] = rv[e] * ec; bt[e] = bb * en; kt[e] = kd[i] * en;
                const int eo = ((mt >> 1) * 2) * 512 + (16 * (mt & 1) + e) * 8;
                const unsigned wbk = pk2(bb * er, kd[i] * er);
                bkb0[eo] = (bf16)(wbk & 0xffffu); bkb1[eo] = (bf16)(wbk >> 16);
                vfb[(mt >> 1) * 512 + (16 * (mt & 1) + e) * 8] = vraw[e]; }
            const int jb = (4 * (g >> 1)) * 2, cb = (((2 * mt + (g >> 1)) ^ (tau & 7)) << 4) + 8 * (g & 1);
            v2u wa; wa.x = pk2(at[0], at[1]); wa.y = pk2(at[2], at[3]);
            v2u wq; wq.x = pk2(rt[0], rt[1]); wq.y = pk2(rt[2], rt[3]);
            v2u wb; wb.x = pk2(bt[0], bt[1]); wb.y = pk2(bt[2], bt[3]);
            v2u wk; wk.x = pk2(kt[0], kt[1]); wk.y = pk2(kt[2], kt[3]);
            *(v2u*)(blk + BLK_AR + (mt * 64 + tau + 32 * (g & 1)) * 16 + jb) = wa;
            *(v2u*)(blk + BLK_AR + (mt * 64 + 16 + tau + 32 * (g & 1)) * 16 + jb) = wq;
            *(LAS v2u*)(Xs + tau * 128 + cb) = wa; *(LAS v2u*)(Xs + (16 + tau) * 128 + cb) = wq;
            *(LAS v2u*)(Ys + tau * 128 + cb) = wb; *(LAS v2u*)(Ys + (16 + tau) * 128 + cb) = wk;
          }
          if (tau == 0) {
#pragma unroll
              for (int i = 0; i < 16; ++i) { const int j = 16 * (i >> 2) + 4 * g + (i & 3), mtp = j >> 5, jl = j & 31, hq = (jl >> 2) & 1, qq = (jl & 3) + 4 * (jl >> 3); PCs[(hq * 2 + mtp) * 16 + qq] = eC_[i]; } }
        }
        LDS_WAIT();
        f32x16 dm;
#pragma unroll
        for (int i = 0; i < 16; ++i) dm[i] = 0.f;
        { const int r31 = lane & 31, hh = lane >> 5;
#pragma unroll
          for (int ks = 0; ks < 4; ++ks) { const int co = ((2 * ks + hh) ^ (r31 & 7)) << 4; const bf16x8 xa = *(const LAS bf16x8*)(Xs + r31 * 128 + co), yb = *(const LAS bf16x8*)(Ys + r31 * 128 + co); dm = MFMA32(xa, yb, dm); }
          LDS_WAIT();
          LAS float* Dm = (LAS float*)scr;
#pragma unroll
          for (int q_ = 0; q_ < 16; ++q_) Dm[((q_ & 3) + 8 * (q_ >> 2) + 4 * hh) * 36 + r31] = dm[q_];
        }
        LDS_WAIT();
        float xs[16], os[16];
        { const LAS float* Dm = (const LAS float*)scr; const int c = lane & 31, cc = (c - 16) & 15; const bool lo16 = c < 16;
          float ak[16], rk[16];
#pragma unroll
          for (int t = 0; t < 16; ++t) { ak[t] = Dm[t * 36 + 16 + cc]; rk[t] = Dm[(16 + t) * 36 + 16 + cc]; }
          asm volatile("" : "+v"(ak[0]), "+v"(ak[1]), "+v"(ak[2]), "+v"(ak[3]), "+v"(ak[4]), "+v"(ak[5]), "+v"(ak[6]), "+v"(ak[7]), "+v"(ak[8]), "+v"(ak[9]), "+v"(ak[10]), "+v"(ak[11]), "+v"(ak[12]), "+v"(ak[13]), "+v"(ak[14]), "+v"(ak[15]));
          asm volatile("" : "+v"(rk[0]), "+v"(rk[1]), "+v"(rk[2]), "+v"(rk[3]), "+v"(rk[4]), "+v"(rk[5]), "+v"(rk[6]), "+v"(rk[7]), "+v"(rk[8]), "+v"(rk[9]), "+v"(rk[10]), "+v"(rk[11]), "+v"(rk[12]), "+v"(rk[13]), "+v"(rk[14]), "+v"(rk[15]) :: "memory");
#pragma unroll
          for (int t = 0; t < 16; ++t) { const float one = (t == c) ? 1.f : 0.f, akm = (cc < t) ? ak[t] : 0.f, rkm = (cc <= t) ? rk[t] : 0.f; xs[t] = lo16 ? one : akm; os[t] = lo16 ? 0.f : rkm; }
#pragma unroll
          for (int tb = 0; tb < 4; ++tb) {
              f32x4 ar[4][4];
#pragma unroll
              for (int r = 0; r < 4; ++r)
#pragma unroll
                  for (int u4 = 0; u4 <= tb; ++u4) ar[r][u4] = *(const LAS f32x4*)(Dm + (4 * tb + r) * 36 + 4 * u4);
#pragma unroll
              for (int r = 0; r < 4; ++r) { if (tb == 0) asm volatile("" : "+v"(ar[r][0]) :: "memory"); else if (tb == 1) asm volatile("" : "+v"(ar[r][0]), "+v"(ar[r][1]) :: "memory"); else if (tb == 2) asm volatile("" : "+v"(ar[r][0]), "+v"(ar[r][1]), "+v"(ar[r][2]) :: "memory"); else asm volatile("" : "+v"(ar[r][0]), "+v"(ar[r][1]), "+v"(ar[r][2]), "+v"(ar[r][3]) :: "memory"); }
#pragma unroll
              for (int r = 0; r < 4; ++r) { const int t = 4 * tb + r;
#pragma unroll
                  for (int tau_ = 0; tau_ < t; ++tau_) xs[t] += ar[r][tau_ >> 2][tau_ & 3] * xs[tau_]; }
              asm volatile("" : "+v"(xs[4 * tb]), "+v"(xs[4 * tb + 1]), "+v"(xs[4 * tb + 2]), "+v"(xs[4 * tb + 3]) :: "memory");
          }
#pragma unroll
          for (int tb = 0; tb < 4; ++tb) {
              f32x4 ar[4][4];
#pragma unroll
              for (int r = 0; r < 4; ++r)
#pragma unroll
                  for (int u4 = 0; u4 <= tb; ++u4) ar[r][u4] = *(const LAS f32x4*)(Dm + (16 + 4 * tb + r) * 36 + 4 * u4);
#pragma unroll
              for (int r = 0; r < 4; ++r) { if (tb == 0) asm volatile("" : "+v"(ar[r][0]) :: "memory"); else if (tb == 1) asm volatile("" : "+v"(ar[r][0]), "+v"(ar[r][1]) :: "memory"); else if (tb == 2) asm volatile("" : "+v"(ar[r][0]), "+v"(ar[r][1]), "+v"(ar[r][2]) :: "memory"); else asm volatile("" : "+v"(ar[r][0]), "+v"(ar[r][1]), "+v"(ar[r][2]), "+v"(ar[r][3]) :: "memory"); }
#pragma unroll
              for (int r = 0; r < 4; ++r) { const int t = 4 * tb + r;
#pragma unroll
                  for (int tau_ = 0; tau_ <= t; ++tau_) os[t] += ar[r][tau_ >> 2][tau_ & 3] * xs[tau_]; }
              asm volatile("" : "+v"(os[4 * tb]), "+v"(os[4 * tb + 1]), "+v"(os[4 * tb + 2]), "+v"(os[4 * tb + 3]) :: "memory");
          }
        }
        LDS_WAIT();
        { LAS bf16* Gs = (LAS bf16*)(scr + 4608);
          if (lane < 32) { const int c = lane;
              int ks, hh, jj; if (c < 16) { ks = 0; hh = (c >> 2) & 1; jj = 4 * (c >> 3) + (c & 3); } else { ks = 2; hh = (c - 16) >> 3; jj = (c - 16) & 7; }
#pragma unroll
              for (int t = 0; t < 16; ++t) { Gs[(ks * 64 + t + 32 * hh) * 8 + jj] = (bf16)(pk2(xs[t], 0.f) & 0xffffu); Gs[(ks * 64 + 16 + t + 32 * hh) * 8 + jj] = (bf16)(pk2(os[t], 0.f) & 0xffffu); } }
        }
        LDS_WAIT();
        { v4u cg[2], cbk[7];
          cg[0] = *(const LAS v4u*)(scr + 4608 + lane * 16); cg[1] = *(const LAS v4u*)(scr + 4608 + (2 * 64 + lane) * 16);
#pragma unroll
          for (int i = 0; i < 6; ++i) cbk[i] = *(const LAS v4u*)(scr + 8192 + (i * 64 + lane) * 16);
          cbk[6] = *(const LAS v4u*)(scr + 8192 + (6 * 64 + (lane & 15)) * 16);
          asm volatile("" : "+v"(cg[0]), "+v"(cg[1]), "+v"(cbk[0]), "+v"(cbk[1]), "+v"(cbk[2]), "+v"(cbk[3]), "+v"(cbk[4]), "+v"(cbk[5]), "+v"(cbk[6]));
#pragma unroll
          for (int i = 0; i < 2; ++i) *(v4u*)(blk + BLK_G + (i * 64 + lane) * 16) = cg[i];
#pragma unroll
          for (int i = 0; i < 6; ++i) *(v4u*)(blk + BLK_BK + (i * 64 + lane) * 16) = cbk[i];
          if (lane < 16) *(v4u*)(blk + BLK_BK + (6 * 64 + lane) * 16) = cbk[6]; }
    }
#undef SC_LOADS
#undef SC_GRAB
}

__device__ __forceinline__ void scan_consume(const Frame& F, int w  , int lane, int ih) {
    const int nq = win_n(w), lo = win_lo(w);
    const unsigned char* wbuf = F.ws + WS_ACT + ACT_WBUF + (size_t)(w & 1) * WBUF_STRIDE;
    float* SST = (float*)(F.ws + WS_SST);
    const int r31 = lane & 31, hh = lane >> 5;
    for (int p = blockIdx.x; p < 256; p += 256) {
        const int chain = sc_chain(p), b = chain >> 6, h = (chain >> 1) & 31, z = chain & 1; const int sp_ = chain * 2 + ih;
        bf16* YB = (bf16*)(F.ws + WS_ACT + (z ? ACT_YB1 : ACT_YB0));
        f32x16 st0, st1;
        if (w == 0) {
#pragma unroll
            for (int i = 0; i < 16; ++i) { st0[i] = 0.f; st1[i] = 0.f; } }
        else {
#pragma unroll
            for (int i = 0; i < 16; ++i) { st0[i] = SST[((size_t)sp_ * 32 + i) * 64 + lane]; st1[i] = SST[((size_t)sp_ * 32 + 16 + i) * 64 + lane]; } }
        volatile LAS unsigned* ctl = (volatile LAS unsigned*)(F.lds + SC_CTL);
        bf16x8 gmid;
        { unsigned e8[8];
#pragma unroll
          for (int jj = 0; jj < 8; ++jj) { const int pi = 8 * (jj >> 2) + 4 * hh + (jj & 3); e8[jj] = (r31 >= 16 && r31 - 16 == pi) ? 0x3f80u : 0u; }
          v4u m_; m_.x = e8[0] | (e8[1] << 16); m_.y = e8[2] | (e8[3] << 16); m_.z = e8[4] | (e8[5] << 16); m_.w = e8[6] | (e8[7] << 16); gmid = __builtin_bit_cast(bf16x8, m_); }
        unsigned yoff[8];
#pragma unroll
        for (int q_ = 8; q_ < 16; ++q_) { const int t = (q_ & 3) + 8 * ((q_ >> 2) & 1) + 4 * hh; yoff[q_ - 8] = (unsigned)((z ? 15 - t : t) * D + h * 64 + 32 * ih + r31) * 2u; }
#pragma unroll 1
        for (int q = 0; q < nq; ++q) {
            { unsigned sp = 0; _Pragma("unroll 1") while ((int)ctl[0] <= q) { __builtin_amdgcn_s_sleep(1); if (++sp > (1u << 24)) break; } }
            asm volatile("" ::: "memory");
            const LAS unsigned char* sl = F.lds + SC_RING + (q % SC_NSLOT) * SC_SLOT;
            bf16x8 arf[4], gf[3], bkf[2][2], vf; f32x4 pc[8];
#pragma unroll
            for (int ks = 0; ks < 4; ++ks) arf[ks] = *(const LAS bf16x8*)(sl + BLK_AR + (ks * 64 + lane) * 16);
            gf[0] = *(const LAS bf16x8*)(sl + BLK_G + lane * 16); gf[2] = *(const LAS bf16x8*)(sl + BLK_G + (64 + lane) * 16); gf[1] = gmid;
#pragma unroll
            for (int mj = 0; mj < 2; ++mj)
#pragma unroll
                for (int ks = 0; ks < 2; ++ks) bkf[mj][ks] = *(const LAS bf16x8*)(sl + BLK_BK + ((mj * 2 + ks) * 64 + lane) * 16);
            vf = *(const LAS bf16x8*)(sl + BLK_VF + (ih * 64 + lane) * 16);
#pragma unroll
            for (int i = 0; i < 8; ++i) pc[i] = *(const LAS f32x4*)(sl + BLK_PCF + hh * 128 + i * 16);
            LDS_WAIT();
            asm volatile("" ::: "memory"); if (lane == 0) ctl[ih ? 4 : 1] = (unsigned)(q + 1);
            const bf16x8 s0 = pack_frag(st0[0], st0[1], st0[2], st0[3], st0[4], st0[5], st0[6], st0[7]), s1 = pack_frag(st0[8], st0[9], st0[10], st0[11], st0[12], st0[13], st0[14], st0[15]);
            const bf16x8 s2 = pack_frag(st1[0], st1[1], st1[2], st1[3], st1[4], st1[5], st1[6], st1[7]), s3 = pack_frag(st1[8], st1[9], st1[10], st1[11], st1[12], st1[13], st1[14], st1[15]);
            const f32x16 zero16 = {0.f, 0.f, 0.f, 0.f, 0.f, 0.f, 0.f, 0.f, 0.f, 0.f, 0.f, 0.f, 0.f, 0.f, 0.f, 0.f};
            f32x16 zz = MFMA32(arf[0], s0, zero16);
            zz = MFMA32(arf[1], s1, zz);
            zz = MFMA32(arf[2], s2, zz);
            zz = MFMA32(arf[3], s3, zz);
#pragma unroll
            for (int i = 0; i < 16; ++i) { st0[i] *= pc[i >> 2][i & 3]; st1[i] *= pc[4 + (i >> 2)][i & 3]; }
            f32x16 oo = MFMA32(gf[2], vf, zero16);
            oo = MFMA32(gf[0], pack_frag(zz[0], zz[1], zz[2], zz[3], zz[4], zz[5], zz[6], zz[7]), oo);
            oo = MFMA32(gf[1], pack_frag(zz[8], zz[9], zz[10], zz[11], zz[12], zz[13], zz[14], zz[15]), oo);
            st0 = MFMA32(bkf[0][1], vf, st0); st1 = MFMA32(bkf[1][1], vf, st1);
            const bf16x8 uf = pack_frag(oo[0], oo[1], oo[2], oo[3], oo[4], oo[5], oo[6], oo[7]);
            st0 = MFMA32(bkf[0][0], uf, st0); st1 = MFMA32(bkf[1][0], uf, st1);
            if (w > 0) {
                const int sp0 = (lo + q) * 16 - CTXL;
                const int rlow = __builtin_amdgcn_readfirstlane(b * SEQ + (z ? SEQ - 1 - sp0 - 15 : sp0));
                char* yb = (char*)YB + (size_t)rlow * (D * 2);
#pragma unroll
                for (int q_ = 8; q_ < 16; ++q_) *(bf16*)(yb + yoff[q_ - 8]) = (bf16)(pk2(oo[q_], 0.f) & 0xffffu); }
        }
#pragma unroll
        for (int i = 0; i < 16; ++i) { SST[((size_t)sp_ * 32 + i) * 64 + lane] = st0[i]; SST[((size_t)sp_ * 32 + 16 + i) * 64 + lane] = st1[i]; }
    }
}
__device__ __forceinline__ void scan_loader(const Frame& F, int w, int lane) {
    const int nq = win_n(w);
    const int p = blockIdx.x; if (p >= 256) return;
    const unsigned char* cbase = F.ws + WS_ACT + ACT_WBUF + (size_t)(w & 1) * WBUF_STRIDE + (size_t)sc_chain(p) * SC_WQ * SCAN_BLK + lane * 16;
    volatile LAS unsigned* ctl = (volatile LAS unsigned*)(F.lds + SC_CTL);
#pragma unroll 1
    for (int q = 0; q < nq; ++q) {
        { unsigned sp = 0; while (q - (int)ctl[1] >= SC_NSLOT || q - (int)ctl[4] >= SC_NSLOT) { __builtin_amdgcn_s_sleep(1); if (++sp > (1u << 24)) break; } }
        asm volatile("" ::: "memory");
        const unsigned char* src = cbase + (size_t)q * SCAN_BLK; LAS unsigned char* dst = F.lds + SC_RING + (q % SC_NSLOT) * SC_SLOT;
#pragma unroll
        for (int i_ = 0; i_ < 12; ++i_) __builtin_amdgcn_global_load_lds((const unsigned*)(src + i_ * 1024), (LAS unsigned*)(dst + i_ * 1024), 16, 0, 0);
        if (lane < 16) __builtin_amdgcn_global_load_lds((const unsigned*)(src + BLK_PCF), (LAS unsigned*)(dst + BLK_PCF), 16, 0, 0);
        asm volatile("s_waitcnt vmcnt(26)" ::: "memory");
        if (lane == 0 && q >= 1) ctl[0] = (unsigned)(q - 1);
    }
    asm volatile("s_waitcnt vmcnt(0)" ::: "memory");
    if (lane == 0) ctl[0] = (unsigned)nq;
}
__device__ __forceinline__ void phase_scan_step(Frame& F, const Args& AR, int w) {
    int tid_ = threadIdx.x; asm volatile("" : "+v"(tid_)); const int LANE = tid_ & 63, WAVE = __builtin_amdgcn_readfirstlane(tid_ >> 6);
    if (w == 0) scan_setup(F, AR, tid_);
    const bool isA = sc_half(blockIdx.x) == 0;
    if (tid_ < 8) ((volatile LAS unsigned*)(F.lds + SC_CTL))[tid_] = tid_ == 2 ? (unsigned)(isA ? SC_NPROD_A : SC_NPROD_B) : 0u;
    __syncthreads();
    if (isA) {
        if (WAVE <= 1) { if (w >= 1) scan_consume(F, w - 1, LANE, WAVE); }
        else if (WAVE == 2) { if (w >= 1) scan_loader(F, w - 1, LANE); }
        else { if (w < SCAN_NW) scan_produce(F, w, WAVE - 3, LANE, true); }
    } else { if (w < SCAN_NW) scan_produce(F, w, WAVE, LANE, false); }
}
__device__ __forceinline__ void phase_combine(Frame& F, const Args& AR, bf16* PO) {
    int tid_ = threadIdx.x; asm volatile("" : "+v"(tid_)); const int TID = tid_, LANE = tid_ & 63, WAVE = __builtin_amdgcn_readfirstlane(tid_ >> 6);
    const bf16* VP = (const bf16*)(F.ws + WS_ACT + ACT_XM + 5 * XM_STRIDE);
    const bf16* YB0 = (const bf16*)(F.ws + WS_ACT + ACT_YB0); const bf16* YB1 = (const bf16*)(F.ws + WS_ACT + ACT_YB1);
    const float* SA = (const float*)(F.ws + WS_SA);
    LAS float* TC = (LAS float*)F.lds;
    for (int i = TID; i < D / 4; i += NWAVES * 64) { *(LAS f32x4*)(TC + 4 * i) = *(const f32x4*)(AR.in[24] + 4 * i); *(LAS f32x4*)(TC + D + 4 * i) = *(const f32x4*)(AR.in[25] + 4 * i); }
    __syncthreads();
    const int gw = F.vcu * NWAVES + WAVE, NGW = F.G * NWAVES;
    v4u yaA[4], ybA[4], vqA[4], yaB[4], ybB[4], vqB[4]; float s0A[4], s1A[4], s0B[4], s1B[4];
#define CB_LOAD(ya, yb, vq, s0, s1, r_) do { _Pragma("unroll") for (int c = 0; c < 4; ++c) { const unsigned o = (unsigned)((r_) * D + 512 * c + 8 * LANE) * 2u; \
            ya[c] = *(const v4u*)((const char*)YB0 + o); yb[c] = *(const v4u*)((const char*)YB1 + o); vq[c] = *(const v4u*)((const char*)VP + o); \
            s0[c] = SA[(r_) * 32 + 8 * c + (LANE >> 3)]; s1[c] = SA[(MT + (r_)) * 32 + 8 * c + (LANE >> 3)]; } } while (0)
#define CB_COMP(ya, yb, vq, s0, s1, r_) do { _Pragma("unroll") for (int c = 0; c < 4; ++c) { const int d = 512 * c + 8 * LANE; \
            const unsigned aw[4] = {ya[c].x, ya[c].y, ya[c].z, ya[c].w}, bw[4] = {yb[c].x, yb[c].y, yb[c].z, yb[c].w}, vw[4] = {vq[c].x, vq[c].y, vq[c].z, vq[c].w}; \
            float y[8]; float sum = 0.f; \
            _Pragma("unroll") for (int e = 0; e < 4; ++e) { y[2 * e] = bflo(aw[e]) + bflo(bw[e]); y[2 * e + 1] = bfhi(aw[e]) + bfhi(bw[e]); sum += y[2 * e] + y[2 * e + 1]; } \
            sum += __shfl_xor(sum, 1); sum += __shfl_xor(sum, 2); sum += __shfl_xor(sum, 4); \
            const float mean = sum * (1.f / 64.f); float vs = 0.f; \
            _Pragma("unroll") for (int i = 0; i < 8; ++i) { const float dl = y[i] - mean; vs += dl * dl; } \
            vs += __shfl_xor(vs, 1); vs += __shfl_xor(vs, 2); vs += __shfl_xor(vs, 4); \
            const float rstd = 1.0f / sqrtf(vs * (1.f / 64.f) + GN_EPS); \
            const float sb = 0.5f * (s0[c] + s1[c]);        \
            const f32x4 l0 = *(const LAS f32x4*)(TC + d), l1 = *(const LAS f32x4*)(TC + d + 4), b0 = *(const LAS f32x4*)(TC + D + d), b1 = *(const LAS f32x4*)(TC + D + d + 4); \
            const float lw_[8] = {l0.x, l0.y, l0.z, l0.w, l1.x, l1.y, l1.z, l1.w}, lb_[8] = {b0.x, b0.y, b0.z, b0.w, b1.x, b1.y, b1.z, b1.w}; \
            float o[8]; \
            _Pragma("unroll") for (int e = 0; e < 4; ++e) { o[2 * e] = (y[2 * e] - mean) * rstd * lw_[2 * e] + lb_[2 * e] + sb * bflo(vw[e]); o[2 * e + 1] = (y[2 * e + 1] - mean) * rstd * lw_[2 * e + 1] + lb_[2 * e + 1] + sb * bfhi(vw[e]); } \
            v4u w_; w_.x = pk2(o[0], o[1]); w_.y = pk2(o[2], o[3]); w_.z = pk2(o[4], o[5]); w_.w = pk2(o[6], o[7]); \
            *(v4u*)((char*)PO + (unsigned)((r_) * D + d) * 2u) = w_; } } while (0)
    int r = gw;
    if (r < ML) CB_LOAD(yaA, ybA, vqA, s0A, s1A, r);
#pragma unroll 1
    for (; r < ML; r += 2 * NGW) {
        const int r1 = r + NGW, r2 = r + 2 * NGW;
        if (r1 < ML) CB_LOAD(yaB, ybB, vqB, s0B, s1B, r1);
        CB_COMP(yaA, ybA, vqA, s0A, s1A, r);
        if (r2 < ML) CB_LOAD(yaA, ybA, vqA, s0A, s1A, r2);
        if (r1 < ML) CB_COMP(yaB, ybB, vqB, s0B, s1B, r1);
    }
#undef CB_LOAD
#undef CB_COMP
}

template <class RowMap, bool BLK = false>
__device__ __forceinline__ void transpose_item(const float* W, int K, int N, bf16* WT, const RowMap& rm, LAS float* scr, int item, int lane) {
    const int nblk = N / 32, kb = item / nblk, nb = item % nblk, k0 = 64 * kb, n0 = 32 * nb;
#pragma unroll 8
    for (int i = 0; i < 32; ++i) { const int kk = 2 * i + (lane >> 5); scr[kk * 33 + (lane & 31)] = W[(size_t)(k0 + kk) * N + n0 + (lane & 31)]; }
    LDS_WAIT(); asm volatile("" ::: "memory");
    const int c = lane & 7;
#pragma unroll
    for (int j = 0; j < 4; ++j) { const int n = (lane >> 3) + 8 * j; const LAS float* s = scr + (8 * c) * 33 + n;
        v4u o; o.x = pk2(s[0 * 33], s[1 * 33]); o.y = pk2(s[2 * 33], s[3 * 33]); o.z = pk2(s[4 * 33], s[5 * 33]); o.w = pk2(s[6 * 33], s[7 * 33]);
        const int nr = rm(n0 + n);
        if (BLK) *(v4u*)(WT + ((size_t)(nr >> 8) * (K / 64) + (k0 >> 6)) * 16384 + (size_t)(nr & 255) * 64 + 8 * c) = o;
        else *(v4u*)(WT + (size_t)nr * K + k0 + 8 * c) = o; }
    LDS_WAIT(); asm volatile("" ::: "memory");
}
struct RmId { __device__ __forceinline__ int operator()(int n) const { return n; } };
struct RmW13 { __device__ __forceinline__ int operator()(int n) const { const int bj = n >= DFF ? 1 : 0, j = n - bj * DFF; return 256 * (j >> 7) + 128 * bj + (j & 127); } };

__device__ __forceinline__ void p0_prologue(Frame& F, const Args& AR) {
    int tid_ = threadIdx.x; asm volatile("" : "+v"(tid_)); const int TID = tid_, LANE = tid_ & 63, WAVE = __builtin_amdgcn_readfirstlane(tid_ >> 6);
    const float* x_c = AR.in[1]; const float* c_ctx = AR.in[3]; const float* mod_w = AR.in[4];
    for (int i = blockIdx.x * (NWAVES * 64) + TID; i < 6 * 262144 / 4; i += F.G * NWAVES * 64) ((f32x4*)(F.ws + WS_PS))[i] = (f32x4){0.f, 0.f, 0.f, 0.f};
    {
        LAS float* sil = (LAS float*)(F.lds);
        LAS f32x4* red = (LAS f32x4*)(F.lds + 24576);
        for (int i = TID; i < 3 * D; i += NWAVES * 64) { const int who = i / D, k = i % D; const float v = who < 2 ? x_c[who * D + k] : c_ctx[k]; sil[i] = v * sigmoidf_(v); }
        __syncthreads();
        for (int t = blockIdx.x; t < 576; t += F.G) {
            const int q = t & 3, cb = (t >> 2) % 72, layer = t / 288;
            const int r0 = q * 512 + WAVE * 64;
            const float* wp = mod_w + ((size_t)layer * D + r0) * NMODV + cb * 256 + LANE * 4;
            f32x4 a0 = {0.f, 0.f, 0.f, 0.f}, a1 = a0, a2 = a0;
#pragma unroll 8
            for (int r = 0; r < 64; ++r) { const f32x4 w = *(const f32x4*)(wp + (size_t)r * NMODV); a0 += w * sil[r0 + r]; a1 += w * sil[D + r0 + r]; a2 += w * sil[2 * D + r0 + r]; }
            red[(WAVE * 3 + 0) * 64 + LANE] = a0; red[(WAVE * 3 + 1) * 64 + LANE] = a1; red[(WAVE * 3 + 2) * 64 + LANE] = a2;
            __syncthreads();
            if (WAVE < 3) { f32x4 s = {0.f, 0.f, 0.f, 0.f};
#pragma unroll
                for (int w = 0; w < 8; ++w) s += red[(w * 3 + WAVE) * 64 + LANE];
                *(f32x4*)((float*)(F.ws + WS_MODP) + ((size_t)(q * 2 + layer) * 3 + WAVE) * NMODV + cb * 256 + LANE * 4) = s; }
            __syncthreads();
        }
    }
    LAS float* scr = (LAS float*)(F.lds + WAVE * 16384);
    const int gw = F.vcu * NWAVES + WAVE, NGW = F.G * NWAVES;
    {
        constexpr int I13 = (D / 64) * (2 * DFF / 32), I2 = (DFF / 64) * (D / 32), IDD = (D / 64) * (D / 32);
        constexpr int NIT = 4 * I13 + 4 * I2 + 5 * IDD + 2 * (D / 64) * (256 / 32) / 1;
        for (int it = gw; it < NIT; it += NGW) {
            int r = it;
            if (r < 4 * I13) { const int lf = r / I13; r -= lf * I13; const int l = lf >> 1, f = lf & 1;
                transpose_item<RmW13, true>(AR.in[7] + (size_t)lf * D * 2 * DFF, D, 2 * DFF, (bf16*)(F.ws + (l ? WS_WL1 : WS_WL0) + (size_t)f * 44 * MiB), RmW13(), scr, r, LANE); continue; }
            r -= 4 * I13;
            if (r < 4 * I2) { const int lf = r / I2; r -= lf * I2; const int l = lf >> 1, f = lf & 1;
                transpose_item<RmId, true>(AR.in[8] + (size_t)lf * DFF * D, DFF, D, (bf16*)(F.ws + (l ? WS_WL1 : WS_WL0) + 88 * MiB + (size_t)f * 22 * MiB), RmId(), scr, r, LANE); continue; }
            r -= 4 * I2;
            if (r < IDD) { transpose_item(AR.in[9], D, D, (bf16*)(F.ws + WS_WFO), RmId(), scr, r, LANE); continue; }
            r -= IDD;
            if (r < 3 * IDD) { const int p = r / IDD; r -= p * IDD; transpose_item(AR.in[12] + (size_t)p * D * D, D, D, (bf16*)(F.ws + WS_WRKV + (size_t)p * 8 * MiB), RmId(), scr, r, LANE); continue; }
            r -= 3 * IDD;
            if (r < IDD) { transpose_item(AR.in[26], D, D, (bf16*)(F.ws + WS_WRO), RmId(), scr, r, LANE); continue; }
            r -= IDD;
            if (r < 256) { transpose_item(AR.in[19], D, 256, (bf16*)(F.ws + WS_WSMALL + WSM_G1T), RmId(), scr, r, LANE); continue; }
            r -= 256;
            transpose_item(AR.in[20], 256, D, (bf16*)(F.ws + WS_WSMALL + WSM_G2T), RmId(), scr, r, LANE);
        }
    }
    {
        const int gt = (F.vcu * NWAVES + WAVE) * 64 + LANE, NGT = F.G * NWAVES * 64;
        for (int i = gt; i < 2 * 256 * D; i += NGT) { const int which = i / (256 * D), rr = (i / D) % 256, k = i % D;
            float v = 0.f; if (rr < 192) { const int z = rr / 96, r = rr % 96; v = AR.in[which ? 17 : 14][((size_t)z * D + k) * LORA + r]; }
            ((bf16*)(F.ws + WS_WSMALL + (which ? WSM_A1CAT : WSM_W1CAT)))[(size_t)rr * D + k] = (bf16)(pk2(v, 0.f) & 0xffffu); }
        for (int i = gt; i < 2 * 2 * D * LORA; i += NGT) { const int which = i / (2 * D * LORA), j = i % (2 * D * LORA), z = j / (D * LORA), n = (j / LORA) % D, r = j % LORA;
            const float v = AR.in[which ? 18 : 15][((size_t)z * LORA + r) * D + n];
            ((bf16*)(F.ws + WS_WSMALL + (which ? WSM_A2UP : WSM_W2UP)))[j] = (bf16)(pk2(v, 0.f) & 0xffffu); }
        for (int i = gt; i < MC * D / 4; i += NGT) ((f32x4*)(F.ws + WS_XC))[i] = ((const f32x4*)AR.in[2])[i];
        const float RS128 = 0.08838834764831845f;
        bf16* dm = (bf16*)(F.ws + WS_TAB + TAB_DMAT); bf16* m1 = (bf16*)(F.ws + WS_TAB + TAB_M1); bf16* m2 = (bf16*)(F.ws + WS_TAB + TAB_M2); bf16* m3 = (bf16*)(F.ws + WS_TAB + TAB_M3);
        f32x2* tw = (f32x2*)(F.ws + WS_TAB + TAB_TW);
        for (int i = gt; i < 512 * 256; i += NGT) { const int r = i >> 8, ch = i & 255, cs = r >> 8, kc = r & 255; float s, c; sincospif((float)((kc * ch) & 255) * (1.f / 128.f), &s, &c);
            dm[i] = (bf16)(pk2((cs ? s : c) * 0.0625f, 0.f) & 0xffffu); }
        for (int i = gt; i < 256 * 256; i += NGT) { const int r = i >> 8, ci = i & 255, ri = r >> 7, k1 = r & 127, cs = ci >> 7, n1 = ci & 127; float s, c; sincospif((float)((k1 * n1) & 127) * (1.f / 64.f), &s, &c);
            const float v1 = ri == 0 ? (cs == 0 ? c : -s) : (cs == 0 ? s : c);
            m1[i] = (bf16)(pk2(v1 * RS128, 0.f) & 0xffffu);
            const float v2 = r < 128 ? (cs == 0 ? c : -s) : 0.f;
            m2[i] = (bf16)(pk2(v2 * RS128, 0.f) & 0xffffu); }
        for (int i = gt; i < 256 * 512; i += NGT) { const int k = i >> 9, ci = i & 511, cs = ci >> 8, n = ci & 255; float s, c; sincospif((float)((k * n) & 255) * (1.f / 128.f), &s, &c);
            m3[i] = (bf16)(pk2((cs ? -s : c) * 0.0625f, 0.f) & 0xffffu); }
        for (int i = gt; i < 128 * 128; i += NGT) { const int k1 = i >> 7, n2 = i & 127; float s, c; sincospif((float)(k1 * n2) * (1.f / 8192.f), &s, &c); tw[i] = (f32x2){c, s}; }
    }
}

template <bool BLK = false, bool FIRST = false> __device__ __forceinline__ void phase_norm(Frame& F, const float* xl, const float* xc, int r0, int Mrows, const float* nw, int layer, int sidx, bf16* HN) {
    int tid_ = threadIdx.x; asm volatile("" : "+v"(tid_)); const int TID = tid_, LANE = tid_ & 63, WAVE = __builtin_amdgcn_readfirstlane(tid_ >> 6);
    LAS float* TA = (LAS float*)(F.lds);
    LAS float* TB = (LAS float*)(F.lds + 24576);
    for (int i = TID; i < 3 * D / 4; i += NWAVES * 64) { const int who = i / (D / 4), d = (i % (D / 4)) * 4;
        const ModRef MR{(const float*)(F.ws + WS_MODP), F.modb, (const float*)(F.ws + WS_MODV)};
        const f32x4 sh = FIRST ? modv4(MR, layer, who, sidx * D + d) : modvF(MR, layer, who, sidx * D + d), sc = FIRST ? modv4(MR, layer, who, (sidx + 1) * D + d) : modvF(MR, layer, who, (sidx + 1) * D + d), g = *(const f32x4*)(nw + d);
        *(LAS f32x4*)(TA + who * D + d) = g * (sc + 1.f); *(LAS f32x4*)(TB + who * D + d) = sh; }
    if (FIRST) {
        const ModRef MR{(const float*)(F.ws + WS_MODP), F.modb, nullptr}; float* MV = (float*)(F.ws + WS_MODV);
        for (int i = F.vcu * (NWAVES * 64) + TID; i < 6 * NMODV / 4; i += F.G * NWAVES * 64) { const int lw = i / (NMODV / 4), c = (i % (NMODV / 4)) * 4; *(f32x4*)(MV + (size_t)lw * NMODV + c) = modv4(MR, lw / 3, lw % 3, c); }
    }
    __syncthreads();
    const int gw = F.vcu * NWAVES + WAVE, NGW = F.G * NWAVES;
    for (int r = r0 + gw; r < Mrows; r += NGW) {
        const int who = who_of_row(r);
        const float* xr = r < ML ? xl + (size_t)r * D : xc + (size_t)(r - ML) * D;
        f32x4 v[4][2]; float ss = 0.f;
#pragma unroll
        for (int j = 0; j < 4; ++j)
#pragma unroll
            for (int h = 0; h < 2; ++h) { v[j][h] = *(const f32x4*)(xr + 512 * j + 8 * LANE + 4 * h); ss += (v[j][h].x * v[j][h].x + v[j][h].y * v[j][h].y) + (v[j][h].z * v[j][h].z + v[j][h].w * v[j][h].w); }
        const float rstd = 1.0f / sqrtf(wave_sum(ss) * (1.f / D) + NORM_EPS);
#pragma unroll
        for (int j = 0; j < 4; ++j) { const int d = 512 * j + 8 * LANE;
            const f32x4 a0 = *(const LAS f32x4*)(TA + who * D + d), a1 = *(const LAS f32x4*)(TA + who * D + d + 4), b0 = *(const LAS f32x4*)(TB + who * D + d), b1 = *(const LAS f32x4*)(TB + who * D + d + 4);
            const f32x4 o0 = v[j][0] * rstd * a0 + b0, o1 = v[j][1] * rstd * a1 + b1;
            v4u w; w.x = pk2(o0.x, o0.y); w.y = pk2(o0.z, o0.w); w.z = pk2(o1.x, o1.y); w.w = pk2(o1.z, o1.w);
            if (BLK) *(v4u*)(HN + ((size_t)(r >> 8) * (D / 64) + (d >> 6)) * 16384 + (size_t)(r & 255) * 64 + (d & 63)) = w;
            else *(v4u*)(HN + (size_t)r * D + d) = w; }
    }
}
__device__ __forceinline__ void phase_final(Frame& F, float* x, const float* w) {
    int tid_ = threadIdx.x; asm volatile("" : "+v"(tid_)); const int TID = tid_, LANE = tid_ & 63, WAVE = __builtin_amdgcn_readfirstlane(tid_ >> 6);
    const int gw = F.vcu * NWAVES + WAVE, NGW = F.G * NWAVES;
    for (int r = gw; r < ML; r += NGW) {
        float* xr = x + (size_t)r * D;
        f32x4 v[8]; float ss = 0.f;
#pragma unroll
        for (int j = 0; j < 8; ++j) { v[j] = *(const f32x4*)(xr + 256 * j + 4 * LANE); ss += (v[j].x * v[j].x + v[j].y * v[j].y) + (v[j].z * v[j].z + v[j].w * v[j].w); }
        const float rstd = 1.0f / sqrtf(wave_sum(ss) * (1.f / D) + NORM_EPS);
#pragma unroll
        for (int j = 0; j < 8; ++j) { const f32x4 g = *(const f32x4*)(w + 256 * j + 4 * LANE); *(f32x4*)(xr + 256 * j + 4 * LANE) = v[j] * rstd * g; }
    }
}

#if MK_DEBUG
__device__ __forceinline__ void dbg_flag(unsigned* ctl, unsigned code) { atomicMax(ctl + CW_DBG, code); }
__device__ __forceinline__ bool dbg_bad(float got, float ref, float atol, float rtol) { const float e = fabsf(got - ref); return !(e <= atol + rtol * fabsf(ref)); }
__device__ __forceinline__ unsigned dbg_hash(unsigned x) { x ^= x >> 16; x *= 0x7feb352du; x ^= x >> 15; x *= 0x846ca68bu; x ^= x >> 16; return x; }
__device__ __noinline__ void dbg_check_mod(unsigned char* ws, const float* c, const float* c_ctx, const float* mod_w, const float* modb) {
    const int lane = threadIdx.x & 63, gw = blockIdx.x * 8 + (threadIdx.x >> 6);
    if (gw >= 96) return;
    const unsigned h = dbg_hash(gw * 2654435761u + 17u); const int layer = h & 1, who = (h >> 1) % 3, col = ((h >> 4) % NMODV) & ~3;
    float s = 0.f;
    for (int k = lane; k < D; k += 64) { const float v = who < 2 ? c[who * D + k] : c_ctx[k]; s += v / (1.f + expf(-v)) * mod_w[((size_t)layer * D + k) * NMODV + col]; }
    s = wave_sum(s) + modb[(size_t)layer * NMODV + col];
    const ModRef MR{(const float*)(ws + WS_MODP), modb};
    const f32x4 g = modv4(MR, layer, who, col);
    if (lane == 0 && dbg_bad(g.x, s, 2e-3f, 2e-3f)) dbg_flag((unsigned*)(ws + WS_CTL), 1u);
}
__device__ __noinline__ void dbg_check_hn(unsigned char* ws, const float* x, const float* ctx, const float* nw, const float* modb, int layer, int sidx, unsigned code) {
    const int lane = threadIdx.x & 63, gw = blockIdx.x * 8 + (threadIdx.x >> 6);
    if (gw >= 64) return;
    const int r = (gw < 48) ? (int)(dbg_hash(gw + 99u) % ML) : ML + (int)(dbg_hash(gw + 7u) % MC);
    const float* xr = r < ML ? x + (size_t)r * D : ctx + (size_t)(r - ML) * D; const int who = who_of_row(r);
    float ss = 0.f; for (int d = lane; d < D; d += 64) ss += xr[d] * xr[d];
    const float rstd = 1.0f / sqrtf(wave_sum(ss) / D + NORM_EPS);
    const ModRef MR{(const float*)(ws + WS_MODP), modb}; const bf16* HN = (const bf16*)(ws + WS_ACT + ACT_HN);
    bool bad = false;
    for (int d4 = lane * 4; d4 < D; d4 += 256) { const f32x4 sh = modv4(MR, layer, who, sidx * D + d4), sc = modv4(MR, layer, who, (sidx + 1) * D + d4);
        for (int e = 0; e < 4; ++e) { const float ref = xr[d4 + e] * rstd * nw[d4 + e] * (1.f + sc[e]) + sh[e]; bad |= dbg_bad(bf2f(HN[(size_t)r * D + d4 + e]), ref, 0.03f, 0.01f); } }
    if (bad) dbg_flag((unsigned*)(ws + WS_CTL), code);
}
__device__ __noinline__ void dbg_check_h(unsigned char* ws, const float* w13) {
    const int lane = threadIdx.x & 63, gw = blockIdx.x * 8 + (threadIdx.x >> 6);
    if (gw >= 512) return;
    const unsigned h = dbg_hash(gw + 1234u); const int r = (gw & 7) == 7 ? ML + (int)(h % MC) : (int)(h % ML), j = (int)((h >> 7) % DFF);
    const bf16* HN = (const bf16*)(ws + WS_ACT + ACT_HN); const bf16* HB = (const bf16*)(ws + WS_ACT + ACT_H);
    float g = 0.f, u = 0.f;
    for (int k = lane; k < D; k += 64) { const float a = bf2f(HN[(size_t)r * D + k]); g += a * w13[(size_t)k * 2 * DFF + j]; u += a * w13[(size_t)k * 2 * DFF + DFF + j]; }
    g = wave_sum(g); u = wave_sum(u);
    const float ref = g / (1.f + expf(-g)) * u;
    if (lane == 0 && dbg_bad(bf2f(HB[(size_t)r * DFF + j]), ref, 0.03f, 0.03f)) dbg_flag((unsigned*)(ws + WS_CTL), 3u);
}
__device__ __noinline__ void dbg_check_w2(unsigned char* ws, const float* x, const float* ctx, const float* out, const float* w2, const float* modb) {
    const int lane = threadIdx.x & 63, gw = blockIdx.x * 8 + (threadIdx.x >> 6);
    if (gw >= 512) return;
    const unsigned h = dbg_hash(gw + 4321u); const int r = (gw & 7) == 7 ? ML + (int)(h % MC) : (int)(h % ML), col = (int)((h >> 7) % D) & ~3;
    const bf16* HB = (const bf16*)(ws + WS_ACT + ACT_H);
    float a = 0.f; for (int j = lane; j < DFF; j += 64) a += bf2f(HB[(size_t)r * DFF + j]) * w2[(size_t)j * D + col];
    a = wave_sum(a);
    const ModRef MR{(const float*)(ws + WS_MODP), modb}; const f32x4 gt = modv4(MR, 0, who_of_row(r), 2 * D + col);
    const float base = r < ML ? x[(size_t)r * D + col] : ctx[(size_t)(r - ML) * D + col];
    const float got = r < ML ? out[(size_t)r * D + col] : ((const float*)(ws + WS_XC))[(size_t)(r - ML) * D + col];
    if (lane == 0 && dbg_bad(got, base + 0.5f * gt.x * a, 0.02f, 0.01f)) dbg_flag((unsigned*)(ws + WS_CTL), 4u);
}
__device__ __noinline__ void dbg_check_fourier(unsigned char* ws, const float* xl, const float* nw, const float* modb, LAS float* red) {
    const int lane = threadIdx.x & 63, wave = threadIdx.x >> 6;
    if (blockIdx.x >= 40) return;
    const unsigned h = dbg_hash(blockIdx.x + 555u); const bool isc = blockIdx.x >= 32;
    const int L = isc ? CTXL : SEQ, b = h & 1, k = (int)((h >> 1) % (unsigned)L), g = (h >> 17) & 7, ch = (h >> 20) & 255;
    const float* xb = isc ? (const float*)(ws + WS_XC) + (size_t)b * CTXL * D : xl + (size_t)b * SEQ * D; const int who = isc ? 2 : b;
    const ModRef MR{(const float*)(ws + WS_MODP), modb};
    const int c0 = g * 256 + lane * 4; const f32x4 sh = modv4(MR, 0, who, 3 * D + c0), sc = modv4(MR, 0, who, 4 * D + c0);
    float acc = 0.f;
    for (int n = wave; n < L; n += 8) { const float* xr = xb + (size_t)n * D;
        float ss = 0.f; for (int d = lane; d < D; d += 64) ss += xr[d] * xr[d];
        const float rstd = 1.0f / sqrtf(wave_sum(ss) / D + NORM_EPS);
        const float fl = (float)((k * n) % L) / (float)L;
        for (int e = 0; e < 4; ++e) { const int c = lane * 4 + e; float hv = xr[c0 + e] * rstd * nw[c0 + e] * (1.f + sc[e]) + sh[e]; hv = bflo(pk2(hv, 0.f));
            acc += hv * cospif(2.f * (fl + (float)((ch * c) & 255) * (1.f / 256.f))); } }
    acc = wave_sum(acc); if (lane == 0) red[wave] = acc; __syncthreads();
    if (threadIdx.x == 0) { float t = 0.f; for (int w = 0; w < 8; ++w) t += red[w]; t *= isc ? (1.f / 256.f) : (1.f / 2048.f);
        const size_t row = isc ? (size_t)ML + b * CTXL + k : (size_t)b * SEQ + k; const float got = bf2f(((const bf16*)(ws + WS_ACT + ACT_HN))[row * D + g * 256 + ch]);
        if (dbg_bad(got, t, 0.04f, 0.02f)) dbg_flag((unsigned*)(ws + WS_CTL), isc ? 6u : 5u); }
}
__device__ __noinline__ void dbg_check_rkv(unsigned char* ws, const float* wrkv) {
    const int lane = threadIdx.x & 63, gw = blockIdx.x * 8 + (threadIdx.x >> 6);
    if (gw >= 768) return;
    const unsigned h = dbg_hash(gw + 777u); const int wsel = gw % 3, r = (gw & 7) == 7 ? ML + (int)(h % MC) : (int)(h % ML), col = (int)((h >> 9) % D);
    const bf16* A = (const bf16*)(ws + WS_ACT + ACT_XM + (size_t)wsel * XM_STRIDE); const bf16* O = (const bf16*)(ws + WS_ACT + ACT_XM + (size_t)(3 + wsel) * XM_STRIDE);
    float a = 0.f; for (int k = lane; k < D; k += 64) a += bf2f(A[(size_t)r * D + k]) * wrkv[((size_t)wsel * D + k) * D + col];
    a = wave_sum(a);
    if (lane == 0 && dbg_bad(bf2f(O[(size_t)r * D + col]), a, 0.03f, 0.02f)) dbg_flag((unsigned*)(ws + WS_CTL), 8u);
}
__device__ __noinline__ void dbg_check_lora(unsigned char* ws, const float* w1, const float* a1, const float* g1) {
    const int lane = threadIdx.x & 63, gw = blockIdx.x * 8 + (threadIdx.x >> 6);
    if (gw >= 768) return;
    const unsigned h = dbg_hash(gw + 888u); const int which = gw % 3, r = (gw & 7) == 7 ? ML + (int)(h % MC) : (int)(h % ML);
    const int col = which == 2 ? (int)((h >> 9) % 256) : (int)((h >> 9) % 192);
    const bf16* A = (const bf16*)(ws + WS_ACT + ACT_XM + (size_t)(3 + which) * XM_STRIDE); const bf16* O = (const bf16*)(ws + WS_ACT + ACT_LR + (size_t)which * LR_STRIDE);
    float a = 0.f;
    for (int k = lane; k < D; k += 64) { const float wv = which == 2 ? g1[(size_t)k * 256 + col] : (which ? a1 : w1)[((size_t)(col / 96) * D + k) * LORA + (col % 96)]; a += bf2f(A[(size_t)r * D + k]) * wv; }
    a = wave_sum(a); const float ref = which == 0 ? tanhf(a) : (which == 2 ? 1.f / (1.f + expf(-a)) : a);
    if (lane == 0 && dbg_bad(bf2f(O[(size_t)r * 256 + col]), ref, 0.02f, 0.02f)) dbg_flag((unsigned*)(ws + WS_CTL), 9u);
}
__device__ __noinline__ void dbg_check_scan(unsigned char* ws, const float* p_w0, const float* p_a0, const float* p_kk, const float* p_ka, const float* p_w2, const float* p_a2) {
    const int lane = threadIdx.x & 63, gw = blockIdx.x * 8 + (threadIdx.x >> 6);
    if (gw >= 64) return;
    const unsigned hsh = dbg_hash(gw + 31337u); const int chain = hsh & 127, i = (hsh >> 8) & 63, b = chain >> 6, hd = (chain >> 1) & 31, z = chain & 1;
    const bf16* RKV = (const bf16*)(ws + WS_ACT + ACT_XM + 3 * XM_STRIDE);
    const bf16* TWb = (const bf16*)(ws + WS_ACT + ACT_LR); const bf16* TAb = (const bf16*)(ws + WS_ACT + ACT_LR + LR_STRIDE);
    const bf16* YB = (const bf16*)(ws + WS_ACT + (z ? ACT_YB1 : ACT_YB0));
    const int ch = hd * 64 + lane;
    const float w0 = p_w0[z * D + ch], a0 = p_a0[z * D + ch], kkc = p_kk[ch], kac = p_ka[ch];
    float st = 0.f; float worst = 0.f;
    for (int s_ = 0; s_ < CTXL + SEQ; ++s_) {
        const int row = scan_row(b, z, s_);
        float lwv = 0.f, lav = 0.f;
        for (int r = 0; r < LORA; ++r) { lwv += bf2f(TWb[(size_t)row * 256 + z * 96 + r]) * p_w2[((size_t)z * LORA + r) * D + ch]; lav += bf2f(TAb[(size_t)row * 256 + z * 96 + r]) * p_a2[((size_t)z * LORA + r) * D + ch]; }
        const float xw = w0 + lwv, logw = -log1pf(expf(-xw)) - 0.5f, dec = expf(-expf(logw));
        const float asig = 1.f / (1.f + expf(-(a0 + lav)));
        const float rj = bf2f(RKV[(size_t)row * D + ch]), kj = bf2f(RKV[(size_t)MT * D + (size_t)row * D + ch]), vi = bf2f(RKV[2 * (size_t)MT * D + (size_t)row * D + hd * 64 + i]);
        const float kr = kj * kkc; const float nrm = wave_sum(kr * kr); const float kkj = kr / sqrtf(fmaxf(nrm, 1e-24f));
        const float aj = -kkj, bj = kkj * asig, kdj = kj * (1.f + (asig - 1.f) * kac);
        const float sa = wave_sum(st * aj);
        st = st * dec + sa * bj + vi * kdj;
        const float y = wave_sum(st * rj);
        if (s_ >= CTXL) { const float got = bf2f(YB[(size_t)row * D + hd * 64 + i]); const float e = fabsf(got - y) / (0.05f + 0.03f * fabsf(y)); worst = fmaxf(worst, e); }
    }
    if (lane == 0 && !(worst <= 1.f)) dbg_flag((unsigned*)(ws + WS_CTL), 10u);
}
__device__ __noinline__ void dbg_check_combine(unsigned char* ws, const float* p_ka, const float* p_rk, const float* p_lnw, const float* p_lnb) {
    const int lane = threadIdx.x & 63, gw = blockIdx.x * 8 + (threadIdx.x >> 6);
    if (gw >= 256) return;
    const unsigned hsh = dbg_hash(gw + 4242u); const int r = (int)(hsh % ML), hd = (hsh >> 20) & 31, ch = hd * 64 + lane;
    const bf16* RKV = (const bf16*)(ws + WS_ACT + ACT_XM + 3 * XM_STRIDE);
    const float y = bf2f(((const bf16*)(ws + WS_ACT + ACT_YB0))[(size_t)r * D + ch]) + bf2f(((const bf16*)(ws + WS_ACT + ACT_YB1))[(size_t)r * D + ch]);
    const float mean = wave_sum(y) / 64.f, var = wave_sum((y - mean) * (y - mean)) / 64.f;
    const float rj = bf2f(RKV[(size_t)r * D + ch]), kj = bf2f(RKV[(size_t)MT * D + (size_t)r * D + ch]), vj = bf2f(RKV[2 * (size_t)MT * D + (size_t)r * D + ch]);
    const float* SA = (const float*)(ws + WS_SA);
    const float sb = wave_sum(rj * p_rk[ch] * kj * (1.f - p_ka[ch])) + 0.5f * (SA[(size_t)r * 32 + hd] + SA[((size_t)MT + r) * 32 + hd]);
    const float ref = (y - mean) / sqrtf(var + GN_EPS) * p_lnw[ch] + p_lnb[ch] + sb * vj;
    const float got = bf2f(((const bf16*)(ws + WS_ACT + ACT_PO))[(size_t)r * D + ch]);
    if (dbg_bad(got, ref, 0.03f, 0.02f)) dbg_flag((unsigned*)(ws + WS_CTL), 12u);
}
__device__ __noinline__ void dbg_final(unsigned char* ws, float* out) {
    const unsigned code = __hip_atomic_load((unsigned*)(ws + WS_CTL) + CW_DBG, __ATOMIC_RELAXED, __HIP_MEMORY_SCOPE_AGENT);
    if (code) for (size_t i = (size_t)blockIdx.x * 512 + threadIdx.x; i < (size_t)ML * D; i += (size_t)gridDim.x * 512) out[i] = 1000.f * code;
}
#define DBG_PHASE(stmt) PH_BEGIN stmt; PH_END
#else
#define DBG_PHASE(stmt)
#endif

constexpr int NPH = 42;
__global__ void __launch_bounds__(NWAVES * 64, 2) mk_fwd(const Args args) {
    const Args& AR = args;
    extern __shared__ __attribute__((aligned(16))) unsigned char lds[];
    Frame F;
    F.lds = (LAS unsigned char*)lds;
    F.MISC = (volatile LAS unsigned*)(F.lds + LDSCTL_OFF);
    F.G = gridDim.x; { const int bx = blockIdx.x; F.vcu = (F.G % 8 == 0) ? (bx % 8) * (F.G / 8) + bx / 8 : bx; }
    F.ws = args.ws; F.ctl = (unsigned*)(args.ws + WS_CTL); F.out = args.out;
    F.modb = args.in[5];
    if (threadIdx.x < 16) ((LAS unsigned*)(F.lds + LDSCTL_OFF))[threadIdx.x] = 0u;
    __syncthreads();
    XcdBarrier bar; bar.bar = F.ctl + CW_BAR; bar.x = 0; bar.st = nullptr;
    if (!MK_PER_PHASE) bar = xcd_barrier_post(F.ctl + CW_BAR, F.MISC + 8);
    const int lo = args.ph_lo, hi = args.ph_hi;
    int ph = 0;
#define PH_BEGIN if (ph >= lo && ph < hi) {
#define PH_END   if (ph + 1 < hi) { if (MK_PER_PHASE) { if (threadIdx.x == 0) __hip_atomic_store(F.ctl + 0, 0xBADu, __ATOMIC_RELAXED, __HIP_MEMORY_SCOPE_AGENT); } else { xcd_barrier(bar); if (MK_PROBE & 16384) xcd_barrier(bar); } } } ++ph;

    float* XC = (float*)(F.ws + WS_XC);
    const ModRef MR{(const float*)(F.ws + WS_MODP), args.in[5], (const float*)(F.ws + WS_MODV)};
    bf16* HN = (bf16*)(F.ws + WS_ACT + ACT_HN);
    bf16* HB = (bf16*)(F.ws + WS_ACT + ACT_H);
    bf16* HNA = (bf16*)(F.ws + WS_ACT + 500 * MiB);
    float* PSB = (float*)(F.ws + WS_PS); float* RSTD = (float*)(F.ws + WS_RSTD);

    REP(16) PH_BEGIN p0_prologue(F, args); PH_END
    DBG_PHASE(dbg_check_mod(F.ws, AR.in[1], AR.in[3], AR.in[4], AR.in[5]))

#define FFN_STAGE(s_) do { constexpr int s = (s_); constexpr int layer = s >> 1, f = s & 1; constexpr int Mrows = (s == 3) ? ML : MT; \
        const float* srcL = (s == 0) ? AR.in[0] : F.out; const float* srcC = XC; \
        bf16* HNs = (s & 1) ? HNA : HN;        \
        if (s == 0) { REP(4) PH_BEGIN phase_norm<true, true>(F, srcL, srcC, 0, Mrows, AR.in[6] + (size_t)(layer * 3 + (f ? 2 : 0)) * D, layer, f ? 6 : 0, HNs); PH_END } \
        else if (s != 3) { PH_BEGIN phase_norm<true>(F, srcL, srcC, ML, Mrows, AR.in[6] + (size_t)(layer * 3 + (f ? 2 : 0)) * D, layer, f ? 6 : 0, HNs); PH_END }        \
        if (s == 0) { DBG_PHASE(dbg_check_hn(F.ws, AR.in[0], AR.in[2], AR.in[6], AR.in[5], 0, 0, 2u)) } \
        REP(s == 0 ? 2 : 0) PH_BEGIN { \
            OpBlk A{HNs, D / 64, true}, B{(const bf16*)(F.ws + (layer ? WS_WL1 : WS_WL0) + (size_t)f * 44 * MiB), D / 64, false}; \
            pg8::StaticOrder S; S.init(Mrows / 256, DFF / 128, F.G, (int)blockIdx.x); \
            EpiSwiGLU E{HB}; \
            pg8::gemm_phase(F.lds + RING_OFF, D, A, B, S, E); \
        } PH_END \
        if (s == 0) { DBG_PHASE(dbg_check_h(F.ws, AR.in[7])) } \
        PH_BEGIN { \
            OpHBlk A{HB, -1, 0}; OpBlk B{(const bf16*)(F.ws + (layer ? WS_WL1 : WS_WL0) + 88 * MiB + (size_t)f * 22 * MiB), HKT, false}; \
            pg8::StaticOrder S; S.init(ML / 256, D / 256, F.G, (int)blockIdx.x, 4, 0, 1); \
              \
            constexpr int NX = (s == 0) ? 2 : (s == 1) ? 1 : (s == 2) ? 3 : 4; constexpr int site = (s == 0) ? 0 : (s == 1) ? 2 : (s == 2) ? 3 : 5; \
            const float* nwn = (s == 0) ? AR.in[6] + (size_t)(0 * 3 + 1) * D : (s == 1) ? AR.in[6] + (size_t)(1 * 3 + 0) * D : AR.in[27]; \
            EpiResidNorm<false, true, NX> E{MR, srcL, F.out, nullptr, layer, f ? 8 : 2, nwn, (s == 0) ? 0 : 1, (s == 0) ? 3 : 0, HN, RSTD, PSB + (size_t)site * 262144, F.ctl + CW_PCNT + site * 1024, F.lds + RING_BYTES}; \
            pg8::gemm_phase(F.lds + RING_OFF, DFF, A, B, S, E); \
            if (Mrows > ML) { OpHBlk Ac{HB, 128, HKT / 4}; OpBlkK Bc{(const bf16*)(F.ws + (layer ? WS_WL1 : WS_WL0) + 88 * MiB + (size_t)f * 22 * MiB), HKT}; \
                OrderCtxK Sc{F.G, (int)blockIdx.x}; EpiCtxAtomic<false, true> Ec{MR, XC, nullptr, layer, f ? 8 : 2}; \
                pg8::gemm_phase(F.lds + RING_OFF, DFF / 4, Ac, Bc, Sc, Ec); } \
        } PH_END \
        if (s == 0) { DBG_PHASE(dbg_check_w2(F.ws, AR.in[0], AR.in[2], F.out, AR.in[8], AR.in[5])) } \
    } while (0)

    FFN_STAGE(0);
        {
            bf16* YT = (bf16*)(F.ws + WS_ACT + ACT_YT); bf16* T2 = (bf16*)(F.ws + WS_ACT + ACT_T2); bf16* YC = (bf16*)(F.ws + WS_ACT + ACT_YC);
            PH_BEGIN phase_norm<false>(F, F.out, XC, ML, MT, AR.in[6] + (size_t)(0 * 3 + 1) * D, 0, 3, HN); PH_END
            REP(64) PH_BEGIN {
                { OpFixed A{(const bf16*)(F.ws + WS_TAB + TAB_DMAT), 256, 1}; OpChanL B{HN}; pg8::StaticOrder S; S.init(16, 128, F.G, (int)blockIdx.x); EpiChanL E{YT};
                  pg8::gemm_phase(F.lds + RING_OFF, 256, A, B, S, E); }
                { OpFixed A{(const bf16*)(F.ws + WS_TAB + TAB_DMAT), 256, 1}; OpChanC B{HN}; pg8::StaticOrder S; S.init(16, 2, F.G, (int)blockIdx.x); EpiChanC E{YC};
                  pg8::gemm_phase(F.lds + RING_OFF, 256, A, B, S, E); }
            } PH_END
            REP(64) PH_BEGIN {
                { OpFixed A{(const bf16*)(F.ws + WS_TAB + TAB_M1), 256, 0}; pg8::OpPlain B{YT, 256, false}; pg8::StaticOrder S; S.init(1, 2048, F.G, (int)blockIdx.x); EpiStage1 E{T2, (const float*)(F.ws + WS_TAB + TAB_TW)};
                  pg8::gemm_phase(F.lds + RING_OFF, 256, A, B, S, E); }
                { OpFixed A{(const bf16*)(F.ws + WS_TAB + TAB_M3), 512, 0}; pg8::OpPlain B{YC, 512, false}; pg8::StaticOrder S; S.init(1, 16, F.G, (int)blockIdx.x); EpiCtxDft E{HN};
                  pg8::gemm_phase(F.lds + RING_OFF, 512, A, B, S, E); }
            } PH_END
            REP(64) PH_BEGIN {
                OpFixed A{(const bf16*)(F.ws + WS_TAB + TAB_M2), 256, 0}; OpStage2B B{T2}; pg8::StaticOrder S; S.init(1, 2048, F.G, (int)blockIdx.x); EpiStage2 E{HN};
                pg8::gemm_phase(F.lds + RING_OFF, 256, A, B, S, E);
            } PH_END
            DBG_PHASE(dbg_check_fourier(F.ws, F.out, AR.in[6] + D, AR.in[5], (LAS float*)F.lds))
            PH_BEGIN {
                pg8::OpPlain A{HN, D, true}, B{(const bf16*)(F.ws + WS_WFO), D, false};
                pg8::StaticOrder S; S.init(ML / 256, D / 256, F.G, (int)blockIdx.x, 4);
                EpiResidNorm<true, false, 1> E{MR, F.out, F.out, AR.in[10], 0, 5, AR.in[6] + (size_t)(0 * 3 + 2) * D, 0, 6, HNA, RSTD, PSB + (size_t)1 * 262144, F.ctl + CW_PCNT + 1 * 1024, F.lds + RING_BYTES};
                pg8::gemm_phase(F.lds + RING_OFF, D, A, B, S, E);
                OpKSplit Ac{HN + (size_t)ML * D, D, D / 4, true}, Bc{(const bf16*)(F.ws + WS_WFO), D, D / 4, false};
                OrderCtxK Sc{F.G, (int)blockIdx.x}; EpiCtxAtomic<true, false> Ec{MR, XC, AR.in[10], 0, 5};
                pg8::gemm_phase(F.lds + RING_OFF, D / 4, Ac, Bc, Sc, Ec);
            } PH_END
        }
    FFN_STAGE(1);
    FFN_STAGE(2);
    {
        bf16* XM = (bf16*)(F.ws + WS_ACT + ACT_XM); bf16* LR = (bf16*)(F.ws + WS_ACT + ACT_LR); bf16* PO = (bf16*)(F.ws + WS_ACT + ACT_PO);
        REP(8) PH_BEGIN phase_rowstats(F, F.out, XC, RSTD, ML); PH_END
        REP(4096) PH_BEGIN phase_mix(F, MR, F.out, XC, RSTD, AR.in[6] + (size_t)(1 * 3 + 1) * D, AR.in[11], XM); PH_END
        REP(128) PH_BEGIN {
            OpXM A{XM, 1, 3}; OpWSel B{(const bf16*)(F.ws + WS_WSMALL), 1, 1 * MiB}; pg8::StaticOrder S; S.init(MT / 256, 3, F.G, (int)blockIdx.x); EpiLora E{LR};
            pg8::gemm_phase(F.lds + RING_OFF, D, A, B, S, E);
            { OpXM Ac{XM, 8, 0}; OpWSel Bc{(const bf16*)(F.ws + WS_WRKV), 8, 8 * MiB}; pg8::StaticOrder Sc; Sc.init(2, 24, F.G, (int)((blockIdx.x + F.G - 140) % F.G), pg8::WGM, 128); EpiRkvC Ec{(bf16*)(F.ws + WS_RKVC)};
              pg8::gemm_phase(F.lds + RING_OFF, D, Ac, Bc, Sc, Ec); }
        } PH_END
        DBG_PHASE(dbg_check_lora(F.ws, AR.in[14], AR.in[17], AR.in[19]))
        REP(512) PH_BEGIN {
            OpXM A{XM, 8, 0}; OpWSel B{(const bf16*)(F.ws + WS_WRKV), 8, 8 * MiB}; pg8::StaticOrder S; S.init(ML / 256, 24, F.G, (int)blockIdx.x); EpiRkv E{XM};
            pg8::gemm_phase(F.lds + RING_OFF, D, A, B, S, E);
        } PH_END
        DBG_PHASE(dbg_check_rkv(F.ws, AR.in[12]))
        REP(1)
#pragma unroll 1
        for (int w = 0; w <= SCAN_NW; ++w) { PH_BEGIN phase_scan_step(F, args, w); PH_END }
        DBG_PHASE(dbg_check_scan(F.ws, AR.in[13], AR.in[16], AR.in[21], AR.in[22], AR.in[15], AR.in[18]))
        DBG_PHASE(dbg_check_combine(F.ws, AR.in[22], AR.in[23], AR.in[24], AR.in[25]))
        PH_BEGIN {
            pg8::OpPlain A{(const bf16*)((const char*)LR + 2 * LR_STRIDE), 256, true}, B{(const bf16*)(F.ws + WS_WSMALL + WSM_G2T), 256, false};
            pg8::StaticOrder S; S.init(ML / 256, D / 256, F.G, (int)blockIdx.x);
            EpiCombGate E{PO, (const bf16*)(F.ws + WS_ACT + ACT_YB0), (const bf16*)(F.ws + WS_ACT + ACT_YB1), (const bf16*)(F.ws + WS_ACT + ACT_XM + 5 * XM_STRIDE), (const float*)(F.ws + WS_SA), AR.in[24], AR.in[25], F.lds + RING_BYTES};
            pg8::gemm_phase(F.lds + RING_OFF, 256, A, B, S, E);
        } PH_END
        PH_BEGIN {
            pg8::OpPlain A{PO, D, true}, B{(const bf16*)(F.ws + WS_WRO), D, false};
            pg8::StaticOrder S; S.init(ML / 256, D / 256, F.G, (int)blockIdx.x, 4);
            EpiResidNorm<false, false, 1> E{MR, F.out, F.out, nullptr, 1, 5, AR.in[6] + (size_t)(1 * 3 + 2) * D, 1, 6, HNA, RSTD, PSB + (size_t)4 * 262144, F.ctl + CW_PCNT + 4 * 1024, F.lds + RING_BYTES};
            pg8::gemm_phase(F.lds + RING_OFF, D, A, B, S, E);
        } PH_END
    }
    FFN_STAGE(3);
    DBG_PHASE(dbg_final(F.ws, F.out))
#undef PH_BEGIN
#undef PH_END
}

extern "C" void kernel_launch(void* const* d_in, const int* in_sizes, int n_in, void* d_out, int out_size, void* d_ws, size_t ws_size, hipStream_t stream) {
    static int grid = 0;
    if (grid == 0) {
        if (n_in != 28 || out_size != ML * D || ws_size < WS_END) { fprintf(stderr, "kernel_launch: unexpected shapes (n_in %d, out %d, ws %zu < %zu)\n", n_in, out_size, ws_size, (size_t)WS_END); grid = -1; return; }
        int dev = 0, cus = 0, per_cu = 0;
        if (hipGetDevice(&dev) != hipSuccess || hipDeviceGetAttribute(&cus, hipDeviceAttributeMultiprocessorCount, dev) != hipSuccess) { grid = -1; return; }
        if (hipFuncSetAttribute((const void*)mk_fwd, hipFuncAttributeMaxDynamicSharedMemorySize, LDS_BYTES) != hipSuccess) { fprintf(stderr, "kernel_launch: hipFuncSetAttribute failed\n"); grid = -1; return; }
        if (hipOccupancyMaxActiveBlocksPerMultiprocessor(&per_cu, (const void*)mk_fwd, NWAVES * 64, LDS_BYTES) != hipSuccess || per_cu < 1)
            fprintf(stderr, "kernel_launch: occupancy query reports %d per CU\n", per_cu);
        (void)hipGetLastError();
        grid = cus;
        if (cus != 256) { fprintf(stderr, "kernel_launch: built for a 256-CU device (the scan phase maps its 256 chains-halves onto 256 workgroups); found %d CUs, nothing launched\n", cus); grid = -1; return; }
    }
    if (grid < 0) return;
    if (hipMemsetAsync((char*)d_ws + WS_CTL, 0, CTL_ZERO_BYTES, stream) != hipSuccess) return;
    Args a{};
    for (int i = 0; i < 28; ++i) a.in[i] = (const float*)d_in[i];
    a.out = (float*)d_out; a.ws = (unsigned char*)d_ws;
#if MK_PER_PHASE
    for (int p = 0; p < NPH; ++p) { a.ph_lo = p; a.ph_hi = p + 1; hipLaunchKernelGGL(mk_fwd, dim3(grid), dim3(NWAVES * 64), LDS_BYTES, stream, a); }
#else
    a.ph_lo = 0; a.ph_hi = 100000;
    hipLaunchKernelGGL(mk_fwd, dim3(grid), dim3(NWAVES * 64), LDS_BYTES, stream, a);
#endif
}
```

```cpp
#include <hip/hip_runtime.h>
#include <cstdio>
#include <cstdint>

#ifndef MK_PER_PHASE
#define MK_PER_PHASE 0
#endif
#ifndef MK_PROBE
#define MK_PROBE 0
#endif
#define REP(mask) _Pragma("unroll 1") for (int rep_ = 0; rep_ < ((MK_PROBE & (mask)) ? 2 : 1); ++rep_)
#ifndef MK_DEBUG
#define MK_DEBUG 0
#endif

#define GAS __attribute__((address_space(1)))
#define LAS __attribute__((address_space(3)))
typedef unsigned short bf16;
typedef unsigned v4u __attribute__((ext_vector_type(4)));
typedef unsigned v2u __attribute__((ext_vector_type(2)));
typedef float f32x4 __attribute__((ext_vector_type(4)));
typedef float f32x2 __attribute__((ext_vector_type(2)));
typedef float f32x16 __attribute__((ext_vector_type(16)));
typedef short bf16x8 __attribute__((ext_vector_type(8)));
typedef __bf16 bf2_t __attribute__((ext_vector_type(2)));

constexpr int D = 2048, NBATCH = 2, SEQ = 16384, CTXL = 256, DFF = 5632, NMODV = 9 * 2048, NH = 32, HD = 64;
constexpr int ML = NBATCH * SEQ, MC = NBATCH * CTXL, MT = ML + MC;
constexpr int LORA = 96;
constexpr int HKT = DFF / 64;
constexpr int NWAVES = 8;
constexpr float NORM_EPS = 1e-6f, GN_EPS = 64e-5f;

constexpr size_t MiB = 1u << 20;
constexpr size_t WS_CTL = 0, CTL_ZERO_BYTES = 64 * 1024;
constexpr size_t WS_MODP = 1 * MiB;
constexpr size_t WS_TAB = 3 * MiB;
constexpr size_t TAB_DMAT = 0, TAB_M1 = 262144, TAB_M2 = 393216, TAB_M3 = 524288, TAB_TW = 786432;
constexpr size_t WS_RSTD = 4 * MiB;
constexpr size_t WS_SA = 5 * MiB;
constexpr size_t WS_XC = 14 * MiB;
constexpr size_t WS_WSMALL = 18 * MiB;
constexpr size_t WSM_W1CAT = 0, WSM_A1CAT = 1 * MiB, WSM_G1T = 2 * MiB, WSM_W2UP = 3 * MiB, WSM_A2UP = 4 * MiB, WSM_G2T = 5 * MiB;
constexpr size_t WS_WFO = 24 * MiB, WS_WRO = 32 * MiB, WS_WRKV = 40 * MiB;
constexpr size_t WS_WL0 = 64 * MiB, WS_WL1 = 196 * MiB;
constexpr size_t WS_ACT = 328 * MiB;
constexpr size_t ACT_HN = 0, ACT_H = 130 * MiB;
constexpr size_t ACT_YT = 130 * MiB, ACT_T2 = 386 * MiB, ACT_YC = 642 * MiB;
constexpr size_t ACT_XM = 0, XM_STRIDE = 130 * MiB, ACT_LR = 780 * MiB, LR_STRIDE = 17039360;
constexpr size_t ACT_WBUF = 0, WBUF_STRIDE = 184 * MiB, ACT_YB0 = WS_WL0 - WS_ACT  , ACT_YB1 = 829 * MiB, ACT_PO = 0;
constexpr size_t WS_SST = WS_ACT + 957 * MiB;
constexpr size_t WS_RKVC = WS_SST + 2 * MiB;
constexpr size_t WS_PS = WS_RKVC + 6 * MiB;
constexpr size_t WS_MODV = WS_PS + 6 * MiB;
constexpr size_t WS_DUMP = WS_MODV + 1 * MiB;
constexpr size_t WS_END = WS_DUMP + 16 * MiB;
static_assert(WS_END <= 1476395008ull, "workspace map exceeds the guaranteed minimum");
static_assert((size_t)MT * D * 2 == 130 * MiB, "XM size");

constexpr int CW_DBG = 8;
constexpr int CW_BAR = 4096;
constexpr int CW_PCNT = 8192;

#define LDS_WAIT() asm volatile("s_waitcnt lgkmcnt(0)" ::: "memory")
#define VM_WAIT() asm volatile("s_waitcnt vmcnt(0)" ::: "memory")
__device__ __forceinline__ unsigned pk2(float lo, float hi) { f32x2 v = {lo, hi}; bf2_t b = __builtin_convertvector(v, bf2_t); return __builtin_bit_cast(unsigned, b); }
__device__ __forceinline__ float bf2f(bf16 b) { return __uint_as_float(((unsigned)b) << 16); }
__device__ __forceinline__ float bflo(unsigned w) { return __uint_as_float(w << 16); }
__device__ __forceinline__ float bfhi(unsigned w) { return __uint_as_float(w & 0xffff0000u); }
__device__ __forceinline__ float wave_sum(float v) {
#pragma unroll
    for (int o = 1; o < 64; o <<= 1) v += __shfl_xor(v, o);
    return v;
}
__device__ __forceinline__ float sigmoidf_(float x) { return __builtin_amdgcn_rcpf(1.f + __expf(-x)); }

#define XB_TMO      128
#define XB_XCNT(j)  (256  + 64 * (j))
#define XB_XSUB(j)  (1280 + 64 * (j))
#define XB_XGEN(j)  (2304 + 64 * (j))
#define XB_TOP      3328
#define XB_TOPGEN   3392
#define XCD_BAR_WORDS 3456
#define XB_SPIN_CAP (1u << 22)

__device__ __forceinline__ unsigned xb_ld(unsigned* p)              { return __hip_atomic_load(p, __ATOMIC_RELAXED, __HIP_MEMORY_SCOPE_AGENT); }
__device__ __forceinline__ unsigned xb_add(unsigned* p, unsigned v) { return __hip_atomic_fetch_add(p, v, __ATOMIC_RELAXED, __HIP_MEMORY_SCOPE_AGENT); }
__device__ __forceinline__ unsigned xb_xcc_id() { return (unsigned)__builtin_amdgcn_s_getreg((3 << 11) | 20) & 0xFu; }
#define XB_SPIN(cond, bar) do { unsigned _sp = 0; while (cond) { __builtin_amdgcn_s_sleep(1); \
    if ((++_sp & 255u) == 0u) { if (xb_ld(&(bar)[XB_TMO])) break; if (_sp > XB_SPIN_CAP) { atomicAdd(&(bar)[XB_TMO], 1u); break; } } } } while (0)

struct XcdBarrier { unsigned* bar; unsigned x; volatile LAS unsigned* st; };

__device__ __forceinline__ XcdBarrier xcd_barrier_post(unsigned* bar, volatile LAS unsigned* st) {
    XcdBarrier b; b.bar = bar; b.x = xb_xcc_id(); b.st = st;
    if (threadIdx.x == 0) (void)xb_add(&bar[XB_XCNT(b.x)], 1u);
    return b;
}
__device__ __forceinline__ void xcd_barrier_complete(unsigned* bar, unsigned x, unsigned& nloc, unsigned& nx) {
    const unsigned G = gridDim.x * gridDim.y * gridDim.z;
    unsigned sum, cnt, mine, sp = 0u;
    for (;;) {
        sum = 0u; cnt = 0u; mine = 0u;
#pragma unroll
        for (unsigned j = 0; j < 16; ++j) { const unsigned c = xb_ld(&bar[XB_XCNT(j)]); sum += c; cnt += (c > 0u) ? 1u : 0u; mine = (j == x) ? c : mine; }
        if (sum == G) break;
        __builtin_amdgcn_s_sleep(1);
        if ((++sp & 255u) == 0u) { if (xb_ld(&bar[XB_TMO])) break; if (sp > XB_SPIN_CAP) { atomicAdd(&bar[XB_TMO], 1u); break; } }
    }
    nloc = mine > 0u ? mine : 1u; nx = cnt > 0u ? cnt : 1u;
}
__device__ __forceinline__ void xcd_barrier(const XcdBarrier& b) {
    asm volatile("s_waitcnt vmcnt(0)" ::: "memory");
    __syncthreads();
    if (threadIdx.x == 0) {
        unsigned* bar = b.bar;
        __builtin_amdgcn_s_waitcnt(0);
        unsigned nloc = b.st[0], nx = b.st[1];
        if (nloc == 0u) { xcd_barrier_complete(bar, b.x, nloc, nx); b.st[0] = nloc; b.st[1] = nx; }
        const unsigned old = xb_add(&bar[XB_XSUB(b.x)], 1u);
        const unsigned gen = old / nloc;
        if (old + 1u == (gen + 1u) * nloc) {
            __builtin_amdgcn_fence(__ATOMIC_RELEASE, "agent");
            asm volatile("s_waitcnt vmcnt(0)" ::: "memory");
            const unsigned og = xb_add(&bar[XB_TOP], 1u);
            const unsigned tg = og / nx;
            if (og + 1u == (tg + 1u) * nx) xb_add(&bar[XB_TOPGEN], 1u);
            else XB_SPIN(xb_ld(&bar[XB_TOPGEN]) == tg, bar);
            __builtin_amdgcn_fence(__ATOMIC_ACQUIRE, "agent");
            xb_add(&bar[XB_XGEN(b.x)], 1u);
            asm volatile("s_waitcnt vmcnt(0)" ::: "memory");
        } else {
            XB_SPIN(xb_ld(&bar[XB_XGEN(b.x)]) == gen, bar);
            __builtin_amdgcn_fence(__ATOMIC_ACQUIRE, "agent");
            asm volatile("s_waitcnt vmcnt(0)" ::: "memory");
        }
    }
    __syncthreads();
}

namespace pg8 {
constexpr int BM = 256, BK = 64, HALF = 128, HTB = HALF * BK * 2, STAGE_BYTES = 8 * HTB, NXCD = 8, WGM = 8;
__host__ __device__ __forceinline__ int lds_byte(int r, int c) { const int st = (r >> 4) * 2 + (c >> 5), rr = r & 15, cc = c & 31, ob = rr * 64 + cc * 2; return st * 1024 + (ob ^ (((ob >> 9) & 1) << 5)); }
__host__ __device__ __forceinline__ void stage_rc(int b, int& R, int& C) { const int st = b / 1024, sb = b % 1024, swz = sb ^ (((sb >> 9) & 1) << 5); R = (st >> 1) * 16 + swz / 64; C = (st & 1) * 32 + (swz % 64) / 2; }
__host__ __device__ __forceinline__ int perm32(int rho) { const int n = rho >> 4, i = rho & 15; return 8 * (i >> 2) + 4 * n + (i & 3); }

struct Unit { int pm, pn; };
struct StaticOrder {
    int nM, nN, nwg, G, c, wgm, pm0, rev;
    __host__ __device__ void init(int nM_, int nN_, int G_, int c_, int wgm_ = WGM, int pm0_ = 0, int rev_ = 0) { nM = nM_; nN = nN_; nwg = nM * nN; G = G_; c = c_; wgm = wgm_; pm0 = pm0_; rev = rev_; }
    __host__ __device__ bool next(int i, Unit& u) const {
        const long L = (long)i * G + c; if (L >= nwg) return false;
        int wgid = (int)L; { const int q = nwg / NXCD, r = nwg % NXCD, xcd = wgid % NXCD, off = wgid / NXCD; wgid = (xcd < r ? xcd * (q + 1) : r * (q + 1) + (xcd - r) * q) + off; }
        const int nig = wgm * nN, gid = wgid / nig, fm = gid * wgm, gsz = (nM - fm) < wgm ? (nM - fm) : wgm;
        const int pmi = fm + ((wgid % nig) % gsz); u.pm = pm0 + (rev ? nM - 1 - pmi : pmi); u.pn = (wgid % nig) / gsz; return true;
    }
};
struct OpPlain {
    const bf16* base; int ld; bool isA;
    __device__ __forceinline__ const char* tile(const Unit& u) const { return (const char*)base + (size_t)(isA ? u.pm : u.pn) * 256 * ld * 2; }
    __device__ __forceinline__ unsigned voff(int R, int C) const { return (unsigned)(R * ld + C) * 2u; }
    __device__ __forceinline__ size_t hstep() const { return (size_t)HALF * ld * 2; }
    __device__ __forceinline__ size_t kstep() const { return 128; }
};

template <class AOp, class BOp, class Epi, class Sched>
__device__ __forceinline__ void gemm_phase(LAS unsigned char* lds, const int K, const AOp& Aop, const BOp& Bop, const Sched& S, const Epi& E) {
    int tid = threadIdx.x; asm volatile("" : "+v"(tid));
    const int wid = __builtin_amdgcn_readfirstlane(tid >> 6), lane = tid & 63, wr = wid >> 2, wc = wid & 3, fr = lane & 15, fq = lane >> 4;
    int nt = K / BK; asm volatile("" : "+s"(nt));
    unsigned voffA[2], voffB[2];
#pragma unroll
    for (int i = 0; i < 2; ++i) { int R, C; stage_rc(tid * 16 + i * 8192, R, C); const int Rb = Epi::PERM ? ((R & ~31) + perm32(R & 31)) : R;
        voffA[i] = Aop.voff(R, C); voffB[i] = Bop.voff(Rb, C); }
    const size_t kstepA = Aop.kstep(), kstepB = Bop.kstep();
    const size_t hstepA = Aop.hstep(), hstepB = Bop.hstep();
    const unsigned ldsw = (unsigned)wid * 1024u;
    const int aoff = lds_byte(wr * 64 + fr, fq * 8), boff = lds_byte(wc * 32 + fr, fq * 8);
#define PG8_SA(b, h) (((b) * 2 + (h)) * HTB)
#define PG8_SB(b, h) ((4 + (b) * 2 + (h)) * HTB)
#define PG8_STAGE(bufoff, gbase, voff) do { _Pragma("unroll") for (int _i = 0; _i < 2; ++_i) \
        __builtin_amdgcn_global_load_lds((const unsigned*)((const char*)(gbase) + (voff)[_i]), (LAS unsigned*)(lds + (bufoff) + ldsw + _i * 8192), 16, 0, 0); } while (0)
#define PG8_LDA(dst, b, h) do { _Pragma("unroll") for (int m = 0; m < 4; ++m) _Pragma("unroll") for (int k = 0; k < 2; ++k) dst[m][k] = *(const LAS bf16x8*)(lds + PG8_SA(b, h) + aoff + m * 2048 + k * 1024); } while (0)
#define PG8_LDB(dst, b, h) do { _Pragma("unroll") for (int n = 0; n < 2; ++n) _Pragma("unroll") for (int k = 0; k < 2; ++k) dst[n][k] = *(const LAS bf16x8*)(lds + PG8_SB(b, h) + boff + n * 2048 + k * 1024); } while (0)
#define PG8_MMA(ai, bj, At, Bt) do { __builtin_amdgcn_s_setprio(1); _Pragma("unroll") for (int m = 0; m < 4; ++m) _Pragma("unroll") for (int n = 0; n < 2; ++n) _Pragma("unroll") for (int k = 0; k < 2; ++k) \
        acc[ai][bj][m][n] = __builtin_amdgcn_mfma_f32_16x16x32_bf16(Bt[n][k], At[m][k], acc[ai][bj][m][n], 0, 0, 0); __builtin_amdgcn_s_setprio(0); } while (0)
#define PG8_WAIT_V(n) asm volatile("s_waitcnt vmcnt(" #n ")" ::: "memory")
#define PG8_WAIT_L(n) asm volatile("s_waitcnt lgkmcnt(" #n ")" ::: "memory")
#define PG8_BAR __builtin_amdgcn_s_barrier()
#define PG8_SCHED __builtin_amdgcn_sched_barrier(0)
    Unit cur, nxt; int ui = 0;
    if (!S.next(0, cur)) return;
    f32x4 acc[2][2][4][2];
#pragma unroll
    for (int a = 0; a < 2; ++a)
#pragma unroll
        for (int b = 0; b < 2; ++b)
#pragma unroll
            for (int m = 0; m < 4; ++m)
#pragma unroll
                for (int n = 0; n < 2; ++n) acc[a][b][m][n] = (f32x4){0.f, 0.f, 0.f, 0.f};
    bf16x8 At[4][2], B0[2][2], B1[2][2];
    const char* cA = Aop.tile(cur); const char* cB = Bop.tile(cur);
    PG8_STAGE(PG8_SB(0, 0), cB, voffB); PG8_STAGE(PG8_SB(0, 1), cB + hstepB, voffB); PG8_STAGE(PG8_SA(0, 0), cA, voffA); PG8_STAGE(PG8_SA(0, 1), cA + hstepA, voffA);
    if (wr == 1) PG8_BAR;
    PG8_WAIT_V(2); PG8_BAR;
    PG8_STAGE(PG8_SB(1, 0), cB + kstepB, voffB); PG8_STAGE(PG8_SA(1, 0), cA + kstepA, voffA); PG8_STAGE(PG8_SB(1, 1), cB + hstepB + kstepB, voffB);
    PG8_WAIT_V(6); PG8_BAR;
    for (;;) {
        const bool has_next = S.next(ui + 1, nxt);
        const char* nA = has_next ? Aop.tile(nxt) : cA; const char* nB = has_next ? Bop.tile(nxt) : cB;
#pragma unroll 1
        for (int t = 0; t < nt; t += 2) {
            const bool last = (t == nt - 2);
            const char* a1 = cA + (size_t)(t + 1) * kstepA;
            const char* a2 = last ? nA : cA + (size_t)(t + 2) * kstepA; const char* b2 = last ? nB : cB + (size_t)(t + 2) * kstepB;
            const char* a3 = a2 + kstepA; const char* b3 = b2 + kstepB;
            PG8_LDB(B0, 0, 0); PG8_LDB(B1, 0, 1); PG8_SCHED; PG8_LDA(At, 0, 0); PG8_STAGE(PG8_SA(1, 1), a1 + hstepA, voffA);
            PG8_WAIT_V(8); PG8_WAIT_L(0); PG8_BAR; PG8_MMA(0, 0, At, B0); PG8_MMA(0, 1, At, B1); PG8_BAR; PG8_SCHED;
            PG8_LDA(At, 0, 1); PG8_STAGE(PG8_SB(0, 0), b2, voffB); PG8_STAGE(PG8_SB(0, 1), b2 + hstepB, voffB); PG8_STAGE(PG8_SA(0, 0), a2, voffA);
            PG8_WAIT_V(8); PG8_WAIT_L(0); PG8_BAR; PG8_MMA(1, 0, At, B0); PG8_MMA(1, 1, At, B1); PG8_BAR; PG8_SCHED;
            PG8_LDB(B0, 1, 0); PG8_LDB(B1, 1, 1); PG8_SCHED; PG8_LDA(At, 1, 0); PG8_STAGE(PG8_SA(0, 1), a2 + hstepA, voffA);
            PG8_WAIT_V(8); PG8_WAIT_L(0); PG8_BAR; PG8_MMA(0, 0, At, B0); PG8_MMA(0, 1, At, B1); PG8_BAR; PG8_SCHED;
            PG8_LDA(At, 1, 1); PG8_STAGE(PG8_SB(1, 0), b3, voffB); PG8_STAGE(PG8_SB(1, 1), b3 + hstepB, voffB); PG8_STAGE(PG8_SA(1, 0), a3, voffA);
            PG8_WAIT_V(8); PG8_WAIT_L(0); PG8_BAR; PG8_MMA(1, 0, At, B0); PG8_MMA(1, 1, At, B1); PG8_BAR; PG8_SCHED;
        }
        if (wr == 0) PG8_BAR;
        E(acc, cur, wr, wc, fr, fq);
        if (!has_next) break;
#pragma unroll
        for (int a = 0; a < 2; ++a)
#pragma unroll
            for (int b = 0; b < 2; ++b)
#pragma unroll
                for (int m = 0; m < 4; ++m)
#pragma unroll
                    for (int n = 0; n < 2; ++n) acc[a][b][m][n] = (f32x4){0.f, 0.f, 0.f, 0.f};
        cur = nxt; cA = nA; cB = nB; ++ui;
        if (wr == 1) PG8_BAR;
    }
    PG8_WAIT_V(0);
    PG8_BAR;
#undef PG8_SA
#undef PG8_SB
#undef PG8_STAGE
#undef PG8_LDA
#undef PG8_LDB
#undef PG8_MMA
#undef PG8_WAIT_V
#undef PG8_WAIT_L
#undef PG8_BAR
#undef PG8_SCHED
}
}

constexpr int RING_OFF = 0, RING_BYTES = 131072;
constexpr int LDSCTL_OFF = 160 * 1024 - 64;
constexpr int LDS_BYTES = 160 * 1024;

struct Args { const float* in[28]; float* out; unsigned char* ws; int ph_lo, ph_hi; };
struct Frame {
    LAS unsigned char* lds;
    volatile LAS unsigned* MISC;
    unsigned* ctl;
    int vcu, G;
    float* out; unsigned char* ws; const float* modb;
};
struct ModRef { const float* modp; const float* modb; const float* modv; };
__device__ __forceinline__ f32x4 modv4(const ModRef& M, int layer, int who, int col  ) {
    const float* p = M.modp + ((size_t)(layer * 3 + who)) * NMODV + col;
    f32x4 s = *(const f32x4*)(M.modb + (size_t)layer * NMODV + col);
#pragma unroll
    for (int q = 0; q < 4; ++q) s += *(const f32x4*)(p + (size_t)q * 6 * NMODV);
    return s;
}
__device__ __forceinline__ f32x4 modvF(const ModRef& M, int layer, int who, int col) { return *(const f32x4*)(M.modv + ((size_t)(layer * 3 + who)) * NMODV + col); }
__device__ __forceinline__ int who_of_row(int r) { return r < SEQ ? 0 : (r < ML ? 1 : 2); }

struct EpiSwiGLU {
    static constexpr bool PERM = true;
    bf16* H;
    __device__ __forceinline__ void operator()(const f32x4 (&acc)[2][2][4][2], const pg8::Unit& u, int wr, int wc, int fr, int fq) const {
        const int rl0 = wr * 64 + fr; const size_t tb = ((size_t)u.pm * HKT + 2 * u.pn + (wc >> 1)) * 16384 + 32 * (wc & 1) + 8 * fq;
#pragma unroll
        for (int ai = 0; ai < 2; ++ai)
#pragma unroll
            for (int m = 0; m < 4; ++m) {
                bf16* rowp = H + tb + (size_t)(rl0 + ai * 128 + m * 16) * 64;
                float h[8];
#pragma unroll
                for (int n = 0; n < 2; ++n)
#pragma unroll
                    for (int e = 0; e < 4; ++e) { const float g = acc[ai][0][m][n][e], up = acc[ai][1][m][n][e]; h[4 * n + e] = g * sigmoidf_(g) * up; }
                v4u w; w.x = pk2(h[0], h[1]); w.y = pk2(h[2], h[3]); w.z = pk2(h[4], h[5]); w.w = pk2(h[6], h[7]);
                *(v4u*)rowp = w;
            }
    }
};
template <bool HAS_BIAS, bool HALF, bool DRY = false> struct EpiResid {
    static constexpr bool PERM = false;
    ModRef MR; const float* baseL; const float* baseC; float* outL; float* outC; const float* bias; int layer, gidx;
    __device__ __forceinline__ void operator()(const f32x4 (&acc)[2][2][4][2], const pg8::Unit& u, int wr, int wc, int fr, int fq) const {
        const int who = u.pm < 64 ? 0 : (u.pm < 128 ? 1 : 2);
        const bool isl = u.pm < 128;
        const int rbase = (isl ? u.pm : u.pm - 128) * 256 + wr * 64 + fr;
        const float* bp = isl ? baseL : baseC; float* op = isl ? outL : outC;
        const int col0 = u.pn * 256 + wc * 32 + 4 * fq;
        f32x4 gv[2][2], bv[2][2];
#pragma unroll
        for (int bj = 0; bj < 2; ++bj)
#pragma unroll
            for (int n = 0; n < 2; ++n) { gv[bj][n] = modvF(MR, layer, who, gidx * D + col0 + bj * 128 + n * 16) * (HALF ? 0.5f : 1.0f);
                bv[bj][n] = (f32x4){0.f, 0.f, 0.f, 0.f}; if (HAS_BIAS) bv[bj][n] = *(const f32x4*)(bias + col0 + bj * 128 + n * 16); }
#pragma unroll
        for (int ai = 0; ai < 2; ++ai) {
            f32x4 bs[4][2][2];
#pragma unroll
            for (int m = 0; m < 4; ++m)
#pragma unroll
                for (int bj = 0; bj < 2; ++bj)
#pragma unroll
                    for (int n = 0; n < 2; ++n) bs[m][bj][n] = *(const f32x4*)(bp + (size_t)(rbase + ai * 128 + m * 16) * D + col0 + bj * 128 + n * 16);
#pragma unroll
            for (int m = 0; m < 4; ++m) asm volatile("" : "+v"(bs[m][0][0]), "+v"(bs[m][0][1]), "+v"(bs[m][1][0]), "+v"(bs[m][1][1]));
#pragma unroll
            for (int m = 0; m < 4; ++m)
#pragma unroll
                for (int bj = 0; bj < 2; ++bj)
#pragma unroll
                    for (int n = 0; n < 2; ++n) { const f32x4 o_ = bs[m][bj][n] + gv[bj][n] * (acc[ai][bj][m][n] + bv[bj][n]);
                        if (!DRY || o_.x == 123456.789f) *(f32x4*)(op + (size_t)(rbase + ai * 128 + m * 16) * D + col0 + bj * 128 + n * 16) = o_; }
            asm volatile("" ::: "memory");
        }
    }
};

template <bool HAS_BIAS, bool HALF, int NX> struct EpiResidNorm {
    static constexpr bool PERM = false;
    ModRef MR; const float* baseL; float* outL; const float* bias; int layer, gidx;
    const float* nw; int nlayer, sidx; bf16* HN; float* RSTD; float* PS; unsigned* cnt; LAS unsigned char* sl;
    __device__ __forceinline__ void operator()(const f32x4 (&acc)[2][2][4][2], const pg8::Unit& u, int wr, int wc, int fr_, int fq_) const {
        int fr = fr_, fq = fq_; asm volatile("" : "+v"(fr), "+v"(fq));
        const int who = u.pm < 64 ? 0 : 1;
        const int rbase = u.pm * 256 + wr * 64 + fr;
        const int col0 = u.pn * 256 + wc * 32 + 4 * fq;
        const unsigned eo0 = (unsigned)(rbase * D + col0) * 4u;
        char* dump = (char*)RSTD + (WS_DUMP - WS_RSTD) + (size_t)blockIdx.x * 65536 + ((wr * 4 + wc) * 64 + fq * 16 + fr) * 16;
        f32x4 xn[2][2][4][2]; float ssq[2][4];
        {
            f32x4 gv[2][2];
#pragma unroll
            for (int bj = 0; bj < 2; ++bj)
#pragma unroll
                for (int n = 0; n < 2; ++n) { gv[bj][n] = modvF(MR, layer, who, gidx * D + col0 + bj * 128 + n * 16) * (HALF ? 0.5f : 1.0f);
                    f32x4 bv = (f32x4){0.f, 0.f, 0.f, 0.f}; if (HAS_BIAS) bv = *(const f32x4*)(bias + col0 + bj * 128 + n * 16);
#pragma unroll
                    for (int ai = 0; ai < 2; ++ai)
#pragma unroll
                        for (int m = 0; m < 4; ++m) { xn[ai][bj][m][n] = acc[ai][bj][m][n]; if (HAS_BIAS) xn[ai][bj][m][n] += bv; } }
#pragma unroll
            for (int ai = 0; ai < 2; ++ai) {
                f32x4 bs[4][2][2];
#pragma unroll
                for (int m = 0; m < 4; ++m)
#pragma unroll
                    for (int bj = 0; bj < 2; ++bj)
#pragma unroll
                        for (int n = 0; n < 2; ++n) bs[m][bj][n] = *(const f32x4*)((const char*)baseL + (size_t)(eo0 + (unsigned)((ai * 128 + m * 16) * D) * 4u) + (bj * 128 + n * 16) * 4);
#pragma unroll
                for (int m = 0; m < 4; ++m) asm volatile("" : "+v"(bs[m][0][0]), "+v"(bs[m][0][1]), "+v"(bs[m][1][0]), "+v"(bs[m][1][1]));
#pragma unroll
                for (int m = 0; m < 4; ++m) { float sq = 0.f;
#pragma unroll
                    for (int bj = 0; bj < 2; ++bj)
#pragma unroll
                        for (int n = 0; n < 2; ++n) { const f32x4 o_ = bs[m][bj][n] + gv[bj][n] * xn[ai][bj][m][n];
                            if (NX != 4) *(f32x4*)((char*)outL + (size_t)(eo0 + (unsigned)((ai * 128 + m * 16) * D) * 4u) + (bj * 128 + n * 16) * 4) = o_;
                            else *(f32x4*)(dump + ((m * 4 + bj * 2 + n) & 7) * 512) = o_;
                            xn[ai][bj][m][n] = o_; sq += (o_.x * o_.x + o_.y * o_.y) + (o_.z * o_.z + o_.w * o_.w); }
                    ssq[ai][m] = sq; }
                asm volatile("" ::: "memory");
            }
        }
        f32x4 a4[2][2], b4[2][2];
        if (NX != 3) {
#pragma unroll
            for (int bj = 0; bj < 2; ++bj)
#pragma unroll
                for (int n = 0; n < 2; ++n) { const int col = col0 + bj * 128 + n * 16;
                    a4[bj][n] = *(const f32x4*)(nw + col); b4[bj][n] = (f32x4){0.f, 0.f, 0.f, 0.f};
                    if (NX != 4) { a4[bj][n] = a4[bj][n] * (modvF(MR, nlayer, who, (sidx + 1) * D + col) + 1.f); b4[bj][n] = modvF(MR, nlayer, who, sidx * D + col); } }
        }
        LAS float* P = (LAS float*)sl; LAS float* RS = P + 1024;
#pragma unroll
        for (int ai = 0; ai < 2; ++ai)
#pragma unroll
            for (int m = 0; m < 4; ++m) { float v = ssq[ai][m]; v += __shfl_xor(v, 16); v += __shfl_xor(v, 32); if (fq == 0) P[wc * 256 + ai * 128 + wr * 64 + m * 16 + fr] = v; }
        LDS_WAIT(); __builtin_amdgcn_s_barrier(); asm volatile("" ::: "memory");
        const int wid = wr * 4 + wc, t = wid * 64 + fq * 16 + fr;
        if (wid < 4) {
            const float v = (P[t] + P[256 + t]) + (P[512 + t] + P[768 + t]);
            unsigned* slot = (unsigned*)PS + (size_t)u.pm * 2048 + t;
            __hip_atomic_store(slot + u.pn * 256, __float_as_uint(v) | 1u, __ATOMIC_RELAXED, __HIP_MEMORY_SCOPE_AGENT);
            float tot = 0.f;
            for (int it = 0; it < (1 << 20); ++it) { unsigned w[8]; bool ok = true;
#pragma unroll
                for (int j = 0; j < 8; ++j) { w[j] = __hip_atomic_load(slot + j * 256, __ATOMIC_RELAXED, __HIP_MEMORY_SCOPE_AGENT); ok = ok && (w[j] != 0u); }
                if (__all(ok)) { tot = ((__uint_as_float(w[0]) + __uint_as_float(w[1])) + (__uint_as_float(w[2]) + __uint_as_float(w[3]))) + ((__uint_as_float(w[4]) + __uint_as_float(w[5])) + (__uint_as_float(w[6]) + __uint_as_float(w[7]))); break; }
                __builtin_amdgcn_s_sleep(1); }
            const float rstd = 1.0f / sqrtf(tot * (1.f / D) + NORM_EPS); RS[t] = rstd;
            if (NX == 3 && u.pn == 0) RSTD[u.pm * 256 + t] = rstd; }
        LDS_WAIT(); __builtin_amdgcn_s_barrier(); asm volatile("" ::: "memory");
        if (NX == 3) return;
        asm volatile("" : "+v"(fr), "+v"(fq));
        const int rl0 = wr * 64 + fr, cb = u.pn * 256 + wc * 32 + 4 * fq;
        float rs[2][4];
#pragma unroll
        for (int ai = 0; ai < 2; ++ai)
#pragma unroll
            for (int m = 0; m < 4; ++m) rs[ai][m] = RS[ai * 128 + m * 16 + rl0];
#pragma unroll
        for (int bj = 0; bj < 2; ++bj)
#pragma unroll
            for (int n = 0; n < 2; ++n) { const int col = cb + bj * 128 + n * 16;
#pragma unroll
                for (int ai = 0; ai < 2; ++ai)
#pragma unroll
                    for (int m = 0; m < 4; ++m) { const int rl = ai * 128 + m * 16 + rl0; const f32x4 o_ = xn[ai][bj][m][n] * rs[ai][m] * a4[bj][n] + b4[bj][n];
                        if (NX == 4) *(f32x4*)((char*)outL + (unsigned)((u.pm * 256 + rl) * D + col) * 4u) = o_;
                        else { f32x2 w; w.x = __uint_as_float(pk2(o_.x, o_.y)); w.y = __uint_as_float(pk2(o_.z, o_.w));
                            if (NX == 1) *(f32x2*)((char*)HN + (unsigned)((u.pm * (D / 64) + (col >> 6)) * 16384 + rl * 64 + (col & 63)) * 2u) = w;
                            else *(f32x2*)((char*)HN + (unsigned)((u.pm * 256 + rl) * D + col) * 2u) = w; } }
                asm volatile("" ::: "memory"); }
    }
};

struct OpHBlk {
    const bf16* base; int pm0, kt0;
    __device__ __forceinline__ const char* tile(const pg8::Unit& u) const { return (const char*)base + ((size_t)(pm0 < 0 ? u.pm : pm0 + (u.pm & 1)) * HKT + (pm0 < 0 ? 0 : (u.pm >> 1) * kt0)) * 32768; }
    __device__ __forceinline__ unsigned voff(int R, int C) const { return (unsigned)(R * 64 + C) * 2u; }
    __device__ __forceinline__ size_t hstep() const { return 16384; }
    __device__ __forceinline__ size_t kstep() const { return 32768; }
};
struct OpBlk {
    const bf16* base; int nkt; bool isA;
    __device__ __forceinline__ const char* tile(const pg8::Unit& u) const { return (const char*)base + (size_t)(isA ? u.pm : u.pn) * nkt * 32768; }
    __device__ __forceinline__ unsigned voff(int R, int C) const { return (unsigned)(R * 64 + C) * 2u; }
    __device__ __forceinline__ size_t hstep() const { return 16384; }
    __device__ __forceinline__ size_t kstep() const { return 32768; }
};
struct OpBlkK {
    const bf16* base; int nkt;
    __device__ __forceinline__ const char* tile(const pg8::Unit& u) const { return (const char*)base + ((size_t)(u.pn & 7) * nkt + (size_t)(u.pn >> 3) * (nkt / 4)) * 32768; }
    __device__ __forceinline__ unsigned voff(int R, int C) const { return (unsigned)(R * 64 + C) * 2u; }
    __device__ __forceinline__ size_t hstep() const { return 16384; }
    __device__ __forceinline__ size_t kstep() const { return 32768; }
};
struct OrderCtxK { int G, c; __device__ __forceinline__ bool next(int i, pg8::Unit& u) const { const int L = i * G + c; if (L >= 64) return false; const int kq = L >> 4; u.pm = (L & 1) + 2 * kq; u.pn = ((L >> 1) & 7) + 8 * kq; return true; } };
struct OpKSplit {
    const bf16* base; int ld, klen; bool isA;
    __device__ __forceinline__ const char* tile(const pg8::Unit& u) const { const int t = isA ? (u.pm & 1) : (u.pn & 7), kq = isA ? (u.pm >> 1) : (u.pn >> 3); return (const char*)base + ((size_t)t * 256 * ld + (size_t)kq * klen) * 2; }
    __device__ __forceinline__ unsigned voff(int R, int C) const { return (unsigned)(R * ld + C) * 2u; }
    __device__ __forceinline__ size_t hstep() const { return (size_t)128 * ld * 2; }
    __device__ __forceinline__ size_t kstep() const { return 128; }
};
template <bool HAS_BIAS, bool HALF> struct EpiCtxAtomic {
    static constexpr bool PERM = false;
    ModRef MR; float* XC; const float* bias; int layer, gidx;
    __device__ __forceinline__ void operator()(const f32x4 (&acc)[2][2][4][2], const pg8::Unit& u, int wr, int wc, int fr, int fq) const {
        const int panel = u.pm & 1, ct = u.pn & 7, kq = u.pn >> 3;
        const int rbase = panel * 256 + wr * 64 + fr, col0 = ct * 256 + wc * 32 + 4 * fq;
#pragma unroll
        for (int bj = 0; bj < 2; ++bj)
#pragma unroll
            for (int n = 0; n < 2; ++n) {
                const f32x4 gv = modvF(MR, layer, 2, gidx * D + col0 + bj * 128 + n * 16) * (HALF ? 0.5f : 1.0f);
                f32x4 bv = {0.f, 0.f, 0.f, 0.f}; if (HAS_BIAS) { if (kq == 0) bv = *(const f32x4*)(bias + col0 + bj * 128 + n * 16); }
#pragma unroll
                for (int ai = 0; ai < 2; ++ai)
#pragma unroll
                    for (int m = 0; m < 4; ++m) { float* op = XC + (size_t)(rbase + ai * 128 + m * 16) * D + col0 + bj * 128 + n * 16; const f32x4 v = gv * (acc[ai][bj][m][n] + bv);
#pragma unroll
                        for (int e = 0; e < 4; ++e) (void)__hip_atomic_fetch_add(op + e, v[e], __ATOMIC_RELAXED, __HIP_MEMORY_SCOPE_AGENT); }
            }
    }
};

struct OpFixed {
    const bf16* base; int ld; int alt;
    __device__ __forceinline__ const char* tile(const pg8::Unit& u) const { return (const char*)base + (size_t)(alt ? (u.pm & 1) : 0) * 256 * ld * 2; }
    __device__ __forceinline__ unsigned voff(int R, int C) const { return (unsigned)(R * ld + C) * 2u; }
    __device__ __forceinline__ size_t hstep() const { return (size_t)128 * ld * 2; }
    __device__ __forceinline__ size_t kstep() const { return 128; }
};
struct OpChanL {
    const bf16* hn;
    __device__ __forceinline__ const char* tile(const pg8::Unit& u) const { return (const char*)hn + ((size_t)((u.pn >> 6) * SEQ + 2 * (u.pn & 63)) * D + (u.pm >> 1) * 256) * 2; }
    __device__ __forceinline__ unsigned voff(int R, int C) const { return (unsigned)(128 * R * D + C) * 2u; }
    __device__ __forceinline__ size_t hstep() const { return (size_t)D * 2; }
    __device__ __forceinline__ size_t kstep() const { return 128; }
};
struct OpChanC {
    const bf16* hn;
    __device__ __forceinline__ const char* tile(const pg8::Unit& u) const { return (const char*)hn + ((size_t)(ML + u.pn * CTXL) * D + (u.pm >> 1) * 256) * 2; }
    __device__ __forceinline__ unsigned voff(int R, int C) const { return (unsigned)(R * D + C) * 2u; }
    __device__ __forceinline__ size_t hstep() const { return (size_t)128 * D * 2; }
    __device__ __forceinline__ size_t kstep() const { return 128; }
};
struct OpStage2B {
    const bf16* T2;
    __device__ __forceinline__ const char* tile(const pg8::Unit& u) const { return (const char*)T2 + ((size_t)(u.pn >> 7) * 256 * 128 + (u.pn & 127)) * 512; }
    __device__ __forceinline__ unsigned voff(int R, int C) const { return (unsigned)R * 65536u + (unsigned)C * 2u; }
    __device__ __forceinline__ size_t hstep() const { return (size_t)128 * 65536; }
    __device__ __forceinline__ size_t kstep() const { return 128; }
};
__device__ __forceinline__ v4u pack8(const f32x4& a, const f32x4& b) { v4u w; w.x = pk2(a.x, a.y); w.y = pk2(a.z, a.w); w.z = pk2(b.x, b.y); w.w = pk2(b.z, b.w); return w; }
struct EpiChanL {
    static constexpr bool PERM = true; bf16* YT;
    __device__ __forceinline__ void operator()(const f32x4 (&acc)[2][2][4][2], const pg8::Unit& u, int wr, int wc, int fr, int fq) const {
        const int g = u.pm >> 1, cs = u.pm & 1, b = u.pn >> 6, n2p = u.pn & 63;
#pragma unroll
        for (int ai = 0; ai < 2; ++ai)
#pragma unroll
            for (int m = 0; m < 4; ++m) { const int kc = 128 * ai + 64 * wr + 16 * m + fr;
#pragma unroll
                for (int bj = 0; bj < 2; ++bj) { const unsigned idx = ((((unsigned)(b * 8 + g) * 256u + kc) * 128u + (2 * n2p + bj)) * 2u + cs) * 128u + 32 * wc + 8 * fq;
                    *(v4u*)((char*)YT + (size_t)(idx * 2u)) = pack8(acc[ai][bj][m][0], acc[ai][bj][m][1]); }
                asm volatile("" ::: "memory"); }
    }
};
struct EpiChanC {
    static constexpr bool PERM = true; bf16* YC;
    __device__ __forceinline__ void operator()(const f32x4 (&acc)[2][2][4][2], const pg8::Unit& u, int wr, int wc, int fr, int fq) const {
        const int g = u.pm >> 1, cs = u.pm & 1, b = u.pn;
#pragma unroll
        for (int ai = 0; ai < 2; ++ai)
#pragma unroll
            for (int m = 0; m < 4; ++m) { const int kc = 128 * ai + 64 * wr + 16 * m + fr;
#pragma unroll
                for (int bj = 0; bj < 2; ++bj) { const unsigned idx = (((unsigned)(b * 8 + g) * 256u + kc) * 2u + cs) * 256u + 128 * bj + 32 * wc + 8 * fq;
                    *(v4u*)((char*)YC + (size_t)(idx * 2u)) = pack8(acc[ai][bj][m][0], acc[ai][bj][m][1]); }
                asm volatile("" ::: "memory"); }
    }
};
struct EpiStage1 {
    static constexpr bool PERM = true; bf16* T2; const float* tw;
    __device__ __forceinline__ void operator()(const f32x4 (&acc)[2][2][4][2], const pg8::Unit& u, int wr, int wc, int fr, int fq) const {
#pragma unroll
        for (int m = 0; m < 4; ++m) { const int k1 = 64 * wr + 16 * m + fr, n20 = 32 * wc + 8 * fq;
#pragma unroll
            for (int n = 0; n < 2; ++n) {
                const f32x4 t0 = *(const f32x4*)((const char*)tw + (size_t)((unsigned)(k1 * 128 + n20 + 4 * n) * 8u));
                const f32x4 t1 = *(const f32x4*)((const char*)tw + (size_t)((unsigned)(k1 * 128 + n20 + 4 * n) * 8u + 16u));
#pragma unroll
                for (int bj = 0; bj < 2; ++bj) { const int chq = 2 * u.pn + bj;
                    const f32x4 tr = acc[0][bj][m][n], ti = acc[1][bj][m][n];
                    const f32x4 c = {t0.x, t0.z, t1.x, t1.z}, sn = {t0.y, t0.w, t1.y, t1.w};
                    const f32x4 ur = tr * c - ti * sn, ui = tr * sn + ti * c;
                    const unsigned idx = (((unsigned)chq * 128u + k1) * 2u) * 128u + n20 + 4 * n;
                    v2u w0; w0.x = pk2(ur.x, ur.y); w0.y = pk2(ur.z, ur.w); v2u w1; w1.x = pk2(ui.x, ui.y); w1.y = pk2(ui.z, ui.w);
                    *(v2u*)((char*)T2 + (size_t)(idx * 2u)) = w0; *(v2u*)((char*)T2 + (size_t)(idx * 2u + 256u)) = w1; }
                asm volatile("" ::: "memory"); } }
    }
};
struct EpiStage2 {
    static constexpr bool PERM = true; bf16* FO;
    __device__ __forceinline__ void operator()(const f32x4 (&acc)[2][2][4][2], const pg8::Unit& u, int wr, int wc, int fr, int fq) const {
        const int bg = u.pn >> 7, k1 = u.pn & 127, b = bg >> 3, g = bg & 7;
#pragma unroll
        for (int m = 0; m < 4; ++m) { const int k2 = 64 * wr + 16 * m + fr; const unsigned row = (unsigned)b * SEQ + k1 + 128 * k2;
#pragma unroll
            for (int bj = 0; bj < 2; ++bj) *(v4u*)((char*)FO + (size_t)((row * D + g * 256 + 128 * bj + 32 * wc + 8 * fq) * 2u)) = pack8(acc[0][bj][m][0], acc[0][bj][m][1]);
            asm volatile("" ::: "memory"); }
    }
};
struct EpiCtxDft {
    static constexpr bool PERM = true; bf16* FO;
    __device__ __forceinline__ void operator()(const f32x4 (&acc)[2][2][4][2], const pg8::Unit& u, int wr, int wc, int fr, int fq) const {
        const int b = u.pn >> 3, g = u.pn & 7;
#pragma unroll
        for (int ai = 0; ai < 2; ++ai)
#pragma unroll
            for (int m = 0; m < 4; ++m) { const int k = 128 * ai + 64 * wr + 16 * m + fr; const unsigned row = (unsigned)ML + b * CTXL + k;
#pragma unroll
                for (int bj = 0; bj < 2; ++bj) *(v4u*)((char*)FO + (size_t)((row * D + g * 256 + 128 * bj + 32 * wc + 8 * fq) * 2u)) = pack8(acc[ai][bj][m][0], acc[ai][bj][m][1]);
                asm volatile("" ::: "memory"); }
    }
};

struct OpXM {
    const bf16* base; int div, add;
    __device__ __forceinline__ const char* tile(const pg8::Unit& u) const { return (const char*)base + (size_t)(add + u.pn / div) * XM_STRIDE + (size_t)u.pm * 256 * D * 2; }
    __device__ __forceinline__ unsigned voff(int R, int C) const { return (unsigned)(R * D + C) * 2u; }
    __device__ __forceinline__ size_t hstep() const { return (size_t)128 * D * 2; }
    __device__ __forceinline__ size_t kstep() const { return 128; }
};
struct OpWSel {
    const bf16* base; int div; size_t stride;
    __device__ __forceinline__ const char* tile(const pg8::Unit& u) const { return (const char*)base + (size_t)(u.pn / div) * stride + (size_t)(u.pn % div) * 256 * D * 2; }
    __device__ __forceinline__ unsigned voff(int R, int C) const { return (unsigned)(R * D + C) * 2u; }
    __device__ __forceinline__ size_t hstep() const { return (size_t)128 * D * 2; }
    __device__ __forceinline__ size_t kstep() const { return 128; }
};
struct EpiLora {
    static constexpr bool PERM = true; bf16* LR;
    __device__ __forceinline__ void operator()(const f32x4 (&acc)[2][2][4][2], const pg8::Unit& u, int wr, int wc, int fr, int fq) const {
        const int which = u.pn; bf16* O = (bf16*)((char*)LR + (size_t)which * LR_STRIDE);
#pragma unroll
        for (int ai = 0; ai < 2; ++ai)
#pragma unroll
            for (int m = 0; m < 4; ++m) { const unsigned row = u.pm * 256 + 128 * ai + 64 * wr + 16 * m + fr;
#pragma unroll
                for (int bj = 0; bj < 2; ++bj) { f32x4 a = acc[ai][bj][m][0], b = acc[ai][bj][m][1];
                    if (which == 0) {
#pragma unroll
                        for (int e = 0; e < 4; ++e) { a[e] = 1.f - 2.f * __builtin_amdgcn_rcpf(1.f + __expf(2.f * a[e])); b[e] = 1.f - 2.f * __builtin_amdgcn_rcpf(1.f + __expf(2.f * b[e])); } }
                    else if (which == 2) {
#pragma unroll
                        for (int e = 0; e < 4; ++e) { a[e] = sigmoidf_(a[e]); b[e] = sigmoidf_(b[e]); } }
                    *(v4u*)((char*)O + (size_t)((row * 256u + 128 * bj + 32 * wc + 8 * fq) * 2u)) = pack8(a, b); }
                asm volatile("" ::: "memory"); }
    }
};
struct EpiRkv {
    static constexpr bool PERM = true; bf16* XM;
    __device__ __forceinline__ void operator()(const f32x4 (&acc)[2][2][4][2], const pg8::Unit& u, int wr, int wc, int fr, int fq) const {
        char* O = (char*)XM + (size_t)(3 + u.pn / 8) * XM_STRIDE; const int colt = (u.pn % 8) * 256;
#pragma unroll
        for (int ai = 0; ai < 2; ++ai)
#pragma unroll
            for (int m = 0; m < 4; ++m) { const unsigned row = u.pm * 256 + 128 * ai + 64 * wr + 16 * m + fr;
#pragma unroll
                for (int bj = 0; bj < 2; ++bj) *(v4u*)(O + (size_t)((row * D + colt + 128 * bj + 32 * wc + 8 * fq) * 2u)) = pack8(acc[ai][bj][m][0], acc[ai][bj][m][1]);
                asm volatile("" ::: "memory"); }
    }
};
struct EpiRkvC {
    static constexpr bool PERM = true; bf16* O;
    __device__ __forceinline__ void operator()(const f32x4 (&acc)[2][2][4][2], const pg8::Unit& u, int wr, int wc, int fr, int fq) const {
        char* Op = (char*)O + (size_t)(u.pn / 8) * MC * D * 2; const int colt = (u.pn % 8) * 256;
#pragma unroll
        for (int ai = 0; ai < 2; ++ai)
#pragma unroll
            for (int m = 0; m < 4; ++m) { const unsigned row = (u.pm - 128) * 256 + 128 * ai + 64 * wr + 16 * m + fr;
#pragma unroll
                for (int bj = 0; bj < 2; ++bj) *(v4u*)(Op + (size_t)((row * D + colt + 128 * bj + 32 * wc + 8 * fq) * 2u)) = pack8(acc[ai][bj][m][0], acc[ai][bj][m][1]);
                asm volatile("" ::: "memory"); }
    }
};
struct EpiCombGate {
    static constexpr bool PERM = true;
    bf16* PO; const bf16* YB0; const bf16* YB1; const bf16* VP; const float* SA; const float* lnw; const float* lnb; LAS unsigned char* sl;
    __device__ __forceinline__ void operator()(const f32x4 (&acc)[2][2][4][2], const pg8::Unit& u, int wr, int wc, int fr_, int fq_) const {
        int tl = threadIdx.x; asm volatile("" : "+v"(tl)); int fr = tl & 15, fq = (tl >> 4) & 3; (void)fr_; (void)fq_;
        const int wid = wr * 4 + wc;
#pragma unroll
        for (int ai = 0; ai < 2; ++ai)
#pragma unroll
            for (int bj = 0; bj < 2; ++bj) {
                const int c0 = u.pn * 256 + 128 * bj + 32 * wc + 8 * fq, hd = c0 >> 6, r0 = u.pm * 256 + 128 * ai + 64 * wr + fr;
                v4u ya[4], yb[4], vv[4]; float sbv[4];
#pragma unroll
                for (int m = 0; m < 4; ++m) { const unsigned o = (unsigned)((r0 + 16 * m) * D + c0) * 2u;
                    ya[m] = *(const v4u*)((const char*)YB0 + o); yb[m] = *(const v4u*)((const char*)YB1 + o);
                    sbv[m] = 0.5f * (*(const float*)((const char*)SA + (unsigned)(((r0 + 16 * m) * 32 + hd) * 4)) + *(const float*)((const char*)SA + (unsigned)(((MT + r0 + 16 * m) * 32 + hd) * 4))); }
                float y[4][8], ma[4], m2[4];
#pragma unroll
                for (int m = 0; m < 4; ++m) { const unsigned aw[4] = {ya[m].x, ya[m].y, ya[m].z, ya[m].w}, bw[4] = {yb[m].x, yb[m].y, yb[m].z, yb[m].w};
#pragma unroll
                    for (int e = 0; e < 4; ++e) { y[m][2 * e] = bflo(aw[e]) + bflo(bw[e]); y[m][2 * e + 1] = bfhi(aw[e]) + bfhi(bw[e]); } }
#pragma unroll
                for (int m = 0; m < 4; ++m) { asm volatile("" : "+v"(y[m][0]), "+v"(y[m][1]), "+v"(y[m][2]), "+v"(y[m][3]), "+v"(y[m][4]), "+v"(y[m][5]), "+v"(y[m][6]), "+v"(y[m][7]));
                    vv[m] = *(const v4u*)((const char*)VP + (unsigned)((r0 + 16 * m) * D + c0) * 2u); }
#pragma unroll
                for (int m = 0; m < 4; ++m) { float sm = 0.f;
#pragma unroll
                    for (int i = 0; i < 8; ++i) sm += y[m][i];
                    sm += __shfl_xor(sm, 16); sm += __shfl_xor(sm, 32); ma[m] = sm * (1.f / 32.f); float sq = 0.f;
#pragma unroll
                    for (int i = 0; i < 8; ++i) { const float dl = y[m][i] - ma[m]; sq += dl * dl; }
                    sq += __shfl_xor(sq, 16); sq += __shfl_xor(sq, 32); m2[m] = sq; }
                LAS f32x2* P = (LAS f32x2*)(sl + ((ai * 2 + bj) & 1) * 4096);
                if (fq == 0) {
#pragma unroll
                    for (int m = 0; m < 4; ++m) P[(wid * 4 + m) * 16 + fr] = (f32x2){ma[m], m2[m]}; }
                LDS_WAIT(); __builtin_amdgcn_s_barrier(); asm volatile("" ::: "memory");
                asm volatile("" : "+v"(tl)); const int fr2 = tl & 15, fq2 = (tl >> 4) & 3, c1 = u.pn * 256 + 128 * bj + 32 * wc + 8 * fq2, r1 = u.pm * 256 + 128 * ai + 64 * wr + fr2;
                const f32x4 l0 = *(const f32x4*)(lnw + c1), l1 = *(const f32x4*)(lnw + c1 + 4), g0 = *(const f32x4*)(lnb + c1), g1 = *(const f32x4*)(lnb + c1 + 4);
                const float lw_[8] = {l0.x, l0.y, l0.z, l0.w, l1.x, l1.y, l1.z, l1.w}, lb_[8] = {g0.x, g0.y, g0.z, g0.w, g1.x, g1.y, g1.z, g1.w};
#pragma unroll
                for (int m = 0; m < 4; ++m) { const f32x2 pp = P[((wid ^ 1) * 4 + m) * 16 + fr2];
                    const float mean = 0.5f * (ma[m] + pp.x), dm = ma[m] - pp.x, var = (m2[m] + pp.y + 16.f * dm * dm) * (1.f / 64.f);
                    const float rstd = 1.0f / sqrtf(var + GN_EPS), sb = sbv[m];
                    const unsigned vw[4] = {vv[m].x, vv[m].y, vv[m].z, vv[m].w}; const f32x4 ga = acc[ai][bj][m][0], gb = acc[ai][bj][m][1]; const float gt[8] = {ga.x, ga.y, ga.z, ga.w, gb.x, gb.y, gb.z, gb.w};
                    float o[8];
#pragma unroll
                    for (int e = 0; e < 4; ++e) { o[2 * e] = ((y[m][2 * e] - mean) * rstd * lw_[2 * e] + lb_[2 * e] + sb * bflo(vw[e])) * gt[2 * e];
                        o[2 * e + 1] = ((y[m][2 * e + 1] - mean) * rstd * lw_[2 * e + 1] + lb_[2 * e + 1] + sb * bfhi(vw[e])) * gt[2 * e + 1]; }
                    v4u w_; w_.x = pk2(o[0], o[1]); w_.y = pk2(o[2], o[3]); w_.z = pk2(o[4], o[5]); w_.w = pk2(o[6], o[7]);
                    *(v4u*)((char*)PO + (unsigned)((r1 + 16 * m) * D + c1) * 2u) = w_; }
                asm volatile("" ::: "memory");
            }
    }
};
template <bool DRY = false> struct EpiMulG {
    static constexpr bool PERM = true; bf16* PO;
    __device__ __forceinline__ void operator()(const f32x4 (&acc)[2][2][4][2], const pg8::Unit& u, int wr, int wc, int fr, int fq) const {
#pragma unroll
        for (int ai = 0; ai < 2; ++ai)
#pragma unroll
            for (int m = 0; m < 4; ++m) { const unsigned row = u.pm * 256 + 128 * ai + 64 * wr + 16 * m + fr;
#pragma unroll
                for (int bj = 0; bj < 2; ++bj) { v4u* ptr = (v4u*)((char*)PO + (size_t)((row * D + u.pn * 256 + 128 * bj + 32 * wc + 8 * fq) * 2u));
                    const v4u o = *ptr; const f32x4 a = acc[ai][bj][m][0], b = acc[ai][bj][m][1];
                    v4u w; w.x = pk2(bflo(o.x) * a.x, bfhi(o.x) * a.y); w.y = pk2(bflo(o.y) * a.z, bfhi(o.y) * a.w); w.z = pk2(bflo(o.z) * b.x, bfhi(o.z) * b.y); w.w = pk2(bflo(o.w) * b.z, bfhi(o.w) * b.w);
                    if (!DRY || w.x == 0x12345678u) *ptr = w; }
                asm volatile("" ::: "memory"); }
    }
};

__device__ __forceinline__ void phase_rowstats(Frame& F, const float* xl, const float* xc, float* RSTD, int r0) {
    int tid_ = threadIdx.x; asm volatile("" : "+v"(tid_)); const int LANE = tid_ & 63, WAVE = __builtin_amdgcn_readfirstlane(tid_ >> 6);
    const int gw = F.vcu * NWAVES + WAVE, NGW = F.G * NWAVES;
    for (int r = r0 + gw; r < MT; r += NGW) {
        const float* xr = r < ML ? xl + (size_t)r * D : xc + (size_t)(r - ML) * D; float ss = 0.f;
#pragma unroll
        for (int j = 0; j < 8; ++j) { const f32x4 v = *(const f32x4*)(xr + 256 * j + 4 * LANE); ss += (v.x * v.x + v.y * v.y) + (v.z * v.z + v.w * v.w); }
        const float rstd = 1.0f / sqrtf(wave_sum(ss) * (1.f / D) + NORM_EPS);
        if (LANE == 0) RSTD[r] = rstd;
    }
}
__device__ __forceinline__ void phase_mix(Frame& F, const ModRef& MR, const float* xl, const float* xc, const float* RSTD, const float* nw, const float* mu, bf16* XM) {
    int tid_ = threadIdx.x; asm volatile("" : "+v"(tid_)); const int TID = tid_, LANE = tid_ & 63, WAVE = __builtin_amdgcn_readfirstlane(tid_ >> 6);
    LAS float* TA = (LAS float*)(F.lds); LAS float* TB = (LAS float*)(F.lds + 24576); LAS float* TM = (LAS float*)(F.lds + 49152);
    for (int i = TID; i < 3 * D / 4; i += NWAVES * 64) { const int who = i / (D / 4), d = (i % (D / 4)) * 4;
        const f32x4 sh = modvF(MR, 1, who, 3 * D + d), sc = modvF(MR, 1, who, 4 * D + d), g = *(const f32x4*)(nw + d);
        *(LAS f32x4*)(TA + who * D + d) = g * (sc + 1.f); *(LAS f32x4*)(TB + who * D + d) = sh; }
    for (int i = TID; i < 6 * D / 4; i += NWAVES * 64) *(LAS f32x4*)(TM + 4 * i) = *(const f32x4*)(mu + 4 * i);
    __syncthreads();
    const int gw = F.vcu * NWAVES + WAVE, NGW = F.G * NWAVES;
    for (int r = gw; r < MT; r += NGW) {
        const int who = who_of_row(r);
        const bool isl = r < ML; const int t = isl ? (r & (SEQ - 1)) : ((r - ML) & (CTXL - 1));
        const float* xr = isl ? xl + (size_t)r * D : xc + (size_t)(r - ML) * D;
        const float rs = RSTD[r];
#pragma unroll
        for (int j = 0; j < 4; ++j) {
            int dt; bool ok;
            if (isl) { const int gx = t & 63, gy = t >> 6; if (j == 0) { dt = -1; ok = gx > 0; } else if (j == 1) { dt = 1; ok = gx < 63; } else if (j == 2) { dt = -64; ok = gy > 0; } else { dt = 64; ok = gy < SEQ / 64 - 1; } }
            else { if ((j & 1) == 0) { dt = -1; ok = t > 0; } else { dt = 1; ok = t < CTXL - 1; } }
            const int d = 512 * j + 8 * LANE;
            const f32x4 a0 = *(const LAS f32x4*)(TA + who * D + d), a1 = *(const LAS f32x4*)(TA + who * D + d + 4), b0 = *(const LAS f32x4*)(TB + who * D + d), b1 = *(const LAS f32x4*)(TB + who * D + d + 4);
            const f32x4 x0 = *(const f32x4*)(xr + d), x1 = *(const f32x4*)(xr + d + 4);
            const f32x4 h0 = x0 * rs * a0 + b0, h1 = x1 * rs * a1 + b1;
            f32x4 s0 = {0.f, 0.f, 0.f, 0.f}, s1 = s0;
            if (ok) { const float rn = RSTD[r + dt]; const float* xn = xr + (ptrdiff_t)dt * D; const f32x4 y0 = *(const f32x4*)(xn + d), y1 = *(const f32x4*)(xn + d + 4); s0 = y0 * rn * a0 + b0; s1 = y1 * rn * a1 + b1; }
            const f32x4 d0 = s0 - h0, d1 = s1 - h1;
#pragma unroll
            for (int p = 0; p < 6; ++p) { const f32x4 m0 = *(const LAS f32x4*)(TM + p * D + d), m1 = *(const LAS f32x4*)(TM + p * D + d + 4);
                *(v4u*)((char*)XM + (size_t)p * XM_STRIDE + ((size_t)r * D + d) * 2) = pack8(h0 + d0 * m0, h1 + d1 * m1); }
        }
    }
}

constexpr int SCAN_BLK = 12544, SC_WQ = 120, SCAN_NW = 10;
constexpr int SC_NSLOT = 4, SC_SLOT = SCAN_BLK;
constexpr int SC_NPROD_A = 5, SC_NPROD_B = 8, SC_QA = 24, SC_QA0 = 6;
constexpr int SC_WF = 0, SC_CONST = 24576, SC_CTL = SC_CONST + 1280, SC_RING = SC_CTL + 128, SC_PROD_A = SC_RING + SC_NSLOT * SC_SLOT, SC_PROD_B = SC_RING, SC_PSTRIDE = 14592;
constexpr int BLK_AR = 0, BLK_G = 4096, BLK_BK = 6144, BLK_VF = 10240, BLK_PCF = 12288;
static_assert(SC_PROD_A + SC_NPROD_A * SC_PSTRIDE <= LDSCTL_OFF && SC_PROD_B + SC_NPROD_B * SC_PSTRIDE <= LDSCTL_OFF && 4608 + 3072 <= 8192 && 8192 + 6400 <= SC_PSTRIDE, "scan LDS map");
__device__ __forceinline__ int scan_row(int b, int z, int s) { if (s < CTXL) return ML + b * CTXL + (z ? CTXL - 1 - s : s); const int sp = s - CTXL; return b * SEQ + (z ? SEQ - 1 - sp : sp); }
__device__ __forceinline__ int sc_chain(int b) { return ((b & 7) | ((b >> 4) << 3)) & 127; }
__device__ __forceinline__ int sc_half(int b) { return (b >> 3) & 1; }
__device__ __forceinline__ int win_lo(int w) { return w == 0 ? 0 : 16 + SC_WQ * (w - 1); }
__device__ __forceinline__ int win_n(int w) { return w == 0 ? 16 : (w == SCAN_NW - 1 ? 1024 - SC_WQ * (SCAN_NW - 2) : SC_WQ); }
template <int N> __device__ __forceinline__ float dpp_row_shr(float v) { return __int_as_float(__builtin_amdgcn_update_dpp(0, __float_as_int(v), 0x110 + N, 0xf, 0xf, true)); }
__device__ __forceinline__ bf16x8 pack_frag(float a0, float a1, float a2, float a3, float a4, float a5, float a6, float a7) { v4u w; w.x = pk2(a0, a1); w.y = pk2(a2, a3); w.z = pk2(a4, a5); w.w = pk2(a6, a7); return __builtin_bit_cast(bf16x8, w); }
#define MFMA32(a, b, c) __builtin_amdgcn_mfma_f32_32x32x16_bf16((a), (b), (c), 0, 0, 0)
#define MFMA16(a, b, c) __builtin_amdgcn_mfma_f32_16x16x32_bf16((a), (b), (c), 0, 0, 0)

__device__ __forceinline__ void scan_setup(const Frame& F, const Args& AR, int tid) {
    const int chain = sc_chain(blockIdx.x), h = (chain >> 1) & 31, z = chain & 1;
    const bf16* W2UP = (const bf16*)(F.ws + WS_WSMALL + WSM_W2UP); const bf16* A2UP = (const bf16*)(F.ws + WS_WSMALL + WSM_A2UP);
    for (int i = tid; i < 2 * 12 * 64; i += NWAVES * 64) { const int which = i / 768, f = (i / 64) % 12, ln = i & 63, ks = f >> 2, mt = f & 3, tau = ln & 15, g = ln >> 4;
        *(LAS v4u*)(F.lds + SC_WF + i * 16) = *(const v4u*)((which ? A2UP : W2UP) + ((size_t)(z * D + h * 64 + 16 * mt + tau)) * LORA + 32 * ks + 8 * g); }
    for (int i = tid; i < 5 * 64; i += NWAVES * 64) { const int k = i / 64, c = h * 64 + (i & 63);
        ((LAS float*)(F.lds + SC_CONST))[i] = k == 0 ? AR.in[13][z * D + c] : k == 1 ? AR.in[16][z * D + c] : k == 2 ? AR.in[21][c] : k == 3 ? AR.in[22][c] : AR.in[23][c]; }
}
__device__ __forceinline__ void scan_produce(const Frame& F, int w, int pw, int lane_in, bool isA) {
    int lane = lane_in;
    LAS unsigned char* scr = F.lds + (isA ? SC_PROD_A : SC_PROD_B) + pw * SC_PSTRIDE;
    const int nq = win_n(w), lo = win_lo(w), qa = (nq == 16) ? SC_QA0 : (nq * 3) / 8;
    const int nhalf = isA ? qa : nq - qa;
    const bf16* RKV = (const bf16*)(F.ws + WS_ACT + ACT_XM + 3 * XM_STRIDE);
    const bf16* TWb = (const bf16*)(F.ws + WS_ACT + ACT_LR); const bf16* TAb = (const bf16*)(F.ws + WS_ACT + ACT_LR + LR_STRIDE);
    unsigned char* wbuf = F.ws + WS_ACT + ACT_WBUF + (size_t)(w & 1) * WBUF_STRIDE;
    float* SA = (float*)(F.ws + WS_SA);
    const int chain = sc_chain(blockIdx.x), b = chain >> 6, h = (chain >> 1) & 31, z = chain & 1, q0 = isA ? 0 : qa;
    if (blockIdx.x >= 256) return;
    v2u r2n[4], k2n[4], v2n[4]; bf16x8 bwn[3], ban[3];
    const bf16* RK0 = w == 0 ? (const bf16*)(F.ws + WS_RKVC) - (size_t)ML * D : RKV; const size_t RKS = w == 0 ? (size_t)MC * D : (size_t)MT * D;
#define SC_LOADS(qq) do { const int row_ = scan_row(b, z, (lo + (qq)) * 16 + (lane & 15)); \
        const unsigned ob_ = ((unsigned)row_ * D + h * 64 + 4 * (lane >> 4)) * 2u, ol_ = ((unsigned)row_ * 256 + z * 96 + 8 * (lane >> 4)) * 2u; \
        _Pragma("unroll") for (int mt = 0; mt < 4; ++mt) { \
            r2n[mt] = *(const v2u*)((const char*)RK0 + (size_t)(ob_ + 32u * mt)); k2n[mt] = *(const v2u*)((const char*)(RK0 + RKS) + (size_t)(ob_ + 32u * mt)); v2n[mt] = *(const v2u*)((const char*)(RK0 + 2 * RKS) + (size_t)(ob_ + 32u * mt)); } \
        _Pragma("unroll") for (int ks = 0; ks < 3; ++ks) { bwn[ks] = *(const bf16x8*)((const char*)TWb + (size_t)(ol_ + 64u * ks)); ban[ks] = *(const bf16x8*)((const char*)TAb + (size_t)(ol_ + 64u * ks)); } } while (0)
    volatile LAS unsigned* tctr = (volatile LAS unsigned*)(F.lds + SC_CTL + 8);
#define SC_GRAB() ({ unsigned v_ = 0; if (lane == 0) v_ = __hip_atomic_fetch_add((LAS unsigned*)(F.lds + SC_CTL + 8), 1u, __ATOMIC_RELAXED, __HIP_MEMORY_SCOPE_WORKGROUP); (int)__builtin_amdgcn_readfirstlane(v_); })
    int qi = pw, qn = SC_GRAB();
    (void)tctr;
    if (qi < nhalf) SC_LOADS(q0 + qi);
#pragma unroll 1
    for (; qi < nhalf; qi = qn, qn = SC_GRAB()) {
        asm volatile("" : "+v"(lane));
        const int tau = lane & 15, g = lane >> 4;
        const int q = q0 + qi;
        const int row = scan_row(b, z, (lo + q) * 16 + tau);
        unsigned char* blk = wbuf + ((size_t)chain * SC_WQ + q) * SCAN_BLK;
        v2u r2[4], k2[4], v2[4]; bf16x8 bw[3], ba[3];
#pragma unroll
        for (int mt = 0; mt < 4; ++mt) { r2[mt] = r2n[mt]; k2[mt] = k2n[mt]; v2[mt] = v2n[mt]; }
#pragma unroll
        for (int ks = 0; ks < 3; ++ks) { bw[ks] = bwn[ks]; ba[ks] = ban[ks]; }
        if (qn < nhalf) SC_LOADS(q0 + qn);
        f32x4 lw[4], la[4];
#pragma unroll
        for (int mt = 0; mt < 4; ++mt) { lw[mt] = (f32x4){0.f, 0.f, 0.f, 0.f}; la[mt] = lw[mt]; }
        {
            bf16x8 wf[12];
#pragma unroll
            for (int f_ = 0; f_ < 12; ++f_) wf[f_] = *(const LAS bf16x8*)(F.lds + SC_WF + (f_ * 64 + lane) * 16);
            asm volatile("" : "+v"(wf[0]), "+v"(wf[1]), "+v"(wf[2]), "+v"(wf[3]), "+v"(wf[4]), "+v"(wf[5]), "+v"(wf[6]), "+v"(wf[7]), "+v"(wf[8]), "+v"(wf[9]), "+v"(wf[10]), "+v"(wf[11]));
            bf16x8 af[12];
#pragma unroll
            for (int f_ = 0; f_ < 12; ++f_) af[f_] = *(const LAS bf16x8*)(F.lds + SC_WF + ((12 + f_) * 64 + lane) * 16);
#pragma unroll
            for (int ks = 0; ks < 3; ++ks)
#pragma unroll
                for (int mt = 0; mt < 4; ++mt) lw[mt] = MFMA16(wf[ks * 4 + mt], bw[ks], lw[mt]);
            asm volatile("" : "+v"(af[0]), "+v"(af[1]), "+v"(af[2]), "+v"(af[3]), "+v"(af[4]), "+v"(af[5]), "+v"(af[6]), "+v"(af[7]), "+v"(af[8]), "+v"(af[9]), "+v"(af[10]), "+v"(af[11]));
#pragma unroll
            for (int ks = 0; ks < 3; ++ks)
#pragma unroll
                for (int mt = 0; mt < 4; ++mt) la[mt] = MFMA16(af[ks * 4 + mt], ba[ks], la[mt]);
        }
        LAS unsigned char* Xs = scr; LAS unsigned char* Ys = scr + 4096;
        LAS bf16* BKs = (LAS bf16*)(scr + 8192); LAS bf16* VFs = (LAS bf16*)(scr + 8192 + 4096); LAS float* PCs = (LAS float*)(scr + 8192 + 6144);
        float lnw[16], asg[16], kk[16], kd[16]; float ss = 0.f, sap = 0.f;
        f32x4 cw0[4], ca0[4], ckk[4], cka[4], crk[4];
#pragma unroll
        for (int mt = 0; mt < 4; ++mt) { const LAS float* cst = (const LAS float*)(F.lds + SC_CONST) + 16 * mt + 4 * g;
            cw0[mt] = *(const LAS f32x4*)(cst); ca0[mt] = *(const LAS f32x4*)(cst + 64); ckk[mt] = *(const LAS f32x4*)(cst + 128); cka[mt] = *(const LAS f32x4*)(cst + 192); crk[mt] = *(const LAS f32x4*)(cst + 256); }
        asm volatile("" : "+v"(cw0[0]), "+v"(cw0[1]), "+v"(cw0[2]), "+v"(cw0[3]), "+v"(ca0[0]), "+v"(ca0[1]), "+v"(ca0[2]), "+v"(ca0[3]), "+v"(ckk[0]), "+v"(ckk[1]), "+v"(ckk[2]), "+v"(ckk[3]), "+v"(cka[0]), "+v"(cka[1]), "+v"(cka[2]), "+v"(cka[3]), "+v"(crk[0]), "+v"(crk[1]), "+v"(crk[2]), "+v"(crk[3]));
#pragma unroll
        for (int mt = 0; mt < 4; ++mt) {
            const f32x4 w0 = cw0[mt], a0 = ca0[mt], kkc = ckk[mt], kac = cka[mt], rkc = crk[mt];
            const float rv[4] = {bflo(r2[mt].x), bfhi(r2[mt].x), bflo(r2[mt].y), bfhi(r2[mt].y)}, kv[4] = {bflo(k2[mt].x), bfhi(k2[mt].x), bflo(k2[mt].y), bfhi(k2[mt].y)};
#pragma unroll
            for (int e = 0; e < 4; ++e) { const int i = 4 * mt + e;
                lnw[i] = -0.6065306597126334f * sigmoidf_(w0[e] + lw[mt][e]);
                asg[i] = sigmoidf_(a0[e] + la[mt][e]);
                const float kr = kv[e] * kkc[e]; kk[i] = kr; ss += kr * kr;
                kd[i] = kv[e] * (1.f + (asg[i] - 1.f) * kac[e]);
                sap += rv[e] * rkc[e] * kd[i]; } }
        ss += __shfl_xor(ss, 16); ss += __shfl_xor(ss, 32); sap += __shfl_xor(sap, 16); sap += __shfl_xor(sap, 32);
        const float inv = __builtin_amdgcn_rsqf(fmaxf(ss, 1e-24f));
        if (g == 0) SA[((size_t)z * MT + row) * 32 + h] = sap;
        float ec_[16], eC_[16];
#pragma unroll
        for (int i = 0; i < 16; ++i) { float c = lnw[i]; c += dpp_row_shr<1>(c); c += dpp_row_shr<2>(c); c += dpp_row_shr<4>(c); c += dpp_row_shr<8>(c); ec_[i] = __expf(c); }
#pragma unroll
        for (int i = 0; i < 16; ++i) eC_[i] = __shfl(ec_[i], (lane & 48) | 15);
        { const int hh0 = (tau >> 2) & 1, jj0 = 4 * (tau >> 3) + (tau & 3), hh1 = tau >> 3, jj1 = tau & 7;
          LAS bf16* bkb0 = BKs + (4 * g + 32 * hh0) * 8 + jj0; LAS bf16* bkb1 = BKs + 512 + (4 * g + 32 * hh1) * 8 + jj1; LAS bf16* vfb = VFs + (4 * g + 32 * hh1) * 8 + jj1;
#pragma unroll
          for (int mt = 0; mt < 4; ++mt) {
            float at[4], rt[4], bt[4], kt[4];
            const float rv[4] = {bflo(r2[mt].x), bfhi(r2[mt].x), bflo(r2[mt].y), bfhi(r2[mt].y)};
            const unsigned short vraw[4] = {(unsigned short)(v2[mt].x & 0xffffu), (unsigned short)(v2[mt].x >> 16), (unsigned short)(v2[mt].y & 0xffffu), (unsigned short)(v2[mt].y >> 16)};
#pragma unroll
            for (int e = 0; e < 4; ++e) { const int i = 4 * mt + e;
                const float ec = ec_[i], en = __builtin_amdgcn_rcpf(ec);
                const float eprev = __int_as_float(__builtin_amdgcn_update_dpp(0x3f800000, __float_as_int(ec), 0x111, 0xf, 0xf, false));
                const float er = eC_[i] * en;
                const float kki = kk[i] * inv, bb = kki * asg[i];
                at[e] = -kki * eprev; rt[e] = rv[e] * ec; bt[e] = bb * en; kt[e] = kd[i] * en;
                const int eo = ((mt >> 1) * 2) * 512 + (16 * (mt & 1) + e) * 8;
                const unsigned wbk = pk2(bb * er, kd[i] * er);
                bkb0[eo] = (bf16)(wbk & 0xffffu); bkb1[eo] = (bf16)(wbk >> 16);
                vfb[(mt >> 1) * 512 + (16 * (mt & 1) + e) * 8] = vraw[e]; }
            const int jb = (4 * (g >> 1)) * 2, cb = (((2 * mt + (g >> 1)) ^ (tau & 7)) << 4) + 8 * (g & 1);
            v2u wa; wa.x = pk2(at[0], at[1]); wa.y = pk2(at[2], at[3]);
            v2u wq; wq.x = pk2(rt[0], rt[1]); wq.y = pk2(rt[2], rt[3]);
            v2u wb; wb.x = pk2(bt[0], bt[1]); wb.y = pk2(bt[2], bt[3]);
            v2u wk; wk.x = pk2(kt[0], kt[1]); wk.y = pk2(kt[2], kt[3]);
            *(v2u*)(blk + BLK_AR + (mt * 64 + tau + 32 * (g & 1)) * 16 + jb) = wa;
            *(v2u*)(blk + BLK_AR + (mt * 64 + 16 + tau + 32 * (g & 1)) * 16 + jb) = wq;
            *(LAS v2u*)(Xs + tau * 128 + cb) = wa; *(LAS v2u*)(Xs + (16 + tau) * 128 + cb) = wq;
            *(LAS v2u*)(Ys + tau * 128 + cb) = wb; *(LAS v2u*)(Ys + (16 + tau) * 128 + cb) = wk;
          }
          if (tau == 0) {
#pragma unroll
              for (int i = 0; i < 16; ++i) { const int j = 16 * (i >> 2) + 4 * g + (i & 3), mtp = j >> 5, jl = j & 31, hq = (jl >> 2) & 1, qq = (jl & 3) + 4 * (jl >> 3); PCs[(hq * 2 + mtp) * 16 + qq] = eC_[i]; } }
        }
        LDS_WAIT();
        f32x16 dm;
#pragma unroll
        for (int i = 0; i < 16; ++i) dm[i] = 0.f;
        { const int r31 = lane & 31, hh = lane >> 5;
#pragma unroll
          for (int ks = 0; ks < 4; ++ks) { const int co = ((2 * ks + hh) ^ (r31 & 7)) << 4; const bf16x8 xa = *(const LAS bf16x8*)(Xs + r31 * 128 + co), yb = *(const LAS bf16x8*)(Ys + r31 * 128 + co); dm = MFMA32(xa, yb, dm); }
          LDS_WAIT();
          LAS float* Dm = (LAS float*)scr;
#pragma unroll
          for (int q_ = 0; q_ < 16; ++q_) Dm[((q_ & 3) + 8 * (q_ >> 2) + 4 * hh) * 36 + r31] = dm[q_];
        }
        LDS_WAIT();
        float xs[16], os[16];
        { const LAS float* Dm = (const LAS float*)scr; const int c = lane & 31, cc = (c - 16) & 15; const bool lo16 = c < 16;
          float ak[16], rk[16];
#pragma unroll
          for (int t = 0; t < 16; ++t) { ak[t] = Dm[t * 36 + 16 + cc]; rk[t] = Dm[(16 + t) * 36 + 16 + cc]; }
          asm volatile("" : "+v"(ak[0]), "+v"(ak[1]), "+v"(ak[2]), "+v"(ak[3]), "+v"(ak[4]), "+v"(ak[5]), "+v"(ak[6]), "+v"(ak[7]), "+v"(ak[8]), "+v"(ak[9]), "+v"(ak[10]), "+v"(ak[11]), "+v"(ak[12]), "+v"(ak[13]), "+v"(ak[14]), "+v"(ak[15]));
          asm volatile("" : "+v"(rk[0]), "+v"(rk[1]), "+v"(rk[2]), "+v"(rk[3]), "+v"(rk[4]), "+v"(rk[5]), "+v"(rk[6]), "+v"(rk[7]), "+v"(rk[8]), "+v"(rk[9]), "+v"(rk[10]), "+v"(rk[11]), "+v"(rk[12]), "+v"(rk[13]), "+v"(rk[14]), "+v"(rk[15]) :: "memory");
#pragma unroll
          for (int t = 0; t < 16; ++t) { const float one = (t == c) ? 1.f : 0.f, akm = (cc < t) ? ak[t] : 0.f, rkm = (cc <= t) ? rk[t] : 0.f; xs[t] = lo16 ? one : akm; os[t] = lo16 ? 0.f : rkm; }
#pragma unroll
          for (int tb = 0; tb < 4; ++tb) {
              f32x4 ar[4][4];
#pragma unroll
              for (int r = 0; r < 4; ++r)
#pragma unroll
                  for (int u4 = 0; u4 <= tb; ++u4) ar[r][u4] = *(const LAS f32x4*)(Dm + (4 * tb + r) * 36 + 4 * u4);
#pragma unroll
              for (int r = 0; r < 4; ++r) { if (tb == 0) asm volatile("" : "+v"(ar[r][0]) :: "memory"); else if (tb == 1) asm volatile("" : "+v"(ar[r][0]), "+v"(ar[r][1]) :: "memory"); else if (tb == 2) asm volatile("" : "+v"(ar[r][0]), "+v"(ar[r][1]), "+v"(ar[r][2]) :: "memory"); else asm volatile("" : "+v"(ar[r][0]), "+v"(ar[r][1]), "+v"(ar[r][2]), "+v"(ar[r][3]) :: "memory"); }
#pragma unroll
              for (int r = 0; r < 4; ++r) { const int t = 4 * tb + r;
#pragma unroll
                  for (int tau_ = 0; tau_ < t; ++tau_) xs[t] += ar[r][tau_ >> 2][tau_ & 3] * xs[tau_]; }
              asm volatile("" : "+v"(xs[4 * tb]), "+v"(xs[4 * tb + 1]), "+v"(xs[4 * tb + 2]), "+v"(xs[4 * tb + 3]) :: "memory");
          }
#pragma unroll
          for (int tb = 0; tb < 4; ++tb) {
              f32x4 ar[4][4];
#pragma unroll
              for (int r = 0; r < 4; ++r)
#pragma unroll
                  for (int u4 = 0; u4 <= tb; ++u4) ar[r][u4] = *(const LAS f32x4*)(Dm + (16 + 4 * tb + r) * 36 + 4 * u4);
#pragma unroll
              for (int r = 0; r < 4; ++r) { if (tb == 0) asm volatile("" : "+v"(ar[r][0]) :: "memory"); else if (tb == 1) asm volatile("" : "+v"(ar[r][0]), "+v"(ar[r][1]) :: "memory"); else if (tb == 2) asm volatile("" : "+v"(ar[r][0]), "+v"(ar[r][1]), "+v"(ar[r][2]) :: "memory"); else asm volatile("" : "+v"(ar[r][0]), "+v"(ar[r][1]), "+v"(ar[r][2]), "+v"(ar[r][3]) :: "memory"); }
#pragma unroll
              for (int r = 0; r < 4; ++r) { const int t = 4 * tb + r;
#pragma unroll
                  for (int tau_ = 0; tau_ <= t; ++tau_) os[t] += ar[r][tau_ >> 2][tau_ & 3] * xs[tau_]; }
              asm volatile("" : "+v"(os[4 * tb]), "+v"(os[4 * tb + 1]), "+v"(os[4 * tb + 2]), "+v"(os[4 * tb + 3]) :: "memory");
          }
        }
        LDS_WAIT();
        { LAS bf16* Gs = (LAS bf16*)(scr + 4608);
          if (lane < 32) { const int c = lane;
              int ks, hh, jj; if (c < 16) { ks = 0; hh = (c >> 2) & 1; jj = 4 * (c >> 3) + (c & 3); } else { ks = 2; hh = (c - 16) >> 3; jj = (c - 16) & 7; }
#pragma unroll
              for (int t = 0; t < 16; ++t) { Gs[(ks * 64 + t + 32 * hh) * 8 + jj] = (bf16)(pk2(xs[t], 0.f) & 0xffffu); Gs[(ks * 64 + 16 + t + 32 * hh) * 8 + jj] = (bf16)(pk2(os[t], 0.f) & 0xffffu); } }
        }
        LDS_WAIT();
        { v4u cg[2], cbk[7];
          cg[0] = *(const LAS v4u*)(scr + 4608 + lane * 16); cg[1] = *(const LAS v4u*)(scr + 4608 + (2 * 64 + lane) * 16);
#pragma unroll
          for (int i = 0; i < 6; ++i) cbk[i] = *(const LAS v4u*)(scr + 8192 + (i * 64 + lane) * 16);
          cbk[6] = *(const LAS v4u*)(scr + 8192 + (6 * 64 + (lane & 15)) * 16);
          asm volatile("" : "+v"(cg[0]), "+v"(cg[1]), "+v"(cbk[0]), "+v"(cbk[1]), "+v"(cbk[2]), "+v"(cbk[3]), "+v"(cbk[4]), "+v"(cbk[5]), "+v"(cbk[6]));
#pragma unroll
          for (int i = 0; i < 2; ++i) *(v4u*)(blk + BLK_G + (i * 64 + lane) * 16) = cg[i];
#pragma unroll
          for (int i = 0; i < 6; ++i) *(v4u*)(blk + BLK_BK + (i * 64 + lane) * 16) = cbk[i];
          if (lane < 16) *(v4u*)(blk + BLK_BK + (6 * 64 + lane) * 16) = cbk[6]; }
    }
#undef SC_LOADS
#undef SC_GRAB
}

__device__ __forceinline__ void scan_consume(const Frame& F, int w  , int lane, int ih) {
    const int nq = win_n(w), lo = win_lo(w);
    const unsigned char* wbuf = F.ws + WS_ACT + ACT_WBUF + (size_t)(w & 1) * WBUF_STRIDE;
    float* SST = (float*)(F.ws + WS_SST);
    const int r31 = lane & 31, hh = lane >> 5;
    for (int p = blockIdx.x; p < 256; p += 256) {
        const int chain = sc_chain(p), b = chain >> 6, h = (chain >> 1) & 31, z = chain & 1; const int sp_ = chain * 2 + ih;
        bf16* YB = (bf16*)(F.ws + WS_ACT + (z ? ACT_YB1 : ACT_YB0));
        f32x16 st0, st1;
        if (w == 0) {
#pragma unroll
            for (int i = 0; i < 16; ++i) { st0[i] = 0.f; st1[i] = 0.f; } }
        else {
#pragma unroll
            for (int i = 0; i < 16; ++i) { st0[i] = SST[((size_t)sp_ * 32 + i) * 64 + lane]; st1[i] = SST[((size_t)sp_ * 32 + 16 + i) * 64 + lane]; } }
        volatile LAS unsigned* ctl = (volatile LAS unsigned*)(F.lds + SC_CTL);
        bf16x8 gmid;
        { unsigned e8[8];
#pragma unroll
          for (int jj = 0; jj < 8; ++jj) { const int pi = 8 * (jj >> 2) + 4 * hh + (jj & 3); e8[jj] = (r31 >= 16 && r31 - 16 == pi) ? 0x3f80u : 0u; }
          v4u m_; m_.x = e8[0] | (e8[1] << 16); m_.y = e8[2] | (e8[3] << 16); m_.z = e8[4] | (e8[5] << 16); m_.w = e8[6] | (e8[7] << 16); gmid = __builtin_bit_cast(bf16x8, m_); }
        unsigned yoff[8];
#pragma unroll
        for (int q_ = 8; q_ < 16; ++q_) { const int t = (q_ & 3) + 8 * ((q_ >> 2) & 1) + 4 * hh; yoff[q_ - 8] = (unsigned)((z ? 15 - t : t) * D + h * 64 + 32 * ih + r31) * 2u; }
#pragma unroll 1
        for (int q = 0; q < nq; ++q) {
            { unsigned sp = 0; _Pragma("unroll 1") while ((int)ctl[0] <= q) { __builtin_amdgcn_s_sleep(1); if (++sp > (1u << 24)) break; } }
            asm volatile("" ::: "memory");
            const LAS unsigned char* sl = F.lds + SC_RING + (q % SC_NSLOT) * SC_SLOT;
            bf16x8 arf[4], gf[3], bkf[2][2], vf; f32x4 pc[8];
#pragma unroll
            for (int ks = 0; ks < 4; ++ks) arf[ks] = *(const LAS bf16x8*)(sl + BLK_AR + (ks * 64 + lane) * 16);
            gf[0] = *(const LAS bf16x8*)(sl + BLK_G + lane * 16); gf[2] = *(const LAS bf16x8*)(sl + BLK_G + (64 + lane) * 16); gf[1] = gmid;
#pragma unroll
            for (int mj = 0; mj < 2; ++mj)
#pragma unroll
                for (int ks = 0; ks < 2; ++ks) bkf[mj][ks] = *(const LAS bf16x8*)(sl + BLK_BK + ((mj * 2 + ks) * 64 + lane) * 16);
            vf = *(const LAS bf16x8*)(sl + BLK_VF + (ih * 64 + lane) * 16);
#pragma unroll
            for (int i = 0; i < 8; ++i) pc[i] = *(const LAS f32x4*)(sl + BLK_PCF + hh * 128 + i * 16);
            LDS_WAIT();
            asm volatile("" ::: "memory"); if (lane == 0) ctl[ih ? 4 : 1] = (unsigned)(q + 1);
            const bf16x8 s0 = pack_frag(st0[0], st0[1], st0[2], st0[3], st0[4], st0[5], st0[6], st0[7]), s1 = pack_frag(st0[8], st0[9], st0[10], st0[11], st0[12], st0[13], st0[14], st0[15]);
            const bf16x8 s2 = pack_frag(st1[0], st1[1], st1[2], st1[3], st1[4], st1[5], st1[6], st1[7]), s3 = pack_frag(st1[8], st1[9], st1[10], st1[11], st1[12], st1[13], st1[14], st1[15]);
            const f32x16 zero16 = {0.f, 0.f, 0.f, 0.f, 0.f, 0.f, 0.f, 0.f, 0.f, 0.f, 0.f, 0.f, 0.f, 0.f, 0.f, 0.f};
            f32x16 zz = MFMA32(arf[0], s0, zero16);
            zz = MFMA32(arf[1], s1, zz);
            zz = MFMA32(arf[2], s2, zz);
            zz = MFMA32(arf[3], s3, zz);
#pragma unroll
            for (int i = 0; i < 16; ++i) { st0[i] *= pc[i >> 2][i & 3]; st1[i] *= pc[4 + (i >> 2)][i & 3]; }
            f32x16 oo = MFMA32(gf[2], vf, zero16);
            oo = MFMA32(gf[0], pack_frag(zz[0], zz[1], zz[2], zz[3], zz[4], zz[5], zz[6], zz[7]), oo);
            oo = MFMA32(gf[1], pack_frag(zz[8], zz[9], zz[10], zz[11], zz[12], zz[13], zz[14], zz[15]), oo);
            st0 = MFMA32(bkf[0][1], vf, st0); st1 = MFMA32(bkf[1][1], vf, st1);
            const bf16x8 uf = pack_frag(oo[0], oo[1], oo[2], oo[3], oo[4], oo[5], oo[6], oo[7]);
            st0 = MFMA32(bkf[0][0], uf, st0); st1 = MFMA32(bkf[1][0], uf, st1);
            if (w > 0) {
                const int sp0 = (lo + q) * 16 - CTXL;
                const int rlow = __builtin_amdgcn_readfirstlane(b * SEQ + (z ? SEQ - 1 - sp0 - 15 : sp0));
                char* yb = (char*)YB + (size_t)rlow * (D * 2);
#pragma unroll
                for (int q_ = 8; q_ < 16; ++q_) *(bf16*)(yb + yoff[q_ - 8]) = (bf16)(pk2(oo[q_], 0.f) & 0xffffu); }
        }
#pragma unroll
        for (int i = 0; i < 16; ++i) { SST[((size_t)sp_ * 32 + i) * 64 + lane] = st0[i]; SST[((size_t)sp_ * 32 + 16 + i) * 64 + lane] = st1[i]; }
    }
}
__device__ __forceinline__ void scan_loader(const Frame& F, int w, int lane) {
    const int nq = win_n(w);
    const int p = blockIdx.x; if (p >= 256) return;
    const unsigned char* cbase = F.ws + WS_ACT + ACT_WBUF + (size_t)(w & 1) * WBUF_STRIDE + (size_t)sc_chain(p) * SC_WQ * SCAN_BLK + lane * 16;
    volatile LAS unsigned* ctl = (volatile LAS unsigned*)(F.lds + SC_CTL);
#pragma unroll 1
    for (int q = 0; q < nq; ++q) {
        { unsigned sp = 0; while (q - (int)ctl[1] >= SC_NSLOT || q - (int)ctl[4] >= SC_NSLOT) { __builtin_amdgcn_s_sleep(1); if (++sp > (1u << 24)) break; } }
        asm volatile("" ::: "memory");
        const unsigned char* src = cbase + (size_t)q * SCAN_BLK; LAS unsigned char* dst = F.lds + SC_RING + (q % SC_NSLOT) * SC_SLOT;
#pragma unroll
        for (int i_ = 0; i_ < 12; ++i_) __builtin_amdgcn_global_load_lds((const unsigned*)(src + i_ * 1024), (LAS unsigned*)(dst + i_ * 1024), 16, 0, 0);
        if (lane < 16) __builtin_amdgcn_global_load_lds((const unsigned*)(src + BLK_PCF), (LAS unsigned*)(dst + BLK_PCF), 16, 0, 0);
        asm volatile("s_waitcnt vmcnt(26)" ::: "memory");
        if (lane == 0 && q >= 1) ctl[0] = (unsigned)(q - 1);
    }
    asm volatile("s_waitcnt vmcnt(0)" ::: "memory");
    if (lane == 0) ctl[0] = (unsigned)nq;
}
__device__ __forceinline__ void phase_scan_step(Frame& F, const Args& AR, int w) {
    int tid_ = threadIdx.x; asm volatile("" : "+v"(tid_)); const int LANE = tid_ & 63, WAVE = __builtin_amdgcn_readfirstlane(tid_ >> 6);
    if (w == 0) scan_setup(F, AR, tid_);
    const bool isA = sc_half(blockIdx.x) == 0;
    if (tid_ < 8) ((volatile LAS unsigned*)(F.lds + SC_CTL))[tid_] = tid_ == 2 ? (unsigned)(isA ? SC_NPROD_A : SC_NPROD_B) : 0u;
    __syncthreads();
    if (isA) {
        if (WAVE <= 1) { if (w >= 1) scan_consume(F, w - 1, LANE, WAVE); }
        else if (WAVE == 2) { if (w >= 1) scan_loader(F, w - 1, LANE); }
        else { if (w < SCAN_NW) scan_produce(F, w, WAVE - 3, LANE, true); }
    } else { if (w < SCAN_NW) scan_produce(F, w, WAVE, LANE, false); }
}
__device__ __forceinline__ void phase_combine(Frame& F, const Args& AR, bf16* PO) {
    int tid_ = threadIdx.x; asm volatile("" : "+v"(tid_)); const int TID = tid_, LANE = tid_ & 63, WAVE = __builtin_amdgcn_readfirstlane(tid_ >> 6);
    const bf16* VP = (const bf16*)(F.ws + WS_ACT + ACT_XM + 5 * XM_STRIDE);
    const bf16* YB0 = (const bf16*)(F.ws + WS_ACT + ACT_YB0); const bf16* YB1 = (const bf16*)(F.ws + WS_ACT + ACT_YB1);
    const float* SA = (const float*)(F.ws + WS_SA);
    LAS float* TC = (LAS float*)F.lds;
    for (int i = TID; i < D / 4; i += NWAVES * 64) { *(LAS f32x4*)(TC + 4 * i) = *(const f32x4*)(AR.in[24] + 4 * i); *(LAS f32x4*)(TC + D + 4 * i) = *(const f32x4*)(AR.in[25] + 4 * i); }
    __syncthreads();
    const int gw = F.vcu * NWAVES + WAVE, NGW = F.G * NWAVES;
    v4u yaA[4], ybA[4], vqA[4], yaB[4], ybB[4], vqB[4]; float s0A[4], s1A[4], s0B[4], s1B[4];
#define CB_LOAD(ya, yb, vq, s0, s1, r_) do { _Pragma("unroll") for (int c = 0; c < 4; ++c) { const unsigned o = (unsigned)((r_) * D + 512 * c + 8 * LANE) * 2u; \
            ya[c] = *(const v4u*)((const char*)YB0 + o); yb[c] = *(const v4u*)((const char*)YB1 + o); vq[c] = *(const v4u*)((const char*)VP + o); \
            s0[c] = SA[(r_) * 32 + 8 * c + (LANE >> 3)]; s1[c] = SA[(MT + (r_)) * 32 + 8 * c + (LANE >> 3)]; } } while (0)
#define CB_COMP(ya, yb, vq, s0, s1, r_) do { _Pragma("unroll") for (int c = 0; c < 4; ++c) { const int d = 512 * c + 8 * LANE; \
            const unsigned aw[4] = {ya[c].x, ya[c].y, ya[c].z, ya[c].w}, bw[4] = {yb[c].x, yb[c].y, yb[c].z, yb[c].w}, vw[4] = {vq[c].x, vq[c].y, vq[c].z, vq[c].w}; \
            float y[8]; float sum = 0.f; \
            _Pragma("unroll") for (int e = 0; e < 4; ++e) { y[2 * e] = bflo(aw[e]) + bflo(bw[e]); y[2 * e + 1] = bfhi(aw[e]) + bfhi(bw[e]); sum += y[2 * e] + y[2 * e + 1]; } \
            sum += __shfl_xor(sum, 1); sum += __shfl_xor(sum, 2); sum += __shfl_xor(sum, 4); \
            const float mean = sum * (1.f / 64.f); float vs = 0.f; \
            _Pragma("unroll") for (int i = 0; i < 8; ++i) { const float dl = y[i] - mean; vs += dl * dl; } \
            vs += __shfl_xor(vs, 1); vs += __shfl_xor(vs, 2); vs += __shfl_xor(vs, 4); \
            const float rstd = 1.0f / sqrtf(vs * (1.f / 64.f) + GN_EPS); \
            const float sb = 0.5f * (s0[c] + s1[c]);        \
            const f32x4 l0 = *(const LAS f32x4*)(TC + d), l1 = *(const LAS f32x4*)(TC + d + 4), b0 = *(const LAS f32x4*)(TC + D + d), b1 = *(const LAS f32x4*)(TC + D + d + 4); \
            const float lw_[8] = {l0.x, l0.y, l0.z, l0.w, l1.x, l1.y, l1.z, l1.w}, lb_[8] = {b0.x, b0.y, b0.z, b0.w, b1.x, b1.y, b1.z, b1.w}; \
            float o[8]; \
            _Pragma("unroll") for (int e = 0; e < 4; ++e) { o[2 * e] = (y[2 * e] - mean) * rstd * lw_[2 * e] + lb_[2 * e] + sb * bflo(vw[e]); o[2 * e + 1] = (y[2 * e + 1] - mean) * rstd * lw_[2 * e + 1] + lb_[2 * e + 1] + sb * bfhi(vw[e]); } \
            v4u w_; w_.x = pk2(o[0], o[1]); w_.y = pk2(o[2], o[3]); w_.z = pk2(o[4], o[5]); w_.w = pk2(o[6], o[7]); \
            *(v4u*)((char*)PO + (unsigned)((r_) * D + d) * 2u) = w_; } } while (0)
    int r = gw;
    if (r < ML) CB_LOAD(yaA, ybA, vqA, s0A, s1A, r);
#pragma unroll 1
    for (; r < ML; r += 2 * NGW) {
        const int r1 = r + NGW, r2 = r + 2 * NGW;
        if (r1 < ML) CB_LOAD(yaB, ybB, vqB, s0B, s1B, r1);
        CB_COMP(yaA, ybA, vqA, s0A, s1A, r);
        if (r2 < ML) CB_LOAD(yaA, ybA, vqA, s0A, s1A, r2);
        if (r1 < ML) CB_COMP(yaB, ybB, vqB, s0B, s1B, r1);
    }
#undef CB_LOAD
#undef CB_COMP
}

template <class RowMap, bool BLK = false>
__device__ __forceinline__ void transpose_item(const float* W, int K, int N, bf16* WT, const RowMap& rm, LAS float* scr, int item, int lane) {
    const int nblk = N / 32, kb = item / nblk, nb = item % nblk, k0 = 64 * kb, n0 = 32 * nb;
#pragma unroll 8
    for (int i = 0; i < 32; ++i) { const int kk = 2 * i + (lane >> 5); scr[kk * 33 + (lane & 31)] = W[(size_t)(k0 + kk) * N + n0 + (lane & 31)]; }
    LDS_WAIT(); asm volatile("" ::: "memory");
    const int c = lane & 7;
#pragma unroll
    for (int j = 0; j < 4; ++j) { const int n = (lane >> 3) + 8 * j; const LAS float* s = scr + (8 * c) * 33 + n;
        v4u o; o.x = pk2(s[0 * 33], s[1 * 33]); o.y = pk2(s[2 * 33], s[3 * 33]); o.z = pk2(s[4 * 33], s[5 * 33]); o.w = pk2(s[6 * 33], s[7 * 33]);
        const int nr = rm(n0 + n);
        if (BLK) *(v4u*)(WT + ((size_t)(nr >> 8) * (K / 64) + (k0 >> 6)) * 16384 + (size_t)(nr & 255) * 64 + 8 * c) = o;
        else *(v4u*)(WT + (size_t)nr * K + k0 + 8 * c) = o; }
    LDS_WAIT(); asm volatile("" ::: "memory");
}
struct RmId { __device__ __forceinline__ int operator()(int n) const { return n; } };
struct RmW13 { __device__ __forceinline__ int operator()(int n) const { const int bj = n >= DFF ? 1 : 0, j = n - bj * DFF; return 256 * (j >> 7) + 128 * bj + (j & 127); } };

__device__ __forceinline__ void p0_prologue(Frame& F, const Args& AR) {
    int tid_ = threadIdx.x; asm volatile("" : "+v"(tid_)); const int TID = tid_, LANE = tid_ & 63, WAVE = __builtin_amdgcn_readfirstlane(tid_ >> 6);
    const float* x_c = AR.in[1]; const float* c_ctx = AR.in[3]; const float* mod_w = AR.in[4];
    for (int i = blockIdx.x * (NWAVES * 64) + TID; i < 6 * 262144 / 4; i += F.G * NWAVES * 64) ((f32x4*)(F.ws + WS_PS))[i] = (f32x4){0.f, 0.f, 0.f, 0.f};
    {
        LAS float* sil = (LAS float*)(F.lds);
        LAS f32x4* red = (LAS f32x4*)(F.lds + 24576);
        for (int i = TID; i < 3 * D; i += NWAVES * 64) { const int who = i / D, k = i % D; const float v = who < 2 ? x_c[who * D + k] : c_ctx[k]; sil[i] = v * sigmoidf_(v); }
        __syncthreads();
        for (int t = blockIdx.x; t < 576; t += F.G) {
            const int q = t & 3, cb = (t >> 2) % 72, layer = t / 288;
            const int r0 = q * 512 + WAVE * 64;
            const float* wp = mod_w + ((size_t)layer * D + r0) * NMODV + cb * 256 + LANE * 4;
            f32x4 a0 = {0.f, 0.f, 0.f, 0.f}, a1 = a0, a2 = a0;
#pragma unroll 8
            for (int r = 0; r < 64; ++r) { const f32x4 w = *(const f32x4*)(wp + (size_t)r * NMODV); a0 += w * sil[r0 + r]; a1 += w * sil[D + r0 + r]; a2 += w * sil[2 * D + r0 + r]; }
            red[(WAVE * 3 + 0) * 64 + LANE] = a0; red[(WAVE * 3 + 1) * 64 + LANE] = a1; red[(WAVE * 3 + 2) * 64 + LANE] = a2;
            __syncthreads();
            if (WAVE < 3) { f32x4 s = {0.f, 0.f, 0.f, 0.f};
#pragma unroll
                for (int w = 0; w < 8; ++w) s += red[(w * 3 + WAVE) * 64 + LANE];
                *(f32x4*)((float*)(F.ws + WS_MODP) + ((size_t)(q * 2 + layer) * 3 + WAVE) * NMODV + cb * 256 + LANE * 4) = s; }
            __syncthreads();
        }
    }
    LAS float* scr = (LAS float*)(F.lds + WAVE * 16384);
    const int gw = F.vcu * NWAVES + WAVE, NGW = F.G * NWAVES;
    {
        constexpr int I13 = (D / 64) * (2 * DFF / 32), I2 = (DFF / 64) * (D / 32), IDD = (D / 64) * (D / 32);
        constexpr int NIT = 4 * I13 + 4 * I2 + 5 * IDD + 2 * (D / 64) * (256 / 32) / 1;
        for (int it = gw; it < NIT; it += NGW) {
            int r = it;
            if (r < 4 * I13) { const int lf = r / I13; r -= lf * I13; const int l = lf >> 1, f = lf & 1;
                transpose_item<RmW13, true>(AR.in[7] + (size_t)lf * D * 2 * DFF, D, 2 * DFF, (bf16*)(F.ws + (l ? WS_WL1 : WS_WL0) + (size_t)f * 44 * MiB), RmW13(), scr, r, LANE); continue; }
            r -= 4 * I13;
            if (r < 4 * I2) { const int lf = r / I2; r -= lf * I2; const int l = lf >> 1, f = lf & 1;
                transpose_item<RmId, true>(AR.in[8] + (size_t)lf * DFF * D, DFF, D, (bf16*)(F.ws + (l ? WS_WL1 : WS_WL0) + 88 * MiB + (size_t)f * 22 * MiB), RmId(), scr, r, LANE); continue; }
            r -= 4 * I2;
            if (r < IDD) { transpose_item(AR.in[9], D, D, (bf16*)(F.ws + WS_WFO), RmId(), scr, r, LANE); continue; }
            r -= IDD;
            if (r < 3 * IDD) { const int p = r / IDD; r -= p * IDD; transpose_item(AR.in[12] + (size_t)p * D * D, D, D, (bf16*)(F.ws + WS_WRKV + (size_t)p * 8 * MiB), RmId(), scr, r, LANE); continue; }
            r -= 3 * IDD;
            if (r < IDD) { transpose_item(AR.in[26], D, D, (bf16*)(F.ws + WS_WRO), RmId(), scr, r, LANE); continue; }
            r -= IDD;
            if (r < 256) { transpose_item(AR.in[19], D, 256, (bf16*)(F.ws + WS_WSMALL + WSM_G1T), RmId(), scr, r, LANE); continue; }
            r -= 256;
            transpose_item(AR.in[20], 256, D, (bf16*)(F.ws + WS_WSMALL + WSM_G2T), RmId(), scr, r, LANE);
        }
    }
    {
        const int gt = (F.vcu * NWAVES + WAVE) * 64 + LANE, NGT = F.G * NWAVES * 64;
        for (int i = gt; i < 2 * 256 * D; i += NGT) { const int which = i / (256 * D), rr = (i / D) % 256, k = i % D;
            float v = 0.f; if (rr < 192) { const int z = rr / 96, r = rr % 96; v = AR.in[which ? 17 : 14][((size_t)z * D + k) * LORA + r]; }
            ((bf16*)(F.ws + WS_WSMALL + (which ? WSM_A1CAT : WSM_W1CAT)))[(size_t)rr * D + k] = (bf16)(pk2(v, 0.f) & 0xffffu); }
        for (int i = gt; i < 2 * 2 * D * LORA; i += NGT) { const int which = i / (2 * D * LORA), j = i % (2 * D * LORA), z = j / (D * LORA), n = (j / LORA) % D, r = j % LORA;
            const float v = AR.in[which ? 18 : 15][((size_t)z * LORA + r) * D + n];
            ((bf16*)(F.ws + WS_WSMALL + (which ? WSM_A2UP : WSM_W2UP)))[j] = (bf16)(pk2(v, 0.f) & 0xffffu); }
        for (int i = gt; i < MC * D / 4; i += NGT) ((f32x4*)(F.ws + WS_XC))[i] = ((const f32x4*)AR.in[2])[i];
        const float RS128 = 0.08838834764831845f;
        bf16* dm = (bf16*)(F.ws + WS_TAB + TAB_DMAT); bf16* m1 = (bf16*)(F.ws + WS_TAB + TAB_M1); bf16* m2 = (bf16*)(F.ws + WS_TAB + TAB_M2); bf16* m3 = (bf16*)(F.ws + WS_TAB + TAB_M3);
        f32x2* tw = (f32x2*)(F.ws + WS_TAB + TAB_TW);
        for (int i = gt; i < 512 * 256; i += NGT) { const int r = i >> 8, ch = i & 255, cs = r >> 8, kc = r & 255; float s, c; sincospif((float)((kc * ch) & 255) * (1.f / 128.f), &s, &c);
            dm[i] = (bf16)(pk2((cs ? s : c) * 0.0625f, 0.f) & 0xffffu); }
        for (int i = gt; i < 256 * 256; i += NGT) { const int r = i >> 8, ci = i & 255, ri = r >> 7, k1 = r & 127, cs = ci >> 7, n1 = ci & 127; float s, c; sincospif((float)((k1 * n1) & 127) * (1.f / 64.f), &s, &c);
            const float v1 = ri == 0 ? (cs == 0 ? c : -s) : (cs == 0 ? s : c);
            m1[i] = (bf16)(pk2(v1 * RS128, 0.f) & 0xffffu);
            const float v2 = r < 128 ? (cs == 0 ? c : -s) : 0.f;
            m2[i] = (bf16)(pk2(v2 * RS128, 0.f) & 0xffffu); }
        for (int i = gt; i < 256 * 512; i += NGT) { const int k = i >> 9, ci = i & 511, cs = ci >> 8, n = ci & 255; float s, c; sincospif((float)((k * n) & 255) * (1.f / 128.f), &s, &c);
            m3[i] = (bf16)(pk2((cs ? -s : c) * 0.0625f, 0.f) & 0xffffu); }
        for (int i = gt; i < 128 * 128; i += NGT) { const int k1 = i >> 7, n2 = i & 127; float s, c; sincospif((float)(k1 * n2) * (1.f / 8192.f), &s, &c); tw[i] = (f32x2){c, s}; }
    }
}

template <bool BLK = false, bool FIRST = false> __device__ __forceinline__ void phase_norm(Frame& F, const float* xl, const float* xc, int r0, int Mrows, const float* nw, int layer, int sidx, bf16* HN) {
    int tid_ = threadIdx.x; asm volatile("" : "+v"(tid_)); const int TID = tid_, LANE = tid_ & 63, WAVE = __builtin_amdgcn_readfirstlane(tid_ >> 6);
    LAS float* TA = (LAS float*)(F.lds);
    LAS float* TB = (LAS float*)(F.lds + 24576);
    for (int i = TID; i < 3 * D / 4; i += NWAVES * 64) { const int who = i / (D / 4), d = (i % (D / 4)) * 4;
        const ModRef MR{(const float*)(F.ws + WS_MODP), F.modb, (const float*)(F.ws + WS_MODV)};
        const f32x4 sh = FIRST ? modv4(MR, layer, who, sidx * D + d) : modvF(MR, layer, who, sidx * D + d), sc = FIRST ? modv4(MR, layer, who, (sidx + 1) * D + d) : modvF(MR, layer, who, (sidx + 1) * D + d), g = *(const f32x4*)(nw + d);
        *(LAS f32x4*)(TA + who * D + d) = g * (sc + 1.f); *(LAS f32x4*)(TB + who * D + d) = sh; }
    if (FIRST) {
        const ModRef MR{(const float*)(F.ws + WS_MODP), F.modb, nullptr}; float* MV = (float*)(F.ws + WS_MODV);
        for (int i = F.vcu * (NWAVES * 64) + TID; i < 6 * NMODV / 4; i += F.G * NWAVES * 64) { const int lw = i / (NMODV / 4), c = (i % (NMODV / 4)) * 4; *(f32x4*)(MV + (size_t)lw * NMODV + c) = modv4(MR, lw / 3, lw % 3, c); }
    }
    __syncthreads();
    const int gw = F.vcu * NWAVES + WAVE, NGW = F.G * NWAVES;
    for (int r = r0 + gw; r < Mrows; r += NGW) {
        const int who = who_of_row(r);
        const float* xr = r < ML ? xl + (size_t)r * D : xc + (size_t)(r - ML) * D;
        f32x4 v[4][2]; float ss = 0.f;
#pragma unroll
        for (int j = 0; j < 4; ++j)
#pragma unroll
            for (int h = 0; h < 2; ++h) { v[j][h] = *(const f32x4*)(xr + 512 * j + 8 * LANE + 4 * h); ss += (v[j][h].x * v[j][h].x + v[j][h].y * v[j][h].y) + (v[j][h].z * v[j][h].z + v[j][h].w * v[j][h].w); }
        const float rstd = 1.0f / sqrtf(wave_sum(ss) * (1.f / D) + NORM_EPS);
#pragma unroll
        for (int j = 0; j < 4; ++j) { const int d = 512 * j + 8 * LANE;
            const f32x4 a0 = *(const LAS f32x4*)(TA + who * D + d), a1 = *(const LAS f32x4*)(TA + who * D + d + 4), b0 = *(const LAS f32x4*)(TB + who * D + d), b1 = *(const LAS f32x4*)(TB + who * D + d + 4);
            const f32x4 o0 = v[j][0] * rstd * a0 + b0, o1 = v[j][1] * rstd * a1 + b1;
            v4u w; w.x = pk2(o0.x, o0.y); w.y = pk2(o0.z, o0.w); w.z = pk2(o1.x, o1.y); w.w = pk2(o1.z, o1.w);
            if (BLK) *(v4u*)(HN + ((size_t)(r >> 8) * (D / 64) + (d >> 6)) * 16384 + (size_t)(r & 255) * 64 + (d & 63)) = w;
            else *(v4u*)(HN + (size_t)r * D + d) = w; }
    }
}
__device__ __forceinline__ void phase_final(Frame& F, float* x, const float* w) {
    int tid_ = threadIdx.x; asm volatile("" : "+v"(tid_)); const int TID = tid_, LANE = tid_ & 63, WAVE = __builtin_amdgcn_readfirstlane(tid_ >> 6);
    const int gw = F.vcu * NWAVES + WAVE, NGW = F.G * NWAVES;
    for (int r = gw; r < ML; r += NGW) {
        float* xr = x + (size_t)r * D;
        f32x4 v[8]; float ss = 0.f;
#pragma unroll
        for (int j = 0; j < 8; ++j) { v[j] = *(const f32x4*)(xr + 256 * j + 4 * LANE); ss += (v[j].x * v[j].x + v[j].y * v[j].y) + (v[j].z * v[j].z + v[j].w * v[j].w); }
        const float rstd = 1.0f / sqrtf(wave_sum(ss) * (1.f / D) + NORM_EPS);
#pragma unroll
        for (int j = 0; j < 8; ++j) { const f32x4 g = *(const f32x4*)(w + 256 * j + 4 * LANE); *(f32x4*)(xr + 256 * j + 4 * LANE) = v[j] * rstd * g; }
    }
}

#if MK_DEBUG
__device__ __forceinline__ void dbg_flag(unsigned* ctl, unsigned code) { atomicMax(ctl + CW_DBG, code); }
__device__ __forceinline__ bool dbg_bad(float got, float ref, float atol, float rtol) { const float e = fabsf(got - ref); return !(e <= atol + rtol * fabsf(ref)); }
__device__ __forceinline__ unsigned dbg_hash(unsigned x) { x ^= x >> 16; x *= 0x7feb352du; x ^= x >> 15; x *= 0x846ca68bu; x ^= x >> 16; return x; }
__device__ __noinline__ void dbg_check_mod(unsigned char* ws, const float* c, const float* c_ctx, const float* mod_w, const float* modb) {
    const int lane = threadIdx.x & 63, gw = blockIdx.x * 8 + (threadIdx.x >> 6);
    if (gw >= 96) return;
    const unsigned h = dbg_hash(gw * 2654435761u + 17u); const int layer = h & 1, who = (h >> 1) % 3, col = ((h >> 4) % NMODV) & ~3;
    float s = 0.f;
    for (int k = lane; k < D; k += 64) { const float v = who < 2 ? c[who * D + k] : c_ctx[k]; s += v / (1.f + expf(-v)) * mod_w[((size_t)layer * D + k) * NMODV + col]; }
    s = wave_sum(s) + modb[(size_t)layer * NMODV + col];
    const ModRef MR{(const float*)(ws + WS_MODP), modb};
    const f32x4 g = modv4(MR, layer, who, col);
    if (lane == 0 && dbg_bad(g.x, s, 2e-3f, 2e-3f)) dbg_flag((unsigned*)(ws + WS_CTL), 1u);
}
__device__ __noinline__ void dbg_check_hn(unsigned char* ws, const float* x, const float* ctx, const float* nw, const float* modb, int layer, int sidx, unsigned code) {
    const int lane = threadIdx.x & 63, gw = blockIdx.x * 8 + (threadIdx.x >> 6);
    if (gw >= 64) return;
    const int r = (gw < 48) ? (int)(dbg_hash(gw + 99u) % ML) : ML + (int)(dbg_hash(gw + 7u) % MC);
    const float* xr = r < ML ? x + (size_t)r * D : ctx + (size_t)(r - ML) * D; const int who = who_of_row(r);
    float ss = 0.f; for (int d = lane; d < D; d += 64) ss += xr[d] * xr[d];
    const float rstd = 1.0f / sqrtf(wave_sum(ss) / D + NORM_EPS);
    const ModRef MR{(const float*)(ws + WS_MODP), modb}; const bf16* HN = (const bf16*)(ws + WS_ACT + ACT_HN);
    bool bad = false;
    for (int d4 = lane * 4; d4 < D; d4 += 256) { const f32x4 sh = modv4(MR, layer, who, sidx * D + d4), sc = modv4(MR, layer, who, (sidx + 1) * D + d4);
        for (int e = 0; e < 4; ++e) { const float ref = xr[d4 + e] * rstd * nw[d4 + e] * (1.f + sc[e]) + sh[e]; bad |= dbg_bad(bf2f(HN[(size_t)r * D + d4 + e]), ref, 0.03f, 0.01f); } }
    if (bad) dbg_flag((unsigned*)(ws + WS_CTL), code);
}
__device__ __noinline__ void dbg_check_h(unsigned char* ws, const float* w13) {
    const int lane = threadIdx.x & 63, gw = blockIdx.x * 8 + (threadIdx.x >> 6);
    if (gw >= 512) return;
    const unsigned h = dbg_hash(gw + 1234u); const int r = (gw & 7) == 7 ? ML + (int)(h % MC) : (int)(h % ML), j = (int)((h >> 7) % DFF);
    const bf16* HN = (const bf16*)(ws + WS_ACT + ACT_HN); const bf16* HB = (const bf16*)(ws + WS_ACT + ACT_H);
    float g = 0.f, u = 0.f;
    for (int k = lane; k < D; k += 64) { const float a = bf2f(HN[(size_t)r * D + k]); g += a * w13[(size_t)k * 2 * DFF + j]; u += a * w13[(size_t)k * 2 * DFF + DFF + j]; }
    g = wave_sum(g); u = wave_sum(u);
    const float ref = g / (1.f + expf(-g)) * u;
    if (lane == 0 && dbg_bad(bf2f(HB[(size_t)r * DFF + j]), ref, 0.03f, 0.03f)) dbg_flag((unsigned*)(ws + WS_CTL), 3u);
}
__device__ __noinline__ void dbg_check_w2(unsigned char* ws, const float* x, const float* ctx, const float* out, const float* w2, const float* modb) {
    const int lane = threadIdx.x & 63, gw = blockIdx.x * 8 + (threadIdx.x >> 6);
    if (gw >= 512) return;
    const unsigned h = dbg_hash(gw + 4321u); const int r = (gw & 7) == 7 ? ML + (int)(h % MC) : (int)(h % ML), col = (int)((h >> 7) % D) & ~3;
    const bf16* HB = (const bf16*)(ws + WS_ACT + ACT_H);
    float a = 0.f; for (int j = lane; j < DFF; j += 64) a += bf2f(HB[(size_t)r * DFF + j]) * w2[(size_t)j * D + col];
    a = wave_sum(a);
    const ModRef MR{(const float*)(ws + WS_MODP), modb}; const f32x4 gt = modv4(MR, 0, who_of_row(r), 2 * D + col);
    const float base = r < ML ? x[(size_t)r * D + col] : ctx[(size_t)(r - ML) * D + col];
    const float got = r < ML ? out[(size_t)r * D + col] : ((const float*)(ws + WS_XC))[(size_t)(r - ML) * D + col];
    if (lane == 0 && dbg_bad(got, base + 0.5f * gt.x * a, 0.02f, 0.01f)) dbg_flag((unsigned*)(ws + WS_CTL), 4u);
}
__device__ __noinline__ void dbg_check_fourier(unsigned char* ws, const float* xl, const float* nw, const float* modb, LAS float* red) {
    const int lane = threadIdx.x & 63, wave = threadIdx.x >> 6;
    if (blockIdx.x >= 40) return;
    const unsigned h = dbg_hash(blockIdx.x + 555u); const bool isc = blockIdx.x >= 32;
    const int L = isc ? CTXL : SEQ, b = h & 1, k = (int)((h >> 1) % (unsigned)L), g = (h >> 17) & 7, ch = (h >> 20) & 255;
    const float* xb = isc ? (const float*)(ws + WS_XC) + (size_t)b * CTXL * D : xl + (size_t)b * SEQ * D; const int who = isc ? 2 : b;
    const ModRef MR{(const float*)(ws + WS_MODP), modb};
    const int c0 = g * 256 + lane * 4; const f32x4 sh = modv4(MR, 0, who, 3 * D + c0), sc = modv4(MR, 0, who, 4 * D + c0);
    float acc = 0.f;
    for (int n = wave; n < L; n += 8) { const float* xr = xb + (size_t)n * D;
        float ss = 0.f; for (int d = lane; d < D; d += 64) ss += xr[d] * xr[d];
        const float rstd = 1.0f / sqrtf(wave_sum(ss) / D + NORM_EPS);
        const float fl = (float)((k * n) % L) / (float)L;
        for (int e = 0; e < 4; ++e) { const int c = lane * 4 + e; float hv = xr[c0 + e] * rstd * nw[c0 + e] * (1.f + sc[e]) + sh[e]; hv = bflo(pk2(hv, 0.f));
            acc += hv * cospif(2.f * (fl + (float)((ch * c) & 255) * (1.f / 256.f))); } }
    acc = wave_sum(acc); if (lane == 0) red[wave] = acc; __syncthreads();
    if (threadIdx.x == 0) { float t = 0.f; for (int w = 0; w < 8; ++w) t += red[w]; t *= isc ? (1.f / 256.f) : (1.f / 2048.f);
        const size_t row = isc ? (size_t)ML + b * CTXL + k : (size_t)b * SEQ + k; const float got = bf2f(((const bf16*)(ws + WS_ACT + ACT_HN))[row * D + g * 256 + ch]);
        if (dbg_bad(got, t, 0.04f, 0.02f)) dbg_flag((unsigned*)(ws + WS_CTL), isc ? 6u : 5u); }
}
__device__ __noinline__ void dbg_check_rkv(unsigned char* ws, const float* wrkv) {
    const int lane = threadIdx.x & 63, gw = blockIdx.x * 8 + (threadIdx.x >> 6);
    if (gw >= 768) return;
    const unsigned h = dbg_hash(gw + 777u); const int wsel = gw % 3, r = (gw & 7) == 7 ? ML + (int)(h % MC) : (int)(h % ML), col = (int)((h >> 9) % D);
    const bf16* A = (const bf16*)(ws + WS_ACT + ACT_XM + (size_t)wsel * XM_STRIDE); const bf16* O = (const bf16*)(ws + WS_ACT + ACT_XM + (size_t)(3 + wsel) * XM_STRIDE);
    float a = 0.f; for (int k = lane; k < D; k += 64) a += bf2f(A[(size_t)r * D + k]) * wrkv[((size_t)wsel * D + k) * D + col];
    a = wave_sum(a);
    if (lane == 0 && dbg_bad(bf2f(O[(size_t)r * D + col]), a, 0.03f, 0.02f)) dbg_flag((unsigned*)(ws + WS_CTL), 8u);
}
__device__ __noinline__ void dbg_check_lora(unsigned char* ws, const float* w1, const float* a1, const float* g1) {
    const int lane = threadIdx.x & 63, gw = blockIdx.x * 8 + (threadIdx.x >> 6);
    if (gw >= 768) return;
    const unsigned h = dbg_hash(gw + 888u); const int which = gw % 3, r = (gw & 7) == 7 ? ML + (int)(h % MC) : (int)(h % ML);
    const int col = which == 2 ? (int)((h >> 9) % 256) : (int)((h >> 9) % 192);
    const bf16* A = (const bf16*)(ws + WS_ACT + ACT_XM + (size_t)(3 + which) * XM_STRIDE); const bf16* O = (const bf16*)(ws + WS_ACT + ACT_LR + (size_t)which * LR_STRIDE);
    float a = 0.f;
    for (int k = lane; k < D; k += 64) { const float wv = which == 2 ? g1[(size_t)k * 256 + col] : (which ? a1 : w1)[((size_t)(col / 96) * D + k) * LORA + (col % 96)]; a += bf2f(A[(size_t)r * D + k]) * wv; }
    a = wave_sum(a); const float ref = which == 0 ? tanhf(a) : (which == 2 ? 1.f / (1.f + expf(-a)) : a);
    if (lane == 0 && dbg_bad(bf2f(O[(size_t)r * 256 + col]), ref, 0.02f, 0.02f)) dbg_flag((unsigned*)(ws + WS_CTL), 9u);
}
__device__ __noinline__ void dbg_check_scan(unsigned char* ws, const float* p_w0, const float* p_a0, const float* p_kk, const float* p_ka, const float* p_w2, const float* p_a2) {
    const int lane = threadIdx.x & 63, gw = blockIdx.x * 8 + (threadIdx.x >> 6);
    if (gw >= 64) return;
    const unsigned hsh = dbg_hash(gw + 31337u); const int chain = hsh & 127, i = (hsh >> 8) & 63, b = chain >> 6, hd = (chain >> 1) & 31, z = chain & 1;
    const bf16* RKV = (const bf16*)(ws + WS_ACT + ACT_XM + 3 * XM_STRIDE);
    const bf16* TWb = (const bf16*)(ws + WS_ACT + ACT_LR); const bf16* TAb = (const bf16*)(ws + WS_ACT + ACT_LR + LR_STRIDE);
    const bf16* YB = (const bf16*)(ws + WS_ACT + (z ? ACT_YB1 : ACT_YB0));
    const int ch = hd * 64 + lane;
    const float w0 = p_w0[z * D + ch], a0 = p_a0[z * D + ch], kkc = p_kk[ch], kac = p_ka[ch];
    float st = 0.f; float worst = 0.f;
    for (int s_ = 0; s_ < CTXL + SEQ; ++s_) {
        const int row = scan_row(b, z, s_);
        float lwv = 0.f, lav = 0.f;
        for (int r = 0; r < LORA; ++r) { lwv += bf2f(TWb[(size_t)row * 256 + z * 96 + r]) * p_w2[((size_t)z * LORA + r) * D + ch]; lav += bf2f(TAb[(size_t)row * 256 + z * 96 + r]) * p_a2[((size_t)z * LORA + r) * D + ch]; }
        const float xw = w0 + lwv, logw = -log1pf(expf(-xw)) - 0.5f, dec = expf(-expf(logw));
        const float asig = 1.f / (1.f + expf(-(a0 + lav)));
        const float rj = bf2f(RKV[(size_t)row * D + ch]), kj = bf2f(RKV[(size_t)MT * D + (size_t)row * D + ch]), vi = bf2f(RKV[2 * (size_t)MT * D + (size_t)row * D + hd * 64 + i]);
        const float kr = kj * kkc; const float nrm = wave_sum(kr * kr); const float kkj = kr / sqrtf(fmaxf(nrm, 1e-24f));
        const float aj = -kkj, bj = kkj * asig, kdj = kj * (1.f + (asig - 1.f) * kac);
        const float sa = wave_sum(st * aj);
        st = st * dec + sa * bj + vi * kdj;
        const float y = wave_sum(st * rj);
        if (s_ >= CTXL) { const float got = bf2f(YB[(size_t)row * D + hd * 64 + i]); const float e = fabsf(got - y) / (0.05f + 0.03f * fabsf(y)); worst = fmaxf(worst, e); }
    }
    if (lane == 0 && !(worst <= 1.f)) dbg_flag((unsigned*)(ws + WS_CTL), 10u);
}
__device__ __noinline__ void dbg_check_combine(unsigned char* ws, const float* p_ka, const float* p_rk, const float* p_lnw, const float* p_lnb) {
    const int lane = threadIdx.x & 63, gw = blockIdx.x * 8 + (threadIdx.x >> 6);
    if (gw >= 256) return;
    const unsigned hsh = dbg_hash(gw + 4242u); const int r = (int)(hsh % ML), hd = (hsh >> 20) & 31, ch = hd * 64 + lane;
    const bf16* RKV = (const bf16*)(ws + WS_ACT + ACT_XM + 3 * XM_STRIDE);
    const float y = bf2f(((const bf16*)(ws + WS_ACT + ACT_YB0))[(size_t)r * D + ch]) + bf2f(((const bf16*)(ws + WS_ACT + ACT_YB1))[(size_t)r * D + ch]);
    const float mean = wave_sum(y) / 64.f, var = wave_sum((y - mean) * (y - mean)) / 64.f;
    const float rj = bf2f(RKV[(size_t)r * D + ch]), kj = bf2f(RKV[(size_t)MT * D + (size_t)r * D + ch]), vj = bf2f(RKV[2 * (size_t)MT * D + (size_t)r * D + ch]);
    const float* SA = (const float*)(ws + WS_SA);
    const float sb = wave_sum(rj * p_rk[ch] * kj * (1.f - p_ka[ch])) + 0.5f * (SA[(size_t)r * 32 + hd] + SA[((size_t)MT + r) * 32 + hd]);
    const float ref = (y - mean) / sqrtf(var + GN_EPS) * p_lnw[ch] + p_lnb[ch] + sb * vj;
    const float got = bf2f(((const bf16*)(ws + WS_ACT + ACT_PO))[(size_t)r * D + ch]);
    if (dbg_bad(got, ref, 0.03f, 0.02f)) dbg_flag((unsigned*)(ws + WS_CTL), 12u);
}
__device__ __noinline__ void dbg_final(unsigned char* ws, float* out) {
    const unsigned code = __hip_atomic_load((unsigned*)(ws + WS_CTL) + CW_DBG, __ATOMIC_RELAXED, __HIP_MEMORY_SCOPE_AGENT);
    if (code) for (size_t i = (size_t)blockIdx.x * 512 + threadIdx.x; i < (size_t)ML * D; i += (size_t)gridDim.x * 512) out[i] = 1000.f * code;
}
#define DBG_PHASE(stmt) PH_BEGIN stmt; PH_END
#else
#define DBG_PHASE(stmt)
#endif

constexpr int NPH = 42;
__global__ void __launch_bounds__(NWAVES * 64, 2) mk_fwd(const Args args) {
    const Args& AR = args;
    extern __shared__ __attribute__((aligned(16))) unsigned char lds[];
    Frame F;
    F.lds = (LAS unsigned char*)lds;
    F.MISC = (volatile LAS unsigned*)(F.lds + LDSCTL_OFF);
    F.G = gridDim.x; { const int bx = blockIdx.x; F.vcu = (F.G % 8 == 0) ? (bx % 8) * (F.G / 8) + bx / 8 : bx; }
    F.ws = args.ws; F.ctl = (unsigned*)(args.ws + WS_CTL); F.out = args.out;
    F.modb = args.in[5];
    if (threadIdx.x < 16) ((LAS unsigned*)(F.lds + LDSCTL_OFF))[threadIdx.x] = 0u;
    __syncthreads();
    XcdBarrier bar; bar.bar = F.ctl + CW_BAR; bar.x = 0; bar.st = nullptr;
    if (!MK_PER_PHASE) bar = xcd_barrier_post(F.ctl + CW_BAR, F.MISC + 8);
    const int lo = args.ph_lo, hi = args.ph_hi;
    int ph = 0;
#define PH_BEGIN if (ph >= lo && ph < hi) {
#define PH_END   if (ph + 1 < hi) { if (MK_PER_PHASE) { if (threadIdx.x == 0) __hip_atomic_store(F.ctl + 0, 0xBADu, __ATOMIC_RELAXED, __HIP_MEMORY_SCOPE_AGENT); } else { xcd_barrier(bar); if (MK_PROBE & 16384) xcd_barrier(bar); } } } ++ph;

    float* XC = (float*)(F.ws + WS_XC);
    const ModRef MR{(const float*)(F.ws + WS_MODP), args.in[5], (const float*)(F.ws + WS_MODV)};
    bf16* HN = (bf16*)(F.ws + WS_ACT + ACT_HN);
    bf16* HB = (bf16*)(F.ws + WS_ACT + ACT_H);
    bf16* HNA = (bf16*)(F.ws + WS_ACT + 500 * MiB);
    float* PSB = (float*)(F.ws + WS_PS); float* RSTD = (float*)(F.ws + WS_RSTD);

    REP(16) PH_BEGIN p0_prologue(F, args); PH_END
    DBG_PHASE(dbg_check_mod(F.ws, AR.in[1], AR.in[3], AR.in[4], AR.in[5]))

#define FFN_STAGE(s_) do { constexpr int s = (s_); constexpr int layer = s >> 1, f = s & 1; constexpr int Mrows = (s == 3) ? ML : MT; \
        const float* srcL = (s == 0) ? AR.in[0] : F.out; const float* srcC = XC; \
        bf16* HNs = (s & 1) ? HNA : HN;        \
        if (s == 0) { REP(4) PH_BEGIN phase_norm<true, true>(F, srcL, srcC, 0, Mrows, AR.in[6] + (size_t)(layer * 3 + (f ? 2 : 0)) * D, layer, f ? 6 : 0, HNs); PH_END } \
        else if (s != 3) { PH_BEGIN phase_norm<true>(F, srcL, srcC, ML, Mrows, AR.in[6] + (size_t)(layer * 3 + (f ? 2 : 0)) * D, layer, f ? 6 : 0, HNs); PH_END }        \
        if (s == 0) { DBG_PHASE(dbg_check_hn(F.ws, AR.in[0], AR.in[2], AR.in[6], AR.in[5], 0, 0, 2u)) } \
        REP(s == 0 ? 2 : 0) PH_BEGIN { \
            OpBlk A{HNs, D / 64, true}, B{(const bf16*)(F.ws + (layer ? WS_WL1 : WS_WL0) + (size_t)f * 44 * MiB), D / 64, false}; \
            pg8::StaticOrder S; S.init(Mrows / 256, DFF / 128, F.G, (int)blockIdx.x); \
            EpiSwiGLU E{HB}; \
            pg8::gemm_phase(F.lds + RING_OFF, D, A, B, S, E); \
        } PH_END \
        if (s == 0) { DBG_PHASE(dbg_check_h(F.ws, AR.in[7])) } \
        PH_BEGIN { \
            OpHBlk A{HB, -1, 0}; OpBlk B{(const bf16*)(F.ws + (layer ? WS_WL1 : WS_WL0) + 88 * MiB + (size_t)f * 22 * MiB), HKT, false}; \
            pg8::StaticOrder S; S.init(ML / 256, D / 256, F.G, (int)blockIdx.x, 4, 0, 1); \
              \
            constexpr int NX = (s == 0) ? 2 : (s == 1) ? 1 : (s == 2) ? 3 : 4; constexpr int site = (s == 0) ? 0 : (s == 1) ? 2 : (s == 2) ? 3 : 5; \
            const float* nwn = (s == 0) ? AR.in[6] + (size_t)(0 * 3 + 1) * D : (s == 1) ? AR.in[6] + (size_t)(1 * 3 + 0) * D : AR.in[27]; \
            EpiResidNorm<false, true, NX> E{MR, srcL, F.out, nullptr, layer, f ? 8 : 2, nwn, (s == 0) ? 0 : 1, (s == 0) ? 3 : 0, HN, RSTD, PSB + (size_t)site * 262144, F.ctl + CW_PCNT + site * 1024, F.lds + RING_BYTES}; \
            pg8::gemm_phase(F.lds + RING_OFF, DFF, A, B, S, E); \
            if (Mrows > ML) { OpHBlk Ac{HB, 128, HKT / 4}; OpBlkK Bc{(const bf16*)(F.ws + (layer ? WS_WL1 : WS_WL0) + 88 * MiB + (size_t)f * 22 * MiB), HKT}; \
                OrderCtxK Sc{F.G, (int)blockIdx.x}; EpiCtxAtomic<false, true> Ec{MR, XC, nullptr, layer, f ? 8 : 2}; \
                pg8::gemm_phase(F.lds + RING_OFF, DFF / 4, Ac, Bc, Sc, Ec); } \
        } PH_END \
        if (s == 0) { DBG_PHASE(dbg_check_w2(F.ws, AR.in[0], AR.in[2], F.out, AR.in[8], AR.in[5])) } \
    } while (0)

    FFN_STAGE(0);
        {
            bf16* YT = (bf16*)(F.ws + WS_ACT + ACT_YT); bf16* T2 = (bf16*)(F.ws + WS_ACT + ACT_T2); bf16* YC = (bf16*)(F.ws + WS_ACT + ACT_YC);
            PH_BEGIN phase_norm<false>(F, F.out, XC, ML, MT, AR.in[6] + (size_t)(0 * 3 + 1) * D, 0, 3, HN); PH_END
            REP(64) PH_BEGIN {
                { OpFixed A{(const bf16*)(F.ws + WS_TAB + TAB_DMAT), 256, 1}; OpChanL B{HN}; pg8::StaticOrder S; S.init(16, 128, F.G, (int)blockIdx.x); EpiChanL E{YT};
                  pg8::gemm_phase(F.lds + RING_OFF, 256, A, B, S, E); }
                { OpFixed A{(const bf16*)(F.ws + WS_TAB + TAB_DMAT), 256, 1}; OpChanC B{HN}; pg8::StaticOrder S; S.init(16, 2, F.G, (int)blockIdx.x); EpiChanC E{YC};
                  pg8::gemm_phase(F.lds + RING_OFF, 256, A, B, S, E); }
            } PH_END
            REP(64) PH_BEGIN {
                { OpFixed A{(const bf16*)(F.ws + WS_TAB + TAB_M1), 256, 0}; pg8::OpPlain B{YT, 256, false}; pg8::StaticOrder S; S.init(1, 2048, F.G, (int)blockIdx.x); EpiStage1 E{T2, (const float*)(F.ws + WS_TAB + TAB_TW)};
                  pg8::gemm_phase(F.lds + RING_OFF, 256, A, B, S, E); }
                { OpFixed A{(const bf16*)(F.ws + WS_TAB + TAB_M3), 512, 0}; pg8::OpPlain B{YC, 512, false}; pg8::StaticOrder S; S.init(1, 16, F.G, (int)blockIdx.x); EpiCtxDft E{HN};
                  pg8::gemm_phase(F.lds + RING_OFF, 512, A, B, S, E); }
            } PH_END
            REP(64) PH_BEGIN {
                OpFixed A{(const bf16*)(F.ws + WS_TAB + TAB_M2), 256, 0}; OpStage2B B{T2}; pg8::StaticOrder S; S.init(1, 2048, F.G, (int)blockIdx.x); EpiStage2 E{HN};
                pg8::gemm_phase(F.lds + RING_OFF, 256, A, B, S, E);
            } PH_END
            DBG_PHASE(dbg_check_fourier(F.ws, F.out, AR.in[6] + D, AR.in[5], (LAS float*)F.lds))
            PH_BEGIN {
                pg8::OpPlain A{HN, D, true}, B{(const bf16*)(F.ws + WS_WFO), D, false};
                pg8::StaticOrder S; S.init(ML / 256, D / 256, F.G, (int)blockIdx.x, 4);
                EpiResidNorm<true, false, 1> E{MR, F.out, F.out, AR.in[10], 0, 5, AR.in[6] + (size_t)(0 * 3 + 2) * D, 0, 6, HNA, RSTD, PSB + (size_t)1 * 262144, F.ctl + CW_PCNT + 1 * 1024, F.lds + RING_BYTES};
                pg8::gemm_phase(F.lds + RING_OFF, D, A, B, S, E);
                OpKSplit Ac{HN + (size_t)ML * D, D, D / 4, true}, Bc{(const bf16*)(F.ws + WS_WFO), D, D / 4, false};
                OrderCtxK Sc{F.G, (int)blockIdx.x}; EpiCtxAtomic<true, false> Ec{MR, XC, AR.in[10], 0, 5};
                pg8::gemm_phase(F.lds + RING_OFF, D / 4, Ac, Bc, Sc, Ec);
            } PH_END
        }
    FFN_STAGE(1);
    FFN_STAGE(2);
    {
        bf16* XM = (bf16*)(F.ws + WS_ACT + ACT_XM); bf16* LR = (bf16*)(F.ws + WS_ACT + ACT_LR); bf16* PO = (bf16*)(F.ws + WS_ACT + ACT_PO);
        REP(8) PH_BEGIN phase_rowstats(F, F.out, XC, RSTD, ML); PH_END
        REP(4096) PH_BEGIN phase_mix(F, MR, F.out, XC, RSTD, AR.in[6] + (size_t)(1 * 3 + 1) * D, AR.in[11], XM); PH_END
        REP(128) PH_BEGIN {
            OpXM A{XM, 1, 3}; OpWSel B{(const bf16*)(F.ws + WS_WSMALL), 1, 1 * MiB}; pg8::StaticOrder S; S.init(MT / 256, 3, F.G, (int)blockIdx.x); EpiLora E{LR};
            pg8::gemm_phase(F.lds + RING_OFF, D, A, B, S, E);
            { OpXM Ac{XM, 8, 0}; OpWSel Bc{(const bf16*)(F.ws + WS_WRKV), 8, 8 * MiB}; pg8::StaticOrder Sc; Sc.init(2, 24, F.G, (int)((blockIdx.x + F.G - 140) % F.G), pg8::WGM, 128); EpiRkvC Ec{(bf16*)(F.ws + WS_RKVC)};
              pg8::gemm_phase(F.lds + RING_OFF, D, Ac, Bc, Sc, Ec); }
        } PH_END
        DBG_PHASE(dbg_check_lora(F.ws, AR.in[14], AR.in[17], AR.in[19]))
        REP(512) PH_BEGIN {
            OpXM A{XM, 8, 0}; OpWSel B{(const bf16*)(F.ws + WS_WRKV), 8, 8 * MiB}; pg8::StaticOrder S; S.init(ML / 256, 24, F.G, (int)blockIdx.x); EpiRkv E{XM};
            pg8::gemm_phase(F.lds + RING_OFF, D, A, B, S, E);
        } PH_END
        DBG_PHASE(dbg_check_rkv(F.ws, AR.in[12]))
        REP(1)
#pragma unroll 1
        for (int w = 0; w <= SCAN_NW; ++w) { PH_BEGIN phase_scan_step(F, args, w); PH_END }
        DBG_PHASE(dbg_check_scan(F.ws, AR.in[13], AR.in[16], AR.in[21], AR.in[22], AR.in[15], AR.in[18]))
        DBG_PHASE(dbg_check_combine(F.ws, AR.in[22], AR.in[23], AR.in[24], AR.in[25]))
        PH_BEGIN {
            pg8::OpPlain A{(const bf16*)((const char*)LR + 2 * LR_STRIDE), 256, true}, B{(const bf16*)(F.ws + WS_WSMALL + WSM_G2T), 256, false};
            pg8::StaticOrder S; S.init(ML / 256, D / 256, F.G, (int)blockIdx.x);
            EpiCombGate E{PO, (const bf16*)(F.ws + WS_ACT + ACT_YB0), (const bf16*)(F.ws + WS_ACT + ACT_YB1), (const bf16*)(F.ws + WS_ACT + ACT_XM + 5 * XM_STRIDE), (const float*)(F.ws + WS_SA), AR.in[24], AR.in[25], F.lds + RING_BYTES};
            pg8::gemm_phase(F.lds + RING_OFF, 256, A, B, S, E);
        } PH_END
        PH_BEGIN {
            pg8::OpPlain A{PO, D, true}, B{(const bf16*)(F.ws + WS_WRO), D, false};
            pg8::StaticOrder S; S.init(ML / 256, D / 256, F.G, (int)blockIdx.x, 4);
            EpiResidNorm<false, false, 1> E{MR, F.out, F.out, nullptr, 1, 5, AR.in[6] + (size_t)(1 * 3 + 2) * D, 1, 6, HNA, RSTD, PSB + (size_t)4 * 262144, F.ctl + CW_PCNT + 4 * 1024, F.lds + RING_BYTES};
            pg8::gemm_phase(F.lds + RING_OFF, D, A, B, S, E);
        } PH_END
    }
    FFN_STAGE(3);
    DBG_PHASE(dbg_final(F.ws, F.out))
#undef PH_BEGIN
#undef PH_END
}

extern "C" void kernel_launch(void* const* d_in, const int* in_sizes, int n_in, void* d_out, int out_size, void* d_ws, size_t ws_size, hipStream_t stream) {
    static int grid = 0;
    if (grid == 0) {
        if (n_in != 28 || out_size != ML * D || ws_size < WS_END) { fprintf(stderr, "kernel_launch: unexpected shapes (n_in %d, out %d, ws %zu < %zu)\n", n_in, out_size, ws_size, (size_t)WS_END); grid = -1; return; }
        int dev = 0, cus = 0, per_cu = 0;
        if (hipGetDevice(&dev) != hipSuccess || hipDeviceGetAttribute(&cus, hipDeviceAttributeMultiprocessorCount, dev) != hipSuccess) { grid = -1; return; }
        if (hipFuncSetAttribute((const void*)mk_fwd, hipFuncAttributeMaxDynamicSharedMemorySize, LDS_BYTES) != hipSuccess) { fprintf(stderr, "kernel_launch: hipFuncSetAttribute failed\n"); grid = -1; return; }
        if (hipOccupancyMaxActiveBlocksPerMultiprocessor(&per_cu, (const void*)mk_fwd, NWAVES * 64, LDS_BYTES) != hipSuccess || per_cu < 1)
            fprintf(stderr, "kernel_launch: occupancy query reports %d per CU\n", per_cu);
        (void)hipGetLastError();
        grid = cus;
        if (cus != 256) { fprintf(stderr, "kernel_launch: built for a 256-CU device (the scan phase maps its 256 chains-halves onto 256 workgroups); found %d CUs, nothing launched\n", cus); grid = -1; return; }
    }
    if (grid < 0) return;
    if (hipMemsetAsync((char*)d_ws + WS_CTL, 0, CTL_ZERO_BYTES, stream) != hipSuccess) return;
    Args a{};
    for (int i = 0; i < 28; ++i) a.in[i] = (const float*)d_in[i];
    a.out = (float*)d_out; a.ws = (unsigned char*)d_ws;
#if MK_PER_PHASE
    for (int p = 0; p < NPH; ++p) { a.ph_lo = p; a.ph_hi = p + 1; hipLaunchKernelGGL(mk_fwd, dim3(grid), dim3(NWAVES * 64), LDS_BYTES, stream, a); }
#else
    a.ph_lo = 0; a.ph_hi = 100000;
    hipLaunchKernelGGL(mk_fwd, dim3(grid), dim3(NWAVES * 64), LDS_BYTES, stream, a);
#endif
}
```
